# Optimizing an MI355X kernel written in HIP

```python
import math
import jax, jax.numpy as jnp
from jax import lax
import numpy as np

D_MODEL = 1024
BATCH = 16
SEQ = 2048
DEPTH = 4

GLA_HEADS = 4
GLA_DK = 32
GLA_DV = 64
GLA_RANK = 16
GLA_GATE_TEMP = 16.0
DIFF_HEADS = 4
DIFF_HD = 64
DIFF_DV = 2 * DIFF_HD
HGRN_HEADS = 4
HGRN_DK = 64
HGRN_DV = 64
CHUNK = 16
Q_BLOCK = 128
ROPE_THETA = 10000.0
EPS = 1e-6
F_FLOOR = 1e-30

GLA_W = GLA_HEADS * GLA_DV
DIFF_W = DIFF_HEADS * DIFF_DV
HGRN_W = HGRN_HEADS * HGRN_DV
MIX_W = GLA_W + DIFF_W + HGRN_W

IN_SIZES = (
    GLA_HEADS * GLA_DK, GLA_HEADS * GLA_DK, GLA_W, GLA_W, GLA_RANK, GLA_RANK,
    DIFF_HEADS * 2 * DIFF_HD, DIFF_HEADS * 2 * DIFF_HD, DIFF_W, DIFF_W,
    HGRN_HEADS * HGRN_DK, HGRN_HEADS * HGRN_DK, HGRN_HEADS * HGRN_DK, HGRN_W, HGRN_W,
)
IN_W = sum(IN_SIZES)

kernel_name = "hybrid_gla_diffattn_hgrn2_bidir_encoder"


def _offsets():
    offs, run = [], 0
    for s in IN_SIZES[:-1]:
        run += s
        offs.append(run)
    return offs


def rms_norm(x, w):
    xf = x.astype(jnp.float32)
    xf = xf * lax.rsqrt(jnp.mean(xf * xf, axis=-1, keepdims=True) + EPS)
    return xf.astype(x.dtype) * w


def split_heads(t, n_heads):
    b, l, _ = t.shape
    return t.reshape(b, l, n_heads, -1).transpose(0, 2, 1, 3)


def merge_heads(t):
    b, h, l, d = t.shape
    return t.transpose(0, 2, 1, 3).reshape(b, l, h * d)


def rope(x, pos):
    d = x.shape[-1]
    inv_freq = ROPE_THETA ** (-jnp.arange(0, d, 2, dtype=jnp.float32) / d)
    ang = pos.astype(jnp.float32)[:, None] * inv_freq[None, :]
    cos, sin = jnp.cos(ang).astype(x.dtype), jnp.sin(ang).astype(x.dtype)
    x1, x2 = x[..., : d // 2], x[..., d // 2:]
    return jnp.concatenate([x1 * cos - x2 * sin, x2 * cos + x1 * sin], axis=-1)


def chunked_gated_scan(q, k, v, log_g):
    b_, h_, l_, dk = q.shape
    dv = v.shape[-1]
    n = l_ // CHUNK
    r = lambda t: t.reshape(b_, h_, n, CHUNK, t.shape[-1])
    q, k, v, lg = r(q), r(k), r(v), r(log_g)
    bcum = jnp.cumsum(lg.astype(jnp.float32), axis=3)
    mask = jnp.tril(jnp.ones((CHUNK, CHUNK), dtype=bool))[:, :, None]
    diff = bcum[:, :, :, :, None, :] - bcum[:, :, :, None, :, :]
    decay = jnp.where(mask, jnp.exp(jnp.where(mask, diff, 0.0)), 0.0)
    attn = jnp.einsum('bhntk,bhnsk,bhntsk->bhnts', q, k, decay.astype(q.dtype))
    o_intra = jnp.einsum('bhnts,bhnsv->bhntv', attn, v)
    b_last = bcum[:, :, :, -1:, :]
    u = jnp.einsum('bhnsk,bhnsv->bhnkv', k * jnp.exp(b_last - bcum).astype(k.dtype), v)
    g_chunk = jnp.exp(b_last[:, :, :, 0, :]).astype(u.dtype)

    def step(state, inp):
        g_n, u_n = inp
        return g_n[..., None] * state + u_n, state

    s0 = jnp.zeros((b_, h_, dk, dv), u.dtype)
    _, s_prev = lax.scan(step, s0, (jnp.moveaxis(g_chunk, 2, 0), jnp.moveaxis(u, 2, 0)))
    s_prev = jnp.moveaxis(s_prev, 0, 2)
    o_inter = jnp.einsum('bhntk,bhnkv->bhntv', q * jnp.exp(bcum).astype(q.dtype), s_prev)
    return (o_intra + o_inter).reshape(b_, h_, l_, dv).astype(v.dtype)


def bidir_scan(q, k_f, k_b, v, lg_f, lg_b):
    flip = lambda t: jnp.flip(t, axis=2)
    o_f = chunked_gated_scan(q, k_f, v, lg_f)
    o_b = flip(chunked_gated_scan(flip(q), flip(k_b), flip(v), flip(lg_b)))
    return o_f + o_b


def gla_branch(q, k, v, g, a_f, a_b, wa2_f, ba_f, wa2_b, ba_b, norm_w):
    q = split_heads(q, GLA_HEADS) * (GLA_DK ** -0.5)
    k = split_heads(k, GLA_HEADS)
    v = split_heads(v, GLA_HEADS)
    lg_f = split_heads(jax.nn.log_sigmoid((a_f @ wa2_f + ba_f).astype(jnp.float32)) / GLA_GATE_TEMP, GLA_HEADS)
    lg_b = split_heads(jax.nn.log_sigmoid((a_b @ wa2_b + ba_b).astype(jnp.float32)) / GLA_GATE_TEMP, GLA_HEADS)
    o = bidir_scan(q, k, k, v, lg_f, lg_b)
    o = rms_norm(o, norm_w)
    return merge_heads(o) * jax.nn.silu(g)


def diff_branch(q, k, v, g, lq1, lk1, lq2, lk2, norm_w, lambda_init, pos):
    b_, l_, _ = q.shape
    q = q.reshape(b_, l_, DIFF_HEADS, 2, DIFF_HD).transpose(3, 0, 2, 1, 4)
    k = k.reshape(b_, l_, DIFF_HEADS, 2, DIFF_HD).transpose(3, 0, 2, 1, 4)
    q = rope(q, pos) * (DIFF_HD ** -0.5)
    k = rope(k, pos)
    v = split_heads(v, DIFF_HEADS)
    lam = (jnp.exp(jnp.sum(lq1 * lk1).astype(jnp.float32))
           - jnp.exp(jnp.sum(lq2 * lk2).astype(jnp.float32)) + lambda_init)
    nb = l_ // Q_BLOCK
    qb = jnp.moveaxis(q.reshape(2, b_, DIFF_HEADS, nb, Q_BLOCK, DIFF_HD), 3, 0)

    def block(qblk):
        s = jnp.einsum('cbhqd,cbhkd->cbhqk', qblk, k).astype(jnp.float32)
        p = jax.nn.softmax(s, axis=-1)
        w = p[0] - lam * p[1]
        return jnp.einsum('bhqk,bhkv->bhqv', w.astype(v.dtype), v)

    o = lax.map(block, qb)
    o = jnp.moveaxis(o, 0, 2).reshape(b_, DIFF_HEADS, l_, DIFF_DV)
    o = rms_norm(o, norm_w) * (1.0 - lambda_init)
    return merge_heads(o) * jax.nn.silu(g)


def hgrn_branch(q, z_f, z_b, i, g, lb, norm_w):
    lb32 = lb.astype(jnp.float32)

    def gates(z):
        z32 = z.astype(jnp.float32)
        one_minus_f = (1.0 - lb32) * jax.nn.sigmoid(-z32)
        f = lb32 + (1.0 - lb32) * jax.nn.sigmoid(z32)
        log_f = jnp.log(jnp.maximum(f, F_FLOOR))
        return split_heads(log_f, HGRN_HEADS), split_heads(one_minus_f.astype(z.dtype), HGRN_HEADS)

    lg_f, k_f = gates(z_f)
    lg_b, k_b = gates(z_b)
    o = bidir_scan(split_heads(q, HGRN_HEADS), k_f, k_b, split_heads(i, HGRN_HEADS), lg_f, lg_b)
    o = rms_norm(o, norm_w)
    return merge_heads(o) * jax.nn.silu(g)


def setup_inputs(seed: int = 0) -> dict:
    key = jax.random.key(seed)
    ks = jax.random.split(key, 20)
    nrm = lambda k, shape, s: jax.random.normal(k, shape, jnp.float32) * s
    return {
        "x": nrm(ks[0], (BATCH, SEQ, D_MODEL), 1.0),
        "norm_pre": 1.0 + nrm(ks[1], (DEPTH, D_MODEL), 0.05),
        "norm_post": 1.0 + nrm(ks[2], (DEPTH, D_MODEL), 0.05),
        "w_in": nrm(ks[3], (DEPTH, D_MODEL, IN_W), D_MODEL ** -0.5),
        "w_out": nrm(ks[4], (DEPTH, MIX_W, D_MODEL), MIX_W ** -0.5),
        "gla_wa2_fwd": nrm(ks[5], (DEPTH, GLA_RANK, GLA_HEADS * GLA_DK), GLA_RANK ** -0.5),
        "gla_ba_fwd": nrm(ks[6], (DEPTH, GLA_HEADS * GLA_DK), 0.1),
        "gla_wa2_bwd": nrm(ks[7], (DEPTH, GLA_RANK, GLA_HEADS * GLA_DK), GLA_RANK ** -0.5),
        "gla_ba_bwd": nrm(ks[8], (DEPTH, GLA_HEADS * GLA_DK), 0.1),
        "gla_norm": 1.0 + nrm(ks[9], (DEPTH, GLA_DV), 0.05),
        "diff_lq1": nrm(ks[10], (DEPTH, DIFF_HD), 0.1),
        "diff_lk1": nrm(ks[11], (DEPTH, DIFF_HD), 0.1),
        "diff_lq2": nrm(ks[12], (DEPTH, DIFF_HD), 0.1),
        "diff_lk2": nrm(ks[13], (DEPTH, DIFF_HD), 0.1),
        "diff_norm": 1.0 + nrm(ks[14], (DEPTH, DIFF_DV), 0.05),
        "hgrn_lb_logits": nrm(ks[15], (DEPTH, HGRN_HEADS * HGRN_DK), 0.1),
        "hgrn_norm": 1.0 + nrm(ks[16], (DEPTH, HGRN_DV), 0.05),
    }


def reference(x, norm_pre, norm_post, w_in, w_out, gla_wa2_fwd, gla_ba_fwd, gla_wa2_bwd, gla_ba_bwd,
              gla_norm, diff_lq1, diff_lk1, diff_lq2, diff_lk2, diff_norm, hgrn_lb_logits, hgrn_norm):
    pos = jnp.arange(x.shape[1], dtype=jnp.int32)
    p_lb = jax.nn.softmax(hgrn_lb_logits.astype(jnp.float32), axis=0)
    lb_all = jnp.cumsum(p_lb, axis=0) - p_lb[0:1]
    offs = _offsets()
    for layer in range(DEPTH):
        lambda_init = 0.8 - 0.6 * math.exp(-0.3 * layer)
        h = rms_norm(x, norm_pre[layer])
        proj = h @ w_in[layer]
        (gq, gk, gv, gg, gaf, gab, dq, dk, dv, dg, hq, hzf, hzb, hi, hg) = jnp.split(proj, offs, axis=-1)
        y_a = gla_branch(gq, gk, gv, gg, gaf, gab, gla_wa2_fwd[layer], gla_ba_fwd[layer],
                         gla_wa2_bwd[layer], gla_ba_bwd[layer], gla_norm[layer])
        y_b = diff_branch(dq, dk, dv, dg, diff_lq1[layer], diff_lk1[layer], diff_lq2[layer], diff_lk2[layer],
                          diff_norm[layer], lambda_init, pos)
        y_c = hgrn_branch(hq, hzf, hzb, hi, hg, lb_all[layer], hgrn_norm[layer])
        y = jnp.concatenate([y_a, y_b, y_c], axis=-1) @ w_out[layer]
        x = x + rms_norm(y, norm_post[layer])
    return x
```

```cpp
#include <hip/hip_runtime.h>
#include <hip/hip_cooperative_groups.h>
#include <hip/hip_bf16.h>
#include <cstdio>
#include <cstdint>
#include <cmath>
namespace cg = cooperative_groups;
namespace pg8 {
#define PG8_LAS __attribute__((address_space(3)))
typedef unsigned short bf16_t;
typedef short bf16x8 __attribute__((ext_vector_type(8)));
typedef float f32x4 __attribute__((ext_vector_type(4)));
typedef unsigned u32x4 __attribute__((ext_vector_type(4)));
constexpr int BM = 256, BK = 64, HALF = 128, HTB = HALF * BK * 2  , STAGE_BYTES = 8 * HTB, NXCD = 8, WGM = 8;

__host__ __device__ __forceinline__ int lds_byte(int r, int c) { const int st = (r >> 4) * 2 + (c >> 5), rr = r & 15, cc = c & 31, ob = rr * 64 + cc * 2; return st * 1024 + (ob ^ (((ob >> 9) & 1) << 5)); }
__host__ __device__ __forceinline__ void stage_rc(int b, int& R, int& C) { const int st = b / 1024, sb = b % 1024, swz = sb ^ (((sb >> 9) & 1) << 5); R = (st >> 1) * 16 + swz / 64; C = (st & 1) * 32 + (swz % 64) / 2; }
__host__ __device__ __forceinline__ int perm32(int rho) { const int n = rho >> 4, i = rho & 15; return 8 * (i >> 2) + 4 * n + (i & 3); }

struct Unit { int pm, pn; };
struct Gemm { const bf16_t* A; const bf16_t* Bt; int M, N, K; };

struct StaticOrder {
    int nM, nN, nwg, G, c;
    __host__ __device__ void init(int M, int N, int G_, int c_) { nM = M / BM; nN = N / BM; nwg = nM * nN; G = G_; c = c_; }
    __host__ __device__ bool next(int i, Unit& u) const {
        const long L = (long)i * G + c; if (L >= nwg) return false;
        int wgid = (int)L; { const int q = nwg / NXCD, r = nwg % NXCD, xcd = wgid % NXCD, off = wgid / NXCD; wgid = (xcd < r ? xcd * (q + 1) : r * (q + 1) + (xcd - r) * q) + off; }
        const int nig = WGM * nN, gid = wgid / nig, fm = gid * WGM, gsz = (nM - fm) < WGM ? (nM - fm) : WGM;
        u.pm = fm + ((wgid % nig) % gsz); u.pn = (wgid % nig) / gsz; return true;
    }
    __device__ __forceinline__ void a_ready(const Unit&) const {}
    __device__ __forceinline__ void done(const Unit&) const {}
};
__device__ __forceinline__ unsigned cvt_pk_bf16(float lo, float hi) { unsigned r; asm volatile("v_cvt_pk_bf16_f32 %0, %1, %2" : "=v"(r) : "v"(lo), "v"(hi)); return r; }
typedef float f32x2 __attribute__((ext_vector_type(2)));
struct EpiF32 {
    static constexpr bool PERM = false, AFTER_DRAIN = false;
    float* C; int ldc; const float* bias;
    __device__ __forceinline__ void operator()(const f32x4 (&acc)[2][2][4][2], const Unit& u, int wr, int wc, int fr, int fq) const {
        const int row0 = u.pm * BM + wr * 64 + fr, col0 = u.pn * BM + wc * 32 + 4 * fq;
        f32x4 bv[2][2];
#pragma unroll
        for (int bj = 0; bj < 2; ++bj)
#pragma unroll
            for (int n = 0; n < 2; ++n) bv[bj][n] = bias ? *(const f32x4*)(bias + col0 + bj * HALF + n * 16) : (f32x4){0.f, 0.f, 0.f, 0.f};
#pragma unroll
        for (int ai = 0; ai < 2; ++ai)
#pragma unroll
            for (int m = 0; m < 4; ++m) { float* rowp = C + (size_t)(row0 + ai * HALF + m * 16) * ldc + col0;
#pragma unroll
                for (int bj = 0; bj < 2; ++bj)
#pragma unroll
                    for (int n = 0; n < 2; ++n) *(f32x4*)(rowp + bj * HALF + n * 16) = acc[ai][bj][m][n] + bv[bj][n]; }
    }
};
struct EpiProj {
    static constexpr bool PERM = true, AFTER_DRAIN = false;
    bf16_t* O; const float* cosT; const float* sinT;
    __device__ __forceinline__ void operator()(const f32x4 (&acc)[2][2][4][2], const Unit& u, int wr, int wc, int fr, int fq) const {
        const int row0 = u.pm * BM + wr * 64 + fr, col0 = u.pn * BM + wc * 32 + 8 * fq;
        const bool rope = (u.pn >= 3 && u.pn <= 6);
        const int j8 = (wc & 1) * 4 + fq;
#pragma unroll
        for (int ai = 0; ai < 2; ++ai)
#pragma unroll
            for (int m = 0; m < 4; ++m) { const int row = row0 + ai * HALF + m * 16; bf16_t* rowp = O + (size_t)row * 4096 + col0;
                f32x4 c4 = (f32x4){1.f, 1.f, 1.f, 1.f}, s4 = (f32x4){0.f, 0.f, 0.f, 0.f};
                if (rope) { const int pos = row & 2047; c4 = *(const f32x4*)(cosT + pos * 32 + 4 * j8); s4 = *(const f32x4*)(sinT + pos * 32 + 4 * j8); }
#pragma unroll
                for (int bj = 0; bj < 2; ++bj) { const f32x4 a0 = acc[ai][bj][m][0], a1 = acc[ai][bj][m][1];
                    const f32x4 v0 = a0 * c4 - a1 * s4, v1 = a1 * c4 + a0 * s4;
                    u32x4 w; w.x = cvt_pk_bf16(v0[0], v0[1]); w.y = cvt_pk_bf16(v0[2], v0[3]); w.z = cvt_pk_bf16(v1[0], v1[1]); w.w = cvt_pk_bf16(v1[2], v1[3]);
                    *(u32x4*)(rowp + bj * HALF) = w; } }
    }
};
template <class Epi, class Sched, bool ALIGN_EPI = false, bool SP2 = false>
__device__ __forceinline__ void gemm_phase(PG8_LAS unsigned char* lds, const Gemm g, const Sched& S, const Epi& E) {
    int tid_ = threadIdx.x; asm volatile("" : "+v"(tid_));
    const int tid = tid_, wid = __builtin_amdgcn_readfirstlane(tid >> 6), lane = tid & 63, wr = wid >> 2, wc = wid & 3, fr = lane & 15, fq = lane >> 4;
    const int K = g.K, nt = K / BK;
    unsigned voffA[2], voffB[2];
#pragma unroll
    for (int i = 0; i < 2; ++i) { int R, C; stage_rc(tid * 16 + i * 8192, R, C); const int Rb = Epi::PERM ? ((R & ~31) + perm32(R & 31)) : R;
        voffA[i] = (unsigned)(R * K + C) * 2u; voffB[i] = (unsigned)(Rb * K + C) * 2u; }
    const size_t kstep = (size_t)(BK * 2);
    const size_t hstep = (size_t)HALF * K * 2;
    const size_t tstep = 2 * hstep;
    const unsigned ldsw = (unsigned)wid * 1024u;
    const int aoff = lds_byte(wr * 64 + fr, fq * 8), boff = lds_byte(wc * 32 + fr, fq * 8);
#define PG8_SA(b, h) (((b) * 2 + (h)) * HTB)
#define PG8_SB(b, h) ((4 + (b) * 2 + (h)) * HTB)
#define PG8_STAGE(bufoff, gbase, voff) do { _Pragma("unroll") for (int _i = 0; _i < 2; ++_i) \
        __builtin_amdgcn_global_load_lds((const unsigned*)((const char*)(gbase) + (voff)[_i]), (PG8_LAS unsigned*)(lds + (bufoff) + ldsw + _i * 8192), 16, 0, 0); } while (0)
#define PG8_LDA(dst, b, h) do { _Pragma("unroll") for (int m = 0; m < 4; ++m) _Pragma("unroll") for (int k = 0; k < 2; ++k) dst[m][k] = *(const PG8_LAS bf16x8*)(lds + PG8_SA(b, h) + aoff + m * 2048 + k * 1024); } while (0)
#define PG8_LDB(dst, b, h) do { _Pragma("unroll") for (int n = 0; n < 2; ++n) _Pragma("unroll") for (int k = 0; k < 2; ++k) dst[n][k] = *(const PG8_LAS bf16x8*)(lds + PG8_SB(b, h) + boff + n * 2048 + k * 1024); } while (0)
#define PG8_MMA(ai, bj, At, Bt) do { __builtin_amdgcn_s_setprio(1); _Pragma("unroll") for (int m = 0; m < 4; ++m) _Pragma("unroll") for (int n = 0; n < 2; ++n) _Pragma("unroll") for (int k = 0; k < 2; ++k) \
        acc[ai][bj][m][n] = __builtin_amdgcn_mfma_f32_16x16x32_bf16(Bt[n][k], At[m][k], acc[ai][bj][m][n], 0, 0, 0); __builtin_amdgcn_s_setprio(0); } while (0)
#define PG8_WAIT_V(n) asm volatile("s_waitcnt vmcnt(" #n ")" ::: "memory")
#define PG8_WAIT_L(n) asm volatile("s_waitcnt lgkmcnt(" #n ")" ::: "memory")
#define PG8_BAR __builtin_amdgcn_s_barrier()
#define PG8_SCHED __builtin_amdgcn_sched_barrier(0)
    Unit cur, nxt; int ui = 0;
    if (!S.next(0, cur)) return;
    f32x4 acc[2][2][4][2];
#pragma unroll
    for (int a = 0; a < 2; ++a)
#pragma unroll
        for (int b = 0; b < 2; ++b)
#pragma unroll
            for (int m = 0; m < 4; ++m)
#pragma unroll
                for (int n = 0; n < 2; ++n) acc[a][b][m][n] = (f32x4){0.f, 0.f, 0.f, 0.f};
    bf16x8 At[4][2], B0[2][2], B1[2][2];
    const char* cA = (const char*)g.A + (size_t)cur.pm * tstep; const char* cB = (const char*)g.Bt + (size_t)cur.pn * tstep;
    S.a_ready(cur);
    if constexpr (SP2) {
        PG8_STAGE(PG8_SB(0, 0), cB, voffB); PG8_STAGE(PG8_SB(0, 1), cB + hstep, voffB); PG8_STAGE(PG8_SA(0, 0), cA, voffA); PG8_STAGE(PG8_SA(0, 1), cA + hstep, voffA);
        if (wr == 1) PG8_BAR;
        PG8_WAIT_V(2); PG8_BAR;
        PG8_STAGE(PG8_SB(1, 0), cB + kstep, voffB); PG8_STAGE(PG8_SA(1, 0), cA + kstep, voffA); PG8_STAGE(PG8_SB(1, 1), cB + hstep + kstep, voffB);
        PG8_WAIT_V(6); PG8_BAR;
    } else {
        PG8_STAGE(PG8_SB(0, 0), cB, voffB); PG8_STAGE(PG8_SA(0, 0), cA, voffA); PG8_STAGE(PG8_SB(0, 1), cB + hstep, voffB); PG8_STAGE(PG8_SA(0, 1), cA + hstep, voffA);
        if (wr == 1) PG8_BAR;
        PG8_WAIT_V(4); PG8_BAR;
        PG8_STAGE(PG8_SB(1, 0), cB + kstep, voffB); PG8_STAGE(PG8_SA(1, 0), cA + kstep, voffA); PG8_STAGE(PG8_SB(1, 1), cB + hstep + kstep, voffB);
        PG8_WAIT_V(6); PG8_BAR;
    }
    for (;;) {
        const bool has_next = S.next(ui + 1, nxt);
        const char* nA = has_next ? (const char*)g.A + (size_t)nxt.pm * tstep : cA; const char* nB = has_next ? (const char*)g.Bt + (size_t)nxt.pn * tstep : cB;
        for (int t = 0; t < nt; t += 2) {
            const bool last = (t == nt - 2);
            const char* a1 = cA + (size_t)(t + 1) * kstep;
            const char* a2 = last ? nA : cA + (size_t)(t + 2) * kstep; const char* b2 = last ? nB : cB + (size_t)(t + 2) * kstep;
            const char* a3 = a2 + kstep; const char* b3 = b2 + kstep;
            if (last && has_next) S.a_ready(nxt);
            if constexpr (SP2) {
            PG8_LDB(B0, 0, 0); PG8_LDB(B1, 0, 1); PG8_SCHED; PG8_LDA(At, 0, 0); PG8_STAGE(PG8_SA(1, 1), a1 + hstep, voffA);
            PG8_WAIT_V(8); PG8_WAIT_L(0); PG8_BAR; PG8_MMA(0, 0, At, B0); PG8_MMA(0, 1, At, B1); PG8_BAR; PG8_SCHED;
            PG8_LDA(At, 0, 1); PG8_STAGE(PG8_SB(0, 0), b2, voffB); PG8_STAGE(PG8_SB(0, 1), b2 + hstep, voffB); PG8_STAGE(PG8_SA(0, 0), a2, voffA);
            PG8_WAIT_V(8); PG8_WAIT_L(0); PG8_BAR; PG8_MMA(1, 0, At, B0); PG8_MMA(1, 1, At, B1); PG8_BAR; PG8_SCHED;
            PG8_LDB(B0, 1, 0); PG8_LDB(B1, 1, 1); PG8_SCHED; PG8_LDA(At, 1, 0); PG8_STAGE(PG8_SA(0, 1), a2 + hstep, voffA);
            PG8_WAIT_V(8); PG8_WAIT_L(0); PG8_BAR; PG8_MMA(0, 0, At, B0); PG8_MMA(0, 1, At, B1); PG8_BAR; PG8_SCHED;
            PG8_LDA(At, 1, 1); PG8_STAGE(PG8_SB(1, 0), b3, voffB); PG8_STAGE(PG8_SB(1, 1), b3 + hstep, voffB); PG8_STAGE(PG8_SA(1, 0), a3, voffA);
            PG8_WAIT_V(8); PG8_WAIT_L(0); PG8_BAR; PG8_MMA(1, 0, At, B0); PG8_MMA(1, 1, At, B1); PG8_BAR; PG8_SCHED;
            } else {
            PG8_LDB(B0, 0, 0); PG8_SCHED; PG8_LDA(At, 0, 0); PG8_STAGE(PG8_SA(1, 1), a1 + hstep, voffA);
            PG8_WAIT_L(8); PG8_BAR; PG8_WAIT_L(0); PG8_MMA(0, 0, At, B0); PG8_BAR; PG8_SCHED;
            PG8_LDB(B1, 0, 1); PG8_STAGE(PG8_SB(0, 0), b2, voffB);
            PG8_BAR; PG8_WAIT_L(0); PG8_MMA(0, 1, At, B1); PG8_BAR;
            PG8_LDA(At, 0, 1); PG8_STAGE(PG8_SA(0, 0), a2, voffA);
            PG8_BAR; PG8_WAIT_L(0); PG8_MMA(1, 0, At, B0); PG8_BAR; PG8_SCHED;
            PG8_STAGE(PG8_SB(0, 1), b2 + hstep, voffB);
            PG8_WAIT_V(6); PG8_BAR; PG8_MMA(1, 1, At, B1); PG8_BAR;
            PG8_LDB(B0, 1, 0); PG8_SCHED; PG8_LDA(At, 1, 0); PG8_STAGE(PG8_SA(0, 1), a2 + hstep, voffA);
            PG8_WAIT_L(8); PG8_BAR; PG8_WAIT_L(0); PG8_MMA(0, 0, At, B0); PG8_BAR; PG8_SCHED;
            PG8_LDB(B1, 1, 1); PG8_STAGE(PG8_SB(1, 0), b3, voffB);
            PG8_BAR; PG8_WAIT_L(0); PG8_MMA(0, 1, At, B1); PG8_BAR;
            PG8_LDA(At, 1, 1); PG8_STAGE(PG8_SA(1, 0), a3, voffA);
            PG8_BAR; PG8_WAIT_L(0); PG8_MMA(1, 0, At, B0); PG8_BAR; PG8_SCHED;
            PG8_STAGE(PG8_SB(1, 1), b3 + hstep, voffB);
            PG8_WAIT_V(6); PG8_BAR; PG8_MMA(1, 1, At, B1); PG8_BAR;
            }
        }
        if constexpr (ALIGN_EPI) { if (wr == 0) PG8_BAR; }
        if constexpr (!Epi::AFTER_DRAIN) { E(acc, cur, wr, wc, fr, fq); S.done(cur); }
        if (!has_next) break;
#pragma unroll
        for (int a = 0; a < 2; ++a)
#pragma unroll
            for (int b = 0; b < 2; ++b)
#pragma unroll
                for (int m = 0; m < 4; ++m)
#pragma unroll
                    for (int n = 0; n < 2; ++n) acc[a][b][m][n] = (f32x4){0.f, 0.f, 0.f, 0.f};
        cur = nxt; cA = nA; cB = nB; ++ui;
        if constexpr (ALIGN_EPI) { if (wr == 1) PG8_BAR; }
    }
    PG8_WAIT_V(0);
    if constexpr (!ALIGN_EPI) { if (wr == 0) PG8_BAR; }
    PG8_BAR;
    if constexpr (Epi::AFTER_DRAIN) { E.fused(acc, cur, wr, wc, fr, fq, lds, wid, lane); S.done(cur); }
#undef PG8_SA
#undef PG8_SB
#undef PG8_STAGE
#undef PG8_LDA
#undef PG8_LDB
#undef PG8_MMA
#undef PG8_WAIT_V
#undef PG8_WAIT_L
#undef PG8_BAR
#undef PG8_SCHED
}
}
namespace dattn {
using bf16x8 = __attribute__((ext_vector_type(8))) short;
using s16x4  = __attribute__((ext_vector_type(4))) short;
using f32x16 = __attribute__((ext_vector_type(16))) float;
using u32x4  = __attribute__((ext_vector_type(4))) unsigned;
typedef unsigned short bf16r;
constexpr int NW = 8, QBLK = 32, KVBLK = 64, SEQ = 2048, LDP = 4096;
constexpr float SCALE = 0.125f, THR = 8.f;
constexpr size_t SHM_V = KVBLK * 128 * 2, SHM_K = KVBLK * 128 * 2, SHM_ATTN = 2 * SHM_V + 2 * SHM_K + NW * 64 * 4;
#define KSWZ(row, colB) ((row) * 256 + ((colB) ^ (((row) & 7) << 4)))
#define SBAR() __builtin_amdgcn_sched_barrier(0)
__device__ __forceinline__ int crow(int r, int hi) { return (r & 3) + 8 * (r >> 2) + 4 * hi; }
__device__ __forceinline__ unsigned cvtpk(float lo, float hi) { unsigned r; asm volatile("v_cvt_pk_bf16_f32 %0, %1, %2" : "=v"(r) : "v"(lo), "v"(hi)); return r; }

__device__ __forceinline__ void partialSM(f32x16& p0, f32x16& p1, float& m_reg, float& mn, float& alpha) {
  constexpr float C = SCALE * 1.4426950408889634f;
  float pmax = p0[0];
#pragma unroll
  for (int r = 1; r < 16; ++r) pmax = fmaxf(pmax, p0[r]);
#pragma unroll
  for (int r = 0; r < 16; ++r) pmax = fmaxf(pmax, p1[r]);
  { auto rr = __builtin_amdgcn_permlane32_swap(__float_as_uint(pmax), __float_as_uint(pmax), false, false);
    pmax = fmaxf(__uint_as_float(rr[0]), __uint_as_float(rr[1])); }
  if (__builtin_expect(__all(pmax - m_reg <= THR / SCALE), 1)) { mn = m_reg; alpha = 1.f; }
  else { mn = fmaxf(m_reg, pmax); alpha = __builtin_amdgcn_exp2f((m_reg - mn) * C); m_reg = mn; }
  float mnC = -mn * C;
#pragma unroll
  for (int r = 0; r < 16; ++r) p0[r] = fmaf(p0[r], C, mnC);
#pragma unroll
  for (int r = 0; r < 16; ++r) p1[r] = fmaf(p1[r], C, mnC);
#pragma unroll
  for (int r = 0; r < 16; ++r) p0[r] = __builtin_amdgcn_exp2f(p0[r]);
}
__device__ __forceinline__ void finishSM(f32x16& p0, f32x16& p1, float alpha, float& l_reg, bf16x8& pa0, bf16x8& pa1, bf16x8& pa2, bf16x8& pa3) {
#pragma unroll
  for (int r = 0; r < 16; ++r) p1[r] = __builtin_amdgcn_exp2f(p1[r]);
  float ps = 0;
#pragma unroll
  for (int r = 0; r < 16; ++r) ps += p0[r];
#pragma unroll
  for (int r = 0; r < 16; ++r) ps += p1[r];
  { auto rr = __builtin_amdgcn_permlane32_swap(__float_as_uint(ps), __float_as_uint(ps), false, false);
    ps = __uint_as_float(rr[0]) + __uint_as_float(rr[1]); }
  l_reg = l_reg * alpha + ps;
#define PK4(P, BASE, OUT) do { unsigned a0 = cvtpk(P[BASE + 0], P[BASE + 1]), a1 = cvtpk(P[BASE + 2], P[BASE + 3]);   \
    unsigned b0 = cvtpk(P[BASE + 4], P[BASE + 5]), b1 = cvtpk(P[BASE + 6], P[BASE + 7]);                              \
    auto r0 = __builtin_amdgcn_permlane32_swap(a0, b0, false, false); auto r1 = __builtin_amdgcn_permlane32_swap(a1, b1, false, false); \
    u32x4 w = {r0[0], r1[0], r0[1], r1[1]}; OUT = *reinterpret_cast<bf16x8*>(&w); } while (0)
  PK4(p0, 0, pa0); PK4(p0, 8, pa1); PK4(p1, 0, pa2); PK4(p1, 8, pa3);
#undef PK4
}
__device__ __forceinline__ void qkt(f32x16& p0, f32x16& p1, const char* Ks, const bf16x8* qr, int r32, int hi, int colb0) {
  p0 = f32x16{}; p1 = f32x16{};
#pragma unroll
  for (int d0 = 0; d0 < 4; ++d0) { int cb = colb0 + (d0 * 16 + hi * 8) * 2;
    bf16x8 b0 = *reinterpret_cast<const bf16x8*>(Ks + KSWZ(r32, cb));
    bf16x8 b1 = *reinterpret_cast<const bf16x8*>(Ks + KSWZ(32 + r32, cb));
    p0 = __builtin_amdgcn_mfma_f32_32x32x16_bf16(b0, qr[d0], p0, 0, 0, 0);
    p1 = __builtin_amdgcn_mfma_f32_32x32x16_bf16(b1, qr[d0], p1, 0, 0, 0); }
}
__device__ __forceinline__ int v_st(int k, int c) { const int kk = (k & ~0xC) | ((k & 4) << 1) | ((k & 8) >> 1); return ((kk >> 3) * 4 + (c >> 5)) * 512 + ((kk & 7) * 32 + (c & 31)) * 2; }
__device__ __forceinline__ int v_rd_base(int lane) { return ((lane & 3) << 3) | (((lane >> 2) & 3) << 6) | (((lane >> 4) & 1) << 5) | (((lane >> 5) & 1) << 8); }
constexpr int v_rd_off(int d0, int ks, int half) { return d0 * 512 + ks * 4096 + half * 2048; }
template <int OFF> __device__ __forceinline__ s16x4 tr_read(int vb) {
  s16x4 r; asm volatile("ds_read_b64_tr_b16 %0, %1 offset:%2" : "=&v"(r) : "v"(vb), "i"(OFF) : "memory"); return r;
}
template <int D0> __device__ __forceinline__ void pv_one(f32x16& od, int vb, bf16x8 pa0, bf16x8 pa1, bf16x8 pa2, bf16x8 pa3) {
  const s16x4 l0 = tr_read<v_rd_off(D0, 0, 0)>(vb), h0 = tr_read<v_rd_off(D0, 0, 1)>(vb), l1 = tr_read<v_rd_off(D0, 1, 0)>(vb), h1 = tr_read<v_rd_off(D0, 1, 1)>(vb);
  const s16x4 l2 = tr_read<v_rd_off(D0, 2, 0)>(vb), h2 = tr_read<v_rd_off(D0, 2, 1)>(vb), l3 = tr_read<v_rd_off(D0, 3, 0)>(vb), h3 = tr_read<v_rd_off(D0, 3, 1)>(vb);
  asm volatile("s_waitcnt lgkmcnt(0)" ::: "memory"); SBAR();
#define PK(L, H) (bf16x8){L[0], L[1], L[2], L[3], H[0], H[1], H[2], H[3]}
  od = __builtin_amdgcn_mfma_f32_32x32x16_bf16(pa0, PK(l0, h0), od, 0, 0, 0);
  od = __builtin_amdgcn_mfma_f32_32x32x16_bf16(pa1, PK(l1, h1), od, 0, 0, 0);
  od = __builtin_amdgcn_mfma_f32_32x32x16_bf16(pa2, PK(l2, h2), od, 0, 0, 0);
  od = __builtin_amdgcn_mfma_f32_32x32x16_bf16(pa3, PK(l3, h3), od, 0, 0, 0);
#undef PK
}
__device__ __forceinline__ void pv_d0(f32x16* o, int vb, bf16x8 pa0, bf16x8 pa1, bf16x8 pa2, bf16x8 pa3) {
  pv_one<0>(o[0], vb, pa0, pa1, pa2, pa3); pv_one<1>(o[1], vb, pa0, pa1, pa2, pa3); pv_one<2>(o[2], vb, pa0, pa1, pa2, pa3); pv_one<3>(o[3], vb, pa0, pa1, pa2, pa3);
}
__device__ __forceinline__ float bf2f(unsigned short u) { return __uint_as_float((unsigned)u << 16); }
__device__ __forceinline__ unsigned short f2bf(float f) { unsigned u = __float_as_uint(f); return (unsigned short)((u + 0x7fffu + ((u >> 16) & 1u)) >> 16); }

__device__ __forceinline__ void diff_unit(const bf16r* __restrict__ Qb, const bf16r* __restrict__ Kh, const bf16r* __restrict__ Vh, const bf16r* __restrict__ Gb,
                                          bf16r* __restrict__ Ob, float lam, const float* __restrict__ nw, float nwscale, char* lds) {
  int tid_ = threadIdx.x; asm volatile("" : "+v"(tid_));
  const int tid = tid_, wid = tid >> 6, lane = tid & 63, r32 = lane & 31, hi = lane >> 5;
  const int mp = wid >> 2, rg = wid & 3;
  char* V_lds = lds; char* K_lds = lds + 2 * SHM_V;
  float* ws = (float*)(lds + 2 * SHM_V + 2 * SHM_K) + wid * 64; float* li_l = ws; float* al_l = ws + 32;
  float m_reg = -1e30f, l_reg = 0; f32x16 o[4] = {}; bf16x8 qr[4];
  const bf16r* Qw = Qb + (long)(rg * QBLK + r32) * LDP + mp * 64 + hi * 8;
#pragma unroll
  for (int d0 = 0; d0 < 4; ++d0) qr[d0] = *reinterpret_cast<const bf16x8*>(Qw + d0 * 16);
  const int colb0 = mp * 128;
  const int sr = tid >> 4, sc = (tid & 15) * 8, vst0 = v_st(sr, sc), vst1 = v_st(32 + sr, sc);
  const int vb0 = (int)(uintptr_t)V_lds + v_rd_base(lane);
  struct { bf16x8 vs0, vs1, ks0, ks1; } sr_[2];
#define SLOAD(i, k0) do { sr_[i].vs0 = *reinterpret_cast<const bf16x8*>(&Vh[(long)((k0) + sr) * LDP + sc]); sr_[i].vs1 = *reinterpret_cast<const bf16x8*>(&Vh[(long)((k0) + 32 + sr) * LDP + sc]); \
    sr_[i].ks0 = *reinterpret_cast<const bf16x8*>(&Kh[(long)((k0) + sr) * LDP + sc]); sr_[i].ks1 = *reinterpret_cast<const bf16x8*>(&Kh[(long)((k0) + 32 + sr) * LDP + sc]); } while (0)
#define SWRITE(b, i) do { *(bf16x8*)(V_lds + (b) * SHM_V + vst0) = sr_[i].vs0;          \
    *(bf16x8*)(V_lds + (b) * SHM_V + vst1) = sr_[i].vs1; int kc = sc * 2;               \
    *(bf16x8*)(K_lds + (b) * SHM_K + KSWZ(sr, kc)) = sr_[i].ks0;                       \
    *(bf16x8*)(K_lds + (b) * SHM_K + KSWZ(32 + sr, kc)) = sr_[i].ks1; } while (0)
#define SWAIT() asm volatile("s_waitcnt vmcnt(4)" ::: "memory")
#define RESC(a) do { if (__any((a) < 1.f)) { if (hi == 0) al_l[r32] = (a); asm volatile("s_waitcnt lgkmcnt(0)" ::: "memory"); \
    _Pragma("unroll") for (int d = 0; d < 4; ++d) _Pragma("unroll") for (int r = 0; r < 16; ++r) o[d][r] *= al_l[crow(r, hi)]; } } while (0)
  f32x16 pA0, pA1, pB0, pB1; float mnA, mnB, alA, alB; bf16x8 pa0, pa1, pa2, pa3; const int NT = SEQ / KVBLK;
  constexpr int SE = 0, SO = 1;
  SLOAD(SE, 0); asm volatile("s_waitcnt vmcnt(0)" ::: "memory"); SWRITE(0, SE); __syncthreads();
  qkt(pA0, pA1, K_lds, qr, r32, hi, colb0); partialSM(pA0, pA1, m_reg, mnA, alA);
  SLOAD(SO, KVBLK); SLOAD(SE, 2 * KVBLK);
  SWAIT(); SWRITE(1, SO); __syncthreads();
  for (int j = 1; j + 1 < NT; j += 2) {
    SBAR(); qkt(pB0, pB1, K_lds + SHM_K, qr, r32, hi, colb0);
    finishSM(pA0, pA1, alA, l_reg, pa0, pa1, pa2, pa3); SBAR();
    SLOAD(SO, (j + 2) * KVBLK); SBAR();
    pv_d0(o, vb0, pa0, pa1, pa2, pa3); partialSM(pB0, pB1, m_reg, mnB, alB);
    __syncthreads(); SWAIT(); SWRITE(0, SE);
    RESC(alB); __syncthreads();
    SBAR(); qkt(pA0, pA1, K_lds, qr, r32, hi, colb0);
    finishSM(pB0, pB1, alB, l_reg, pa0, pa1, pa2, pa3); SBAR();
    if (j + 3 < NT) SLOAD(SE, (j + 3) * KVBLK); SBAR();
    pv_d0(o, vb0 + (int)SHM_V, pa0, pa1, pa2, pa3); partialSM(pA0, pA1, m_reg, mnA, alA);
    __syncthreads(); SWAIT(); SWRITE(1, SO);
    RESC(alA); __syncthreads();
  }
  SBAR(); qkt(pB0, pB1, K_lds + SHM_K, qr, r32, hi, colb0);
  finishSM(pA0, pA1, alA, l_reg, pa0, pa1, pa2, pa3); SBAR();
  pv_d0(o, vb0, pa0, pa1, pa2, pa3); partialSM(pB0, pB1, m_reg, mnB, alB);
  __syncthreads(); RESC(alB);
  finishSM(pB0, pB1, alB, l_reg, pa0, pa1, pa2, pa3); SBAR();
  pv_d0(o, vb0 + (int)SHM_V, pa0, pa1, pa2, pa3);
  if (hi == 0) li_l[r32] = l_reg; asm volatile("s_waitcnt lgkmcnt(0)" ::: "memory");
  float rli[16];
#pragma unroll
  for (int r = 0; r < 16; ++r) rli[r] = __builtin_amdgcn_rcpf(li_l[crow(r, hi)]);
  __syncthreads();
  float* X = (float*)lds + rg * (16 * 4 * 64);
  float* Y = (float*)(lds + 67584);
  if (mp == 1) {
#pragma unroll
    for (int r = 0; r < 16; ++r)
#pragma unroll
      for (int d0 = 0; d0 < 4; ++d0) X[(r * 4 + d0) * 64 + lane] = o[d0][r] * rli[r];
  }
  __syncthreads();
  if (mp == 0) {
#pragma unroll
    for (int r = 0; r < 16; ++r)
#pragma unroll
      for (int d0 = 0; d0 < 4; ++d0) Y[(rg * QBLK + crow(r, hi)) * 128 + d0 * 32 + r32] = o[d0][r] * rli[r] - lam * X[(r * 4 + d0) * 64 + lane];
  }
  __syncthreads();
  { typedef float f32x4e __attribute__((ext_vector_type(4)));
    const int c0 = (lane & 15) * 8;
    const f32x4e w0 = *(const f32x4e*)(nw + c0) * nwscale, w1 = *(const f32x4e*)(nw + c0 + 4) * nwscale;
#pragma unroll 1
    for (int it = 0; it < 4; ++it) { const int row = wid * 16 + it * 4 + (lane >> 4);
      const f32x4e a0 = *(const f32x4e*)(Y + row * 128 + c0), a1 = *(const f32x4e*)(Y + row * 128 + c0 + 4);
      float s = (a0[0] * a0[0] + a0[1] * a0[1]) + (a0[2] * a0[2] + a0[3] * a0[3]) + (a1[0] * a1[0] + a1[1] * a1[1]) + (a1[2] * a1[2] + a1[3] * a1[3]);
      s += __shfl_xor(s, 1); s += __shfl_xor(s, 2); s += __shfl_xor(s, 4); s += __shfl_xor(s, 8);
      const float rs = 1.f / sqrtf(s * (1.f / 128.f) + 1e-6f);
      const u32x4 gq = *reinterpret_cast<const u32x4*>(Gb + (long)row * LDP + c0);
      float gv[8];
#pragma unroll
      for (int e = 0; e < 4; ++e) { gv[2 * e] = __uint_as_float(gq[e] << 16); gv[2 * e + 1] = __uint_as_float(gq[e] & 0xffff0000u); }
      float ov[8];
#pragma unroll
      for (int e = 0; e < 8; ++e) { const float g = gv[e]; const float sg = g / (1.f + __expf(-g)); const float a = e < 4 ? a0[e] : a1[e - 4]; const float w = e < 4 ? w0[e] : w1[e - 4]; ov[e] = a * rs * w * sg; }
      u32x4 ow; ow[0] = cvtpk(ov[0], ov[1]); ow[1] = cvtpk(ov[2], ov[3]); ow[2] = cvtpk(ov[4], ov[5]); ow[3] = cvtpk(ov[6], ov[7]);
      *reinterpret_cast<u32x4*>(Ob + (long)row * 1024 + c0) = ow; }
  }
  __syncthreads();
#undef SLOAD
#undef SWRITE
#undef SWAIT
#undef RESC
}
#undef KSWZ
#undef SBAR
}
#define GAS __attribute__((address_space(1)))
#define LAS __attribute__((address_space(3)))
typedef unsigned short bf16;
typedef unsigned v4u __attribute__((ext_vector_type(4)));
typedef float f32x4 __attribute__((ext_vector_type(4)));
typedef short bf16x8 __attribute__((ext_vector_type(8)));
constexpr int NWAVES = 8;
constexpr int BATCH = 16, SEQ = 2048, DM = 1024, DEPTH = 4, M = BATCH * SEQ;
constexpr int IN_W = 4128, NP = 4096, NPA = 4128;
constexpr float EPS = 1e-6f;
constexpr int PQ_GQ = 0, PQ_GK = 128, PQ_GV = 256, PQ_GG = 512, PQ_DQ = 768, PQ_DK = 1280, PQ_DV = 1792, PQ_DG = 2304, PQ_HQ = 2816, PQ_HZF = 3072, PQ_HZB = 3328, PQ_HI = 3584, PQ_HG = 3840;
constexpr size_t MiB = 1u << 20;
constexpr size_t WS_CTL = 0;
constexpr size_t WS_WIN = 1 * MiB;
constexpr size_t WS_WOUT = 34 * MiB;
constexpr size_t WS_ROPE = 42 * MiB;
constexpr size_t WS_A = 43 * MiB;
constexpr size_t WS_H = 48 * MiB;
constexpr size_t WS_MIX = 112 * MiB;
constexpr size_t WS_PROJ = 176 * MiB;
constexpr size_t WS_Y = WS_PROJ;
constexpr size_t WS_OSC = 432 * MiB;
constexpr size_t WS_END = 496 * MiB;
static_assert(WS_WIN + (size_t)DEPTH * NPA * DM * 2 <= WS_WOUT && WS_OSC + (size_t)2 * M * 512 * 2 <= WS_END, "ws map");
constexpr int LDS_BYTES = 147456;

__device__ __forceinline__ float bf2f(unsigned short u) { return __uint_as_float((unsigned)u << 16); }
__device__ __forceinline__ unsigned f2bf(float f) { unsigned u = __float_as_uint(f); return (u + 0x7fffu + ((u >> 16) & 1u)) >> 16; }
__device__ __forceinline__ unsigned pk2(float lo, float hi) { return f2bf(lo) | (f2bf(hi) << 16); }
__device__ __forceinline__ float wave_sum(float v) {
#pragma unroll
    for (int o = 1; o < 64; o <<= 1) v += __shfl_xor(v, o);
    return v;
}
#define LDS_WAIT() asm volatile("s_waitcnt lgkmcnt(0)" ::: "memory")
#define VM_WAIT() asm volatile("s_waitcnt vmcnt(0)" ::: "memory")

struct Args {
    const float* x; const float* norm_pre; const float* norm_post; const float* w_in; const float* w_out;
    const float* gla_wa2_f; const float* gla_ba_f; const float* gla_wa2_b; const float* gla_ba_b; const float* gla_norm;
    const float* lq1; const float* lk1; const float* lq2; const float* lk2; const float* diff_norm; const float* lb_logits; const float* hgrn_norm;
    float* out; unsigned char* ws; int ph_lo, ph_hi;
};
struct Frame { LAS unsigned char* lds; int tid, lane, wave, vcu, G; };

__device__ __forceinline__ int src_col(int p) {
    if (p >= NP) return 768 + (p - NP);
    if (p < 768) return p;
    if (p < 1792) { const int base = p & ~63, e = p & 63, j8 = e >> 3, e8 = e & 7; const int d = (e8 < 4) ? 4 * j8 + e8 : 32 + 4 * j8 + (e8 - 4); return base + d + 32; }
    return p + 32;
}
__device__ __forceinline__ void transpose_item(const float* W, int srcN, bool remap, bf16* WT, LAS float* scr, int kb, int nb, int lane) {
    const int k0 = 64 * kb, n0 = 32 * nb; const int sc = remap ? src_col(n0 + (lane & 31)) : n0 + (lane & 31);
#pragma unroll 8
    for (int i = 0; i < 32; ++i) { const int kk = 2 * i + (lane >> 5); scr[kk * 33 + (lane & 31)] = W[(size_t)(k0 + kk) * srcN + sc]; }
    LDS_WAIT(); asm volatile("" ::: "memory");
    const int c = lane & 7;
#pragma unroll
    for (int j = 0; j < 4; ++j) { const int n = (lane >> 3) + 8 * j; const LAS float* s = scr + (8 * c) * 33 + n;
        v4u o; o.x = pk2(s[0 * 33], s[1 * 33]); o.y = pk2(s[2 * 33], s[3 * 33]); o.z = pk2(s[4 * 33], s[5 * 33]); o.w = pk2(s[6 * 33], s[7 * 33]);
        *(GAS v4u*)(WT + (size_t)(n0 + n) * DM + k0 + 8 * c) = o; }
    LDS_WAIT(); asm volatile("" ::: "memory");
}
__device__ __forceinline__ void rms_row_to_bf16(const f32x4 (&v)[4], const float* w, bf16* orow, int lane) {
    float s = 0.f;
#pragma unroll
    for (int j = 0; j < 4; ++j) s += (v[j].x * v[j].x + v[j].y * v[j].y) + (v[j].z * v[j].z + v[j].w * v[j].w);
    const float r = 1.f / sqrtf(wave_sum(s) * (1.f / DM) + EPS);
    GAS unsigned long long* o8 = (GAS unsigned long long*)orow + lane;
#pragma unroll
    for (int j = 0; j < 4; ++j) { const f32x4 ww = *((const f32x4*)w + lane + 64 * j);
        o8[64 * j] = (unsigned long long)pk2(v[j].x * r * ww.x, v[j].y * r * ww.y) | ((unsigned long long)pk2(v[j].z * r * ww.z, v[j].w * r * ww.w) << 32); }
}

__device__ __forceinline__ void p0_prologue(const Frame& F, const Args& a) {
    LAS float* scr = (LAS float*)(F.lds + F.wave * 16384);
    const int gw = F.vcu * NWAVES + F.wave, NGW = F.G * NWAVES;
    bf16* WinT = (bf16*)(a.ws + WS_WIN); bf16* WoutT = (bf16*)(a.ws + WS_WOUT);
    constexpr int I_IN = 16 * (NPA / 32), I_OUT = 16 * 32;
    constexpr int NITEMS = DEPTH * (I_IN + I_OUT);
    for (int it = gw; it < NITEMS; it += NGW) {
        const int l = it / (I_IN + I_OUT); int r = it % (I_IN + I_OUT);
        if (r < I_IN) transpose_item(a.w_in + (size_t)l * DM * IN_W, IN_W, true, WinT + (size_t)l * NPA * DM, scr, r / (NPA / 32), r % (NPA / 32), F.lane);
        else { r -= I_IN; transpose_item(a.w_out + (size_t)l * DM * DM, DM, false, WoutT + (size_t)l * DM * DM, scr, r / 32, r % 32, F.lane); }
    }
    float* cosT = (float*)(a.ws + WS_ROPE); float* sinT = cosT + SEQ * 32;
    for (int e = gw * 64 + F.lane; e < SEQ * 32; e += NGW * 64) { const int pos = e >> 5, i = e & 31;
        const float inv = __builtin_amdgcn_exp2f(-(float)i * (13.287712379549449f / 32.f));
        const float ang = (float)pos * inv; float rev = ang * 0.15915494309189535f; rev = rev - floorf(rev);
        cosT[e] = __builtin_amdgcn_cosf(rev); sinT[e] = __builtin_amdgcn_sinf(rev); }
    bf16* H = (bf16*)(a.ws + WS_H);
    for (int m = gw; m < M; m += NGW) { const GAS f32x4* xr = (const GAS f32x4*)(a.x + (size_t)m * DM) + F.lane; f32x4 v[4];
#pragma unroll
        for (int j = 0; j < 4; ++j) v[j] = xr[64 * j];
        rms_row_to_bf16(v, a.norm_pre, H + (size_t)m * DM, F.lane); }
}

__device__ __forceinline__ void lowrank_phase(const Frame& F, const Args& a, int layer) {
    typedef float f32x4v __attribute__((ext_vector_type(4)));
    const bf16* H = (const bf16*)(a.ws + WS_H); const bf16* Wa = (const bf16*)(a.ws + WS_WIN) + ((size_t)layer * NPA + NP) * DM; float* A = (float*)(a.ws + WS_A);
    const int gw = F.vcu * NWAVES + F.wave, NGW = F.G * NWAVES, lane = F.lane;
    for (int u = gw; u < M / 16; u += NGW) {
        const bf16* ap = H + (size_t)(u * 16 + (lane & 15)) * DM + 8 * (lane >> 4);
        const bf16* b0 = Wa + (size_t)(lane & 15) * DM + 8 * (lane >> 4); const bf16* b1 = b0 + 16 * DM;
        f32x4v c0 = {0.f, 0.f, 0.f, 0.f}, c1 = {0.f, 0.f, 0.f, 0.f};
#pragma unroll 8
        for (int ks = 0; ks < 32; ++ks) { const bf16x8 av = *(const bf16x8*)(ap + ks * 32), bv0 = *(const bf16x8*)(b0 + ks * 32), bv1 = *(const bf16x8*)(b1 + ks * 32);
            c0 = __builtin_amdgcn_mfma_f32_16x16x32_bf16(av, bv0, c0, 0, 0, 0); c1 = __builtin_amdgcn_mfma_f32_16x16x32_bf16(av, bv1, c1, 0, 0, 0); }
#pragma unroll
        for (int r = 0; r < 4; ++r) { float* o = A + (size_t)(u * 16 + 4 * (lane >> 4) + r) * 32 + (lane & 15); o[0] = c0[r]; o[16] = c1[r]; }
    }
}

__device__ __forceinline__ void postnorm_phase(const Frame& F, const Args& a, int layer) {
    const float* Y = (const float*)(a.ws + WS_Y); bf16* H = (bf16*)(a.ws + WS_H);
    const float* xin = layer == 0 ? a.x : a.out; const float* wpost = a.norm_post + layer * DM;
    const int gw = F.vcu * NWAVES + F.wave, NGW = F.G * NWAVES, lane = F.lane;
    for (int m = gw; m < M; m += NGW) {
        const GAS f32x4* yr = (const GAS f32x4*)(Y + (size_t)m * DM) + lane; const GAS f32x4* xr = (const GAS f32x4*)(xin + (size_t)m * DM) + lane;
        f32x4 y[4], x[4]; float s = 0.f;
#pragma unroll
        for (int j = 0; j < 4; ++j) { y[j] = yr[64 * j]; x[j] = xr[64 * j]; s += (y[j].x * y[j].x + y[j].y * y[j].y) + (y[j].z * y[j].z + y[j].w * y[j].w); }
        const float r = 1.f / sqrtf(wave_sum(s) * (1.f / DM) + EPS);
        GAS f32x4* orow = (GAS f32x4*)(a.out + (size_t)m * DM) + lane;
#pragma unroll
        for (int j = 0; j < 4; ++j) { const f32x4 ww = *((const f32x4*)wpost + lane + 64 * j); x[j] = x[j] + y[j] * r * ww; orow[64 * j] = x[j]; }
        if (layer + 1 < DEPTH) rms_row_to_bf16(x, a.norm_pre + (layer + 1) * DM, H + (size_t)m * DM, lane);
    }
}
template <int DK, bool HG>
__device__ __forceinline__ void chain_simple(const Frame& F, const Args& a, int layer, int b, int h, int dir, LAS float* lw) {
    const bf16* P = (const bf16*)(a.ws + WS_PROJ); const float* A = (const float*)(a.ws + WS_A);
    bf16* osc = (bf16*)(a.ws + WS_OSC) + (size_t)dir * M * 512;
    const int lane = F.lane;
    LAS float* Gs = lw; LAS float* Ks = lw + 16 * 64; LAS float* Qs = lw + 32 * 64;
    const int qcol = HG ? PQ_HQ + h * 64 : PQ_GQ + h * 32, kcol = HG ? (dir ? PQ_HZB : PQ_HZF) + h * 64 : PQ_GK + h * 32, vcol = HG ? PQ_HI + h * 64 : PQ_GV + h * 64;
    const int ocol = (HG ? 256 : 0) + h * 64;
    float lb = 0.f, wa[16], ba = 0.f;
    const int kc = lane & (DK - 1);
    if (HG) {
        float lg[DEPTH], mx = -1e30f;
#pragma unroll
        for (int l = 0; l < DEPTH; ++l) { lg[l] = a.lb_logits[l * 256 + h * 64 + kc]; mx = fmaxf(mx, lg[l]); }
        float sum = 0.f;
#pragma unroll
        for (int l = 0; l < DEPTH; ++l) { lg[l] = __expf(lg[l] - mx); sum += lg[l]; }
        float cum = 0.f;
#pragma unroll
        for (int l = 1; l < DEPTH; ++l) { if (l <= layer) cum += lg[l] / sum; }
        lb = cum;
#pragma unroll
        for (int i = 0; i < 16; ++i) wa[i] = 0.f;
    } else {
        const float* w2 = (dir ? a.gla_wa2_b : a.gla_wa2_f) + (size_t)layer * 16 * 128 + h * 32 + kc;
#pragma unroll
        for (int i = 0; i < 16; ++i) wa[i] = w2[i * 128];
        ba = (dir ? a.gla_ba_b : a.gla_ba_f)[layer * 128 + h * 32 + kc];
    }
    float S[DK];
#pragma unroll
    for (int k = 0; k < DK; ++k) S[k] = 0.f;
    for (int bt = 0; bt < SEQ / 16; ++bt) {
        float vv[16];
#pragma unroll
        for (int i = 0; i < 16; ++i) {
            const int t = dir ? (SEQ - 1 - (bt * 16 + i)) : (bt * 16 + i); const size_t row = (size_t)b * SEQ + t;
            vv[i] = bf2f(P[row * NP + vcol + lane]);
            float g, kk, q;
            if (HG) {
                const float z = bf2f(P[row * NP + kcol + kc]); q = bf2f(P[row * NP + qcol + kc]);
                const float e = __expf(-fabsf(z)), r = 1.f / (1.f + e); const float sp = r, sn = e * r;
                const float sig = z >= 0.f ? sp : sn, sneg = z >= 0.f ? sn : sp;
                g = lb + (1.f - lb) * sig; kk = (1.f - lb) * sneg;
            } else {
                const float* ar = A + row * 32 + dir * 16; float z = ba;
#pragma unroll
                for (int j = 0; j < 16; ++j) z += ar[j] * wa[j];
                const float ls = fminf(z, 0.f) - log1pf(__expf(-fabsf(z)));
                g = __expf(ls * (1.f / 16.f)); kk = bf2f(P[row * NP + kcol + kc]); q = bf2f(P[row * NP + qcol + kc]) * 0.17677669529663687f;
            }
            if (lane < DK) { Gs[i * 64 + lane] = g; Ks[i * 64 + lane] = kk; Qs[i * 64 + lane] = q; }
        }
        LDS_WAIT(); asm volatile("" ::: "memory");
#pragma unroll 1
        for (int i = 0; i < 16; ++i) {
            const int t = dir ? (SEQ - 1 - (bt * 16 + i)) : (bt * 16 + i); const size_t row = (size_t)b * SEQ + t;
            float v = 0.f;
#pragma unroll
            for (int ii = 0; ii < 16; ++ii) v = (ii == i) ? vv[ii] : v;
            float o = 0.f;
#pragma unroll
            for (int k4 = 0; k4 < DK / 4; ++k4) {
                const f32x4 g4 = *(const LAS f32x4*)(Gs + i * 64 + 4 * k4), k4v = *(const LAS f32x4*)(Ks + i * 64 + 4 * k4), q4 = *(const LAS f32x4*)(Qs + i * 64 + 4 * k4);
#pragma unroll
                for (int j = 0; j < 4; ++j) { float s = S[4 * k4 + j] * g4[j]; s = fmaf(k4v[j], v, s); S[4 * k4 + j] = s; o = fmaf(q4[j], s, o); }
            }
            osc[row * 512 + ocol + lane] = (bf16)f2bf(o);
        }
        LDS_WAIT(); asm volatile("" ::: "memory");
    }
}
template <bool HG>
__device__ __forceinline__ void scan_finalize(const Frame& F, const Args& a, int layer, int b, int h) {
    const bf16* P = (const bf16*)(a.ws + WS_PROJ); const bf16* of = (const bf16*)(a.ws + WS_OSC); const bf16* ob = of + (size_t)M * 512; bf16* MX = (bf16*)(a.ws + WS_MIX);
    const int lane = F.lane, ocol = (HG ? 256 : 0) + h * 64, gcol = (HG ? PQ_HG : PQ_GG) + h * 64, mcol = (HG ? 768 : 0) + h * 64;
    const float w = (HG ? a.hgrn_norm : a.gla_norm)[layer * 64 + lane];
    for (int t = F.wave; t < SEQ; t += NWAVES) { const size_t row = (size_t)b * SEQ + t;
        const float o = bf2f(of[row * 512 + ocol + lane]) + bf2f(ob[row * 512 + ocol + lane]);
        const float r = 1.f / sqrtf(wave_sum(o * o) * (1.f / 64.f) + EPS);
        const float g = bf2f(P[row * NP + gcol + lane]); const float sg = g / (1.f + __expf(-g));
        MX[row * DM + mcol + lane] = (bf16)f2bf(o * r * w * sg); }
}
__device__ __forceinline__ void scan_phase_simple(const Frame& F, const Args& a, int layer) {
    LAS float* lw = (LAS float*)(F.lds + F.wave * 16384);
    const int step = (F.G >= 2) ? (F.G >> 1) : 1;
    for (int p = (F.vcu & 1) ? 128 : (F.vcu >> 1); p < 128; p += step) {
        const int type = p >> 6, b = (p & 63) >> 2, h = p & 3;
        if (F.wave < 2) { if (type) chain_simple<64, true>(F, a, layer, b, h, F.wave, lw); else chain_simple<32, false>(F, a, layer, b, h, F.wave, lw); }
        VM_WAIT(); __syncthreads();
        __builtin_amdgcn_fence(__ATOMIC_ACQUIRE, "agent"); VM_WAIT();
        if (type) scan_finalize<true>(F, a, layer, b, h); else scan_finalize<false>(F, a, layer, b, h);
        __syncthreads();
    }
}
__device__ __forceinline__ void attn_phase(const Frame& F, const Args& a, int layer) {
    const bf16* P = (const bf16*)(a.ws + WS_PROJ); bf16* MX = (bf16*)(a.ws + WS_MIX);
    const float linit = 0.8f - 0.6f * expf(-0.3f * (float)layer);
    const float d1 = wave_sum(a.lq1[layer * 64 + F.lane] * a.lk1[layer * 64 + F.lane]), d2 = wave_sum(a.lq2[layer * 64 + F.lane] * a.lk2[layer * 64 + F.lane]);
    const float lam = expf(d1) - expf(d2) + linit;
    const int NU = BATCH * 4 * (SEQ / 128), per = (NU + F.G - 1) / F.G;
    for (int i = 0; i < per; ++i) { const int u = F.vcu * per + i; if (u >= NU) break;
        const int bh = u >> 4, qb = u & 15, b = bh >> 2, h = bh & 3; const size_t row0 = (size_t)b * SEQ + qb * 128;
        dattn::diff_unit(P + row0 * NP + PQ_DQ + h * 128, P + (size_t)b * SEQ * NP + PQ_DK + h * 128, P + (size_t)b * SEQ * NP + PQ_DV + h * 128,
                         P + row0 * NP + PQ_DG + h * 128, MX + row0 * DM + 256 + h * 128, lam, a.diff_norm + layer * 128, 1.f - linit, (char*)F.lds); }
}

__global__ void __launch_bounds__(NWAVES * 64, 2) fwd_mega(Args args) {
    extern __shared__ __attribute__((aligned(16))) unsigned char lds[];
    cg::grid_group grid = cg::this_grid();
#define MKFRAME() Frame F; { int t_ = threadIdx.x; asm volatile("" : "+v"(t_)); F.lds = (LAS unsigned char*)lds; F.tid = t_; F.lane = t_ & 63; F.wave = __builtin_amdgcn_readfirstlane(t_ >> 6); \
    F.G = gridDim.x; const int bx = blockIdx.x; F.vcu = (F.G % 8 == 0) ? (bx % 8) * (F.G / 8) + bx / 8 : bx; }
    const int lo = args.ph_lo, hi = args.ph_hi;
#define IN(k) (lo <= (k) && (k) < hi)
#define SEAM(k) do { if (IN(k) && IN((k) + 1)) grid.sync(); } while (0)
#ifndef NO_P0
    if (IN(0)) { MKFRAME(); p0_prologue(F, args); }
#endif
    SEAM(0);
    for (int layer = 0; layer < DEPTH; ++layer) {
        const int pb = 1 + 4 * layer;
        if (IN(pb)) {
            MKFRAME();
            pg8::Gemm g{(const pg8::bf16_t*)(args.ws + WS_H), (const pg8::bf16_t*)(args.ws + WS_WIN) + (size_t)layer * NPA * DM, M, NP, DM};
            pg8::StaticOrder S; S.init(M, NP, F.G, (int)blockIdx.x);
            pg8::EpiProj E{(pg8::bf16_t*)(args.ws + WS_PROJ), (const float*)(args.ws + WS_ROPE), (const float*)(args.ws + WS_ROPE) + SEQ * 32};
#ifndef NO_GA
            pg8::gemm_phase<pg8::EpiProj, pg8::StaticOrder, true, true>(F.lds, g, S, E);
#endif
#ifndef NO_LR
            lowrank_phase(F, args, layer);
#endif
        }
        SEAM(pb);
        if (IN(pb + 1)) {
#ifndef NO_SCAN
            { MKFRAME(); scan_phase_simple(F, args, layer); }
#endif
#ifndef NO_ATTN
            { MKFRAME(); attn_phase(F, args, layer); }
#endif
        }
        SEAM(pb + 1);
        if (IN(pb + 2)) {
            MKFRAME();
            pg8::Gemm g{(const pg8::bf16_t*)(args.ws + WS_MIX), (const pg8::bf16_t*)(args.ws + WS_WOUT) + (size_t)layer * DM * DM, M, DM, DM};
            pg8::StaticOrder S; S.init(M, DM, F.G, (int)blockIdx.x);
            pg8::EpiF32 E{(float*)(args.ws + WS_Y), DM, nullptr};
#ifndef NO_GC
            pg8::gemm_phase<pg8::EpiF32, pg8::StaticOrder, true, true>(F.lds, g, S, E);
#endif
        }
        SEAM(pb + 2);
#ifndef NO_PD
        if (IN(pb + 3)) { MKFRAME(); postnorm_phase(F, args, layer); }
#endif
        if (layer + 1 < DEPTH) SEAM(pb + 3);
    }
#undef IN
#undef SEAM
}
constexpr int N_PHASES = 1 + 4 * DEPTH;

extern "C" void kernel_launch(void* const* d_in, const int* in_sizes, int n_in, void* d_out, int out_size, void* d_ws, size_t ws_size, hipStream_t stream) {
    static int grid = 0;
    if (grid == 0) {
        if (n_in != 17 || in_sizes[0] != M * DM || out_size != M * DM || ws_size < WS_END) {
            fprintf(stderr, "kernel_launch: shape mismatch n_in %d in0 %d out %d ws %zu (need %zu)\n", n_in, n_in > 0 ? in_sizes[0] : -1, out_size, ws_size, (size_t)WS_END); grid = -1; return; }
        int dev = 0, cus = 0, per_cu = 0;
        if (hipGetDevice(&dev) != hipSuccess || hipDeviceGetAttribute(&cus, hipDeviceAttributeMultiprocessorCount, dev) != hipSuccess) { grid = -1; return; }
        if (hipFuncSetAttribute((const void*)fwd_mega, hipFuncAttributeMaxDynamicSharedMemorySize, LDS_BYTES) != hipSuccess) { fprintf(stderr, "kernel_launch: hipFuncSetAttribute failed\n"); grid = -1; return; }
        if (hipOccupancyMaxActiveBlocksPerMultiprocessor(&per_cu, (const void*)fwd_mega, NWAVES * 64, LDS_BYTES) != hipSuccess || per_cu < 1) { fprintf(stderr, "kernel_launch: occupancy query says %d\n", per_cu); (void)hipGetLastError(); grid = -1; return; }
        grid = cus;
        fprintf(stderr, "kernel_launch: cus %d per_cu %d grid %d ws %zu\n", cus, per_cu, grid, ws_size);
    }
    if (grid < 0) return;
    Args a{};
    a.x = (const float*)d_in[0]; a.norm_pre = (const float*)d_in[1]; a.norm_post = (const float*)d_in[2]; a.w_in = (const float*)d_in[3]; a.w_out = (const float*)d_in[4];
    a.gla_wa2_f = (const float*)d_in[5]; a.gla_ba_f = (const float*)d_in[6]; a.gla_wa2_b = (const float*)d_in[7]; a.gla_ba_b = (const float*)d_in[8]; a.gla_norm = (const float*)d_in[9];
    a.lq1 = (const float*)d_in[10]; a.lk1 = (const float*)d_in[11]; a.lq2 = (const float*)d_in[12]; a.lk2 = (const float*)d_in[13]; a.diff_norm = (const float*)d_in[14];
    a.lb_logits = (const float*)d_in[15]; a.hgrn_norm = (const float*)d_in[16];
    a.out = (float*)d_out; a.ws = (unsigned char*)d_ws; a.ph_lo = 0; a.ph_hi = N_PHASES;
    void* kargs[] = {&a};
    const hipError_t e = hipLaunchCooperativeKernel((const void*)fwd_mega, dim3(grid), dim3(NWAVES * 64), kargs, LDS_BYTES, stream);
    if (e != hipSuccess) fprintf(stderr, "kernel_launch: cooperative launch failed: %s (grid %d)\n", hipGetErrorString(e), grid);
}
```

```cpp
#include <hip/hip_runtime.h>
#include <hip/hip_cooperative_groups.h>
#include <hip/hip_bf16.h>
#include <cstdio>
#include <cstdint>
#include <cmath>
namespace cg = cooperative_groups;
__device__ __forceinline__ int lane_id_opaque() { int x; asm volatile("v_mbcnt_lo_u32_b32 %0, -1, 0\n\tv_mbcnt_hi_u32_b32 %0, -1, %0" : "=v"(x)); return x; }
template <int MASK> __device__ __forceinline__ float xor_shfl(float v) {
    if constexpr (MASK == 32) { auto rr = __builtin_amdgcn_permlane32_swap(__float_as_uint(v), __float_as_uint(v), false, false);
        return __uint_as_float(rr[0] ^ rr[1] ^ __float_as_uint(v)); }
    else return __int_as_float(__builtin_amdgcn_ds_swizzle(__float_as_int(v), (MASK << 10) | 0x1f));
}
namespace pg8 {
#define PG8_LAS __attribute__((address_space(3)))
typedef unsigned short bf16_t;
typedef short bf16x8 __attribute__((ext_vector_type(8)));
typedef float f32x4 __attribute__((ext_vector_type(4)));
typedef unsigned u32x4 __attribute__((ext_vector_type(4)));
constexpr int BM = 256, BK = 64, HALF = 128, HTB = HALF * BK * 2  , STAGE_BYTES = 8 * HTB, NXCD = 8, WGM = 8;

__host__ __device__ __forceinline__ int lds_byte(int r, int c) { const int st = (r >> 4) * 2 + (c >> 5), rr = r & 15, cc = c & 31, ob = rr * 64 + cc * 2; return st * 1024 + (ob ^ (((ob >> 9) & 1) << 5)); }
__host__ __device__ __forceinline__ void stage_rc(int b, int& R, int& C) { const int st = b / 1024, sb = b % 1024, swz = sb ^ (((sb >> 9) & 1) << 5); R = (st >> 1) * 16 + swz / 64; C = (st & 1) * 32 + (swz % 64) / 2; }
__host__ __device__ __forceinline__ int perm32(int rho) { const int n = rho >> 4, i = rho & 15; return 8 * (i >> 2) + 4 * n + (i & 3); }

struct Unit { int pm, pn; };
struct Gemm { const bf16_t* A; const bf16_t* Bt; int M, N, K; };

struct StaticOrder {
    int nM, nN, nwg, G, c;
    __host__ __device__ void init(int M, int N, int G_, int c_) { nM = M / BM; nN = N / BM; nwg = nM * nN; G = G_; c = c_; }
    __host__ __device__ bool next(int i, Unit& u) const {
        const long L = (long)i * G + c; if (L >= nwg) return false;
        int wgid = (int)L; { const int q = nwg / NXCD, r = nwg % NXCD, xcd = wgid % NXCD, off = wgid / NXCD; wgid = (xcd < r ? xcd * (q + 1) : r * (q + 1) + (xcd - r) * q) + off; }
        const int nig = WGM * nN, gid = wgid / nig, fm = gid * WGM, gsz = (nM - fm) < WGM ? (nM - fm) : WGM;
        u.pm = fm + ((wgid % nig) % gsz); u.pn = (wgid % nig) / gsz; return true;
    }
    __device__ __forceinline__ void a_ready(const Unit&) const {}
    __device__ __forceinline__ void done(const Unit&) const {}
};
__device__ __forceinline__ unsigned cvt_pk_bf16(float lo, float hi) { unsigned r; asm volatile("v_cvt_pk_bf16_f32 %0, %1, %2" : "=v"(r) : "v"(lo), "v"(hi)); return r; }
typedef float f32x2 __attribute__((ext_vector_type(2)));
struct EpiF32 {
    static constexpr bool PERM = false, AFTER_DRAIN = false;
    float* C; int ldc; const float* bias;
    __device__ __forceinline__ void operator()(const f32x4 (&acc)[2][2][4][2], const Unit& u, int wr, int wc, int fr, int fq) const {
        const int row0 = u.pm * BM + wr * 64 + fr, col0 = u.pn * BM + wc * 32 + 4 * fq;
        f32x4 bv[2][2];
#pragma unroll
        for (int bj = 0; bj < 2; ++bj)
#pragma unroll
            for (int n = 0; n < 2; ++n) bv[bj][n] = bias ? *(const f32x4*)(bias + col0 + bj * HALF + n * 16) : (f32x4){0.f, 0.f, 0.f, 0.f};
#pragma unroll
        for (int ai = 0; ai < 2; ++ai)
#pragma unroll
            for (int m = 0; m < 4; ++m) { float* rowp = C + (size_t)(row0 + ai * HALF + m * 16) * ldc + col0;
#pragma unroll
                for (int bj = 0; bj < 2; ++bj)
#pragma unroll
                    for (int n = 0; n < 2; ++n) *(f32x4*)(rowp + bj * HALF + n * 16) = acc[ai][bj][m][n] + bv[bj][n]; }
    }
};
struct EpiProj {
    static constexpr bool PERM = true, AFTER_DRAIN = false;
    bf16_t* O; const float* cosT; const float* sinT;
    __device__ __forceinline__ void operator()(const f32x4 (&acc)[2][2][4][2], const Unit& u, int wr, int wc, int fr, int fq) const {
        const int row0 = u.pm * BM + wr * 64 + fr, col0 = u.pn * BM + wc * 32 + 8 * fq;
        const bool rope = (u.pn >= 3 && u.pn <= 6);
        const int j8 = (wc & 1) * 4 + fq;
#pragma unroll
        for (int ai = 0; ai < 2; ++ai)
#pragma unroll
            for (int m = 0; m < 4; ++m) { const int row = row0 + ai * HALF + m * 16; bf16_t* rowp = O + (size_t)row * 4096 + col0;
                f32x4 c4 = (f32x4){1.f, 1.f, 1.f, 1.f}, s4 = (f32x4){0.f, 0.f, 0.f, 0.f};
                if (rope) { const int pos = row & 2047; c4 = *(const f32x4*)(cosT + pos * 32 + 4 * j8); s4 = *(const f32x4*)(sinT + pos * 32 + 4 * j8); }
#pragma unroll
                for (int bj = 0; bj < 2; ++bj) { const f32x4 a0 = acc[ai][bj][m][0], a1 = acc[ai][bj][m][1];
                    const f32x4 v0 = a0 * c4 - a1 * s4, v1 = a1 * c4 + a0 * s4;
                    u32x4 w; w.x = cvt_pk_bf16(v0[0], v0[1]); w.y = cvt_pk_bf16(v0[2], v0[3]); w.z = cvt_pk_bf16(v1[0], v1[1]); w.w = cvt_pk_bf16(v1[2], v1[3]);
                    *(u32x4*)(rowp + bj * HALF) = w; } }
    }
};
template <class Epi, class Sched, bool ALIGN_EPI = false, bool SP2 = false>
__device__ __forceinline__ void gemm_phase(PG8_LAS unsigned char* lds, const Gemm g, const Sched& S, const Epi& E, int wave_s) {
    int tid_ = wave_s * 64 + lane_id_opaque(); asm volatile("" : "+v"(tid_));
    const int tid = tid_, wid = __builtin_amdgcn_readfirstlane(tid >> 6), lane = tid & 63, wr = wid >> 2, wc = wid & 3, fr = lane & 15, fq = lane >> 4;
    const int K = g.K, nt = K / BK;
    unsigned voffA[2], voffB[2];
#pragma unroll
    for (int i = 0; i < 2; ++i) { int R, C; stage_rc(tid * 16 + i * 8192, R, C); const int Rb = Epi::PERM ? ((R & ~31) + perm32(R & 31)) : R;
        voffA[i] = (unsigned)(R * K + C) * 2u; voffB[i] = (unsigned)(Rb * K + C) * 2u; }
    const size_t kstep = (size_t)(BK * 2);
    const size_t hstep = (size_t)HALF * K * 2;
    const size_t tstep = 2 * hstep;
    const unsigned ldsw = (unsigned)wid * 1024u;
    const int aoff = lds_byte(wr * 64 + fr, fq * 8), boff = lds_byte(wc * 32 + fr, fq * 8);
#define PG8_SA(b, h) (((b) * 2 + (h)) * HTB)
#define PG8_SB(b, h) ((4 + (b) * 2 + (h)) * HTB)
#define PG8_STAGE(bufoff, gbase, voff) do { _Pragma("unroll") for (int _i = 0; _i < 2; ++_i) \
        __builtin_amdgcn_global_load_lds((const unsigned*)((const char*)(gbase) + (voff)[_i]), (PG8_LAS unsigned*)(lds + (bufoff) + ldsw + _i * 8192), 16, 0, 0); } while (0)
#define PG8_LDA(dst, b, h) do { _Pragma("unroll") for (int m = 0; m < 4; ++m) _Pragma("unroll") for (int k = 0; k < 2; ++k) dst[m][k] = *(const PG8_LAS bf16x8*)(lds + PG8_SA(b, h) + aoff + m * 2048 + k * 1024); } while (0)
#define PG8_LDB(dst, b, h) do { _Pragma("unroll") for (int n = 0; n < 2; ++n) _Pragma("unroll") for (int k = 0; k < 2; ++k) dst[n][k] = *(const PG8_LAS bf16x8*)(lds + PG8_SB(b, h) + boff + n * 2048 + k * 1024); } while (0)
#define PG8_MMA(ai, bj, At, Bt) do { __builtin_amdgcn_s_setprio(1); _Pragma("unroll") for (int m = 0; m < 4; ++m) _Pragma("unroll") for (int n = 0; n < 2; ++n) _Pragma("unroll") for (int k = 0; k < 2; ++k) \
        acc[ai][bj][m][n] = __builtin_amdgcn_mfma_f32_16x16x32_bf16(Bt[n][k], At[m][k], acc[ai][bj][m][n], 0, 0, 0); __builtin_amdgcn_s_setprio(0); } while (0)
#define PG8_WAIT_V(n) asm volatile("s_waitcnt vmcnt(" #n ")" ::: "memory")
#define PG8_WAIT_L(n) asm volatile("s_waitcnt lgkmcnt(" #n ")" ::: "memory")
#define PG8_BAR __builtin_amdgcn_s_barrier()
#define PG8_SCHED __builtin_amdgcn_sched_barrier(0)
    Unit cur, nxt; int ui = 0;
    if (!S.next(0, cur)) return;
    f32x4 acc[2][2][4][2];
#pragma unroll
    for (int a = 0; a < 2; ++a)
#pragma unroll
        for (int b = 0; b < 2; ++b)
#pragma unroll
            for (int m = 0; m < 4; ++m)
#pragma unroll
                for (int n = 0; n < 2; ++n) acc[a][b][m][n] = (f32x4){0.f, 0.f, 0.f, 0.f};
    bf16x8 At[4][2], B0[2][2], B1[2][2];
    const char* cA = (const char*)g.A + (size_t)cur.pm * tstep; const char* cB = (const char*)g.Bt + (size_t)cur.pn * tstep;
    S.a_ready(cur);
    if constexpr (SP2) {
        PG8_STAGE(PG8_SB(0, 0), cB, voffB); PG8_STAGE(PG8_SB(0, 1), cB + hstep, voffB); PG8_STAGE(PG8_SA(0, 0), cA, voffA); PG8_STAGE(PG8_SA(0, 1), cA + hstep, voffA);
        if (wr == 1) PG8_BAR;
        PG8_WAIT_V(2); PG8_BAR;
        PG8_STAGE(PG8_SB(1, 0), cB + kstep, voffB); PG8_STAGE(PG8_SA(1, 0), cA + kstep, voffA); PG8_STAGE(PG8_SB(1, 1), cB + hstep + kstep, voffB);
        PG8_WAIT_V(6); PG8_BAR;
    } else {
        PG8_STAGE(PG8_SB(0, 0), cB, voffB); PG8_STAGE(PG8_SA(0, 0), cA, voffA); PG8_STAGE(PG8_SB(0, 1), cB + hstep, voffB); PG8_STAGE(PG8_SA(0, 1), cA + hstep, voffA);
        if (wr == 1) PG8_BAR;
        PG8_WAIT_V(4); PG8_BAR;
        PG8_STAGE(PG8_SB(1, 0), cB + kstep, voffB); PG8_STAGE(PG8_SA(1, 0), cA + kstep, voffA); PG8_STAGE(PG8_SB(1, 1), cB + hstep + kstep, voffB);
        PG8_WAIT_V(6); PG8_BAR;
    }
    for (;;) {
        const bool has_next = S.next(ui + 1, nxt);
        const char* nA = has_next ? (const char*)g.A + (size_t)nxt.pm * tstep : cA; const char* nB = has_next ? (const char*)g.Bt + (size_t)nxt.pn * tstep : cB;
        for (int t = 0; t < nt; t += 2) {
            const bool last = (t == nt - 2);
            const char* a1 = cA + (size_t)(t + 1) * kstep;
            const char* a2 = last ? nA : cA + (size_t)(t + 2) * kstep; const char* b2 = last ? nB : cB + (size_t)(t + 2) * kstep;
            const char* a3 = a2 + kstep; const char* b3 = b2 + kstep;
            if (last && has_next) S.a_ready(nxt);
            if constexpr (SP2) {
            PG8_LDB(B0, 0, 0); PG8_LDB(B1, 0, 1); PG8_SCHED; PG8_LDA(At, 0, 0); PG8_STAGE(PG8_SA(1, 1), a1 + hstep, voffA);
            PG8_WAIT_V(8); PG8_WAIT_L(0); PG8_BAR; PG8_MMA(0, 0, At, B0); PG8_MMA(0, 1, At, B1); PG8_BAR; PG8_SCHED;
            PG8_LDA(At, 0, 1); PG8_STAGE(PG8_SB(0, 0), b2, voffB); PG8_STAGE(PG8_SB(0, 1), b2 + hstep, voffB); PG8_STAGE(PG8_SA(0, 0), a2, voffA);
            PG8_WAIT_V(8); PG8_WAIT_L(0); PG8_BAR; PG8_MMA(1, 0, At, B0); PG8_MMA(1, 1, At, B1); PG8_BAR; PG8_SCHED;
            PG8_LDB(B0, 1, 0); PG8_LDB(B1, 1, 1); PG8_SCHED; PG8_LDA(At, 1, 0); PG8_STAGE(PG8_SA(0, 1), a2 + hstep, voffA);
            PG8_WAIT_V(8); PG8_WAIT_L(0); PG8_BAR; PG8_MMA(0, 0, At, B0); PG8_MMA(0, 1, At, B1); PG8_BAR; PG8_SCHED;
            PG8_LDA(At, 1, 1); PG8_STAGE(PG8_SB(1, 0), b3, voffB); PG8_STAGE(PG8_SB(1, 1), b3 + hstep, voffB); PG8_STAGE(PG8_SA(1, 0), a3, voffA);
            PG8_WAIT_V(8); PG8_WAIT_L(0); PG8_BAR; PG8_MMA(1, 0, At, B0); PG8_MMA(1, 1, At, B1); PG8_BAR; PG8_SCHED;
            } else {
            PG8_LDB(B0, 0, 0); PG8_SCHED; PG8_LDA(At, 0, 0); PG8_STAGE(PG8_SA(1, 1), a1 + hstep, voffA);
            PG8_WAIT_L(8); PG8_BAR; PG8_WAIT_L(0); PG8_MMA(0, 0, At, B0); PG8_BAR; PG8_SCHED;
            PG8_LDB(B1, 0, 1); PG8_STAGE(PG8_SB(0, 0), b2, voffB);
            PG8_BAR; PG8_WAIT_L(0); PG8_MMA(0, 1, At, B1); PG8_BAR;
            PG8_LDA(At, 0, 1); PG8_STAGE(PG8_SA(0, 0), a2, voffA);
            PG8_BAR; PG8_WAIT_L(0); PG8_MMA(1, 0, At, B0); PG8_BAR; PG8_SCHED;
            PG8_STAGE(PG8_SB(0, 1), b2 + hstep, voffB);
            PG8_WAIT_V(6); PG8_BAR; PG8_MMA(1, 1, At, B1); PG8_BAR;
            PG8_LDB(B0, 1, 0); PG8_SCHED; PG8_LDA(At, 1, 0); PG8_STAGE(PG8_SA(0, 1), a2 + hstep, voffA);
            PG8_WAIT_L(8); PG8_BAR; PG8_WAIT_L(0); PG8_MMA(0, 0, At, B0); PG8_BAR; PG8_SCHED;
            PG8_LDB(B1, 1, 1); PG8_STAGE(PG8_SB(1, 0), b3, voffB);
            PG8_BAR; PG8_WAIT_L(0); PG8_MMA(0, 1, At, B1); PG8_BAR;
            PG8_LDA(At, 1, 1); PG8_STAGE(PG8_SA(1, 0), a3, voffA);
            PG8_BAR; PG8_WAIT_L(0); PG8_MMA(1, 0, At, B0); PG8_BAR; PG8_SCHED;
            PG8_STAGE(PG8_SB(1, 1), b3 + hstep, voffB);
            PG8_WAIT_V(6); PG8_BAR; PG8_MMA(1, 1, At, B1); PG8_BAR;
            }
        }
        if constexpr (ALIGN_EPI) { if (wr == 0) PG8_BAR; }
        if constexpr (!Epi::AFTER_DRAIN) { E(acc, cur, wr, wc, fr, fq); S.done(cur); }
        if (!has_next) break;
#pragma unroll
        for (int a = 0; a < 2; ++a)
#pragma unroll
            for (int b = 0; b < 2; ++b)
#pragma unroll
                for (int m = 0; m < 4; ++m)
#pragma unroll
                    for (int n = 0; n < 2; ++n) acc[a][b][m][n] = (f32x4){0.f, 0.f, 0.f, 0.f};
        cur = nxt; cA = nA; cB = nB; ++ui;
        if constexpr (ALIGN_EPI) { if (wr == 1) PG8_BAR; }
    }
    PG8_WAIT_V(0);
    if constexpr (!ALIGN_EPI) { if (wr == 0) PG8_BAR; }
    PG8_BAR;
    if constexpr (Epi::AFTER_DRAIN) { E.fused(acc, cur, wr, wc, fr, fq, lds, wid, lane); S.done(cur); }
#undef PG8_SA
#undef PG8_SB
#undef PG8_STAGE
#undef PG8_LDA
#undef PG8_LDB
#undef PG8_MMA
#undef PG8_WAIT_V
#undef PG8_WAIT_L
#undef PG8_BAR
#undef PG8_SCHED
}
}
namespace dattn {
using bf16x8 = __attribute__((ext_vector_type(8))) short;
using s16x4  = __attribute__((ext_vector_type(4))) short;
using f32x16 = __attribute__((ext_vector_type(16))) float;
using u32x4  = __attribute__((ext_vector_type(4))) unsigned;
typedef unsigned short bf16r;
constexpr int NW = 8, QBLK = 32, KVBLK = 64, SEQ = 2048, LDP = 4096;
constexpr float SCALE = 0.125f, THR = 8.f;
constexpr size_t SHM_V = KVBLK * 128 * 2, SHM_K = KVBLK * 128 * 2, SHM_ATTN = 2 * SHM_V + 2 * SHM_K + NW * 64 * 4;
#define KSWZ(row, colB) ((row) * 256 + ((colB) ^ (((row) & 7) << 4)))
#define SBAR() __builtin_amdgcn_sched_barrier(0)
__device__ __forceinline__ int crow(int r, int hi) { return (r & 3) + 8 * (r >> 2) + 4 * hi; }
__device__ __forceinline__ unsigned cvtpk(float lo, float hi) { unsigned r; asm volatile("v_cvt_pk_bf16_f32 %0, %1, %2" : "=v"(r) : "v"(lo), "v"(hi)); return r; }

__device__ __forceinline__ void partialSM(f32x16& p0, f32x16& p1, float& m_reg, float& mn, float& alpha) {
  constexpr float C = SCALE * 1.4426950408889634f;
  float pmax = p0[0];
#pragma unroll
  for (int r = 1; r < 16; ++r) pmax = fmaxf(pmax, p0[r]);
#pragma unroll
  for (int r = 0; r < 16; ++r) pmax = fmaxf(pmax, p1[r]);
  { auto rr = __builtin_amdgcn_permlane32_swap(__float_as_uint(pmax), __float_as_uint(pmax), false, false);
    pmax = fmaxf(__uint_as_float(rr[0]), __uint_as_float(rr[1])); }
  if (__builtin_expect(__all(pmax - m_reg <= THR / SCALE), 1)) { mn = m_reg; alpha = 1.f; }
  else { mn = fmaxf(m_reg, pmax); alpha = __builtin_amdgcn_exp2f((m_reg - mn) * C); m_reg = mn; }
  float mnC = -mn * C;
#pragma unroll
  for (int r = 0; r < 16; ++r) p0[r] = fmaf(p0[r], C, mnC);
#pragma unroll
  for (int r = 0; r < 16; ++r) p1[r] = fmaf(p1[r], C, mnC);
#pragma unroll
  for (int r = 0; r < 16; ++r) p0[r] = __builtin_amdgcn_exp2f(p0[r]);
}
__device__ __forceinline__ void finishSM(f32x16& p0, f32x16& p1, float alpha, float& l_reg, bf16x8& pa0, bf16x8& pa1, bf16x8& pa2, bf16x8& pa3) {
#pragma unroll
  for (int r = 0; r < 16; ++r) p1[r] = __builtin_amdgcn_exp2f(p1[r]);
  float ps = 0;
#pragma unroll
  for (int r = 0; r < 16; ++r) ps += p0[r];
#pragma unroll
  for (int r = 0; r < 16; ++r) ps += p1[r];
  { auto rr = __builtin_amdgcn_permlane32_swap(__float_as_uint(ps), __float_as_uint(ps), false, false);
    ps = __uint_as_float(rr[0]) + __uint_as_float(rr[1]); }
  l_reg = l_reg * alpha + ps;
#define PK4(P, BASE, OUT) do { unsigned a0 = cvtpk(P[BASE + 0], P[BASE + 1]), a1 = cvtpk(P[BASE + 2], P[BASE + 3]);   \
    unsigned b0 = cvtpk(P[BASE + 4], P[BASE + 5]), b1 = cvtpk(P[BASE + 6], P[BASE + 7]);                              \
    auto r0 = __builtin_amdgcn_permlane32_swap(a0, b0, false, false); auto r1 = __builtin_amdgcn_permlane32_swap(a1, b1, false, false); \
    u32x4 w = {r0[0], r1[0], r0[1], r1[1]}; OUT = *reinterpret_cast<bf16x8*>(&w); } while (0)
  PK4(p0, 0, pa0); PK4(p0, 8, pa1); PK4(p1, 0, pa2); PK4(p1, 8, pa3);
#undef PK4
}
__device__ __forceinline__ void qkt(f32x16& p0, f32x16& p1, const char* Ks, const bf16x8* qr, int r32, int hi, int colb0) {
  p0 = f32x16{}; p1 = f32x16{};
#pragma unroll
  for (int d0 = 0; d0 < 4; ++d0) { int cb = colb0 + (d0 * 16 + hi * 8) * 2;
    bf16x8 b0 = *reinterpret_cast<const bf16x8*>(Ks + KSWZ(r32, cb));
    bf16x8 b1 = *reinterpret_cast<const bf16x8*>(Ks + KSWZ(32 + r32, cb));
    p0 = __builtin_amdgcn_mfma_f32_32x32x16_bf16(b0, qr[d0], p0, 0, 0, 0);
    p1 = __builtin_amdgcn_mfma_f32_32x32x16_bf16(b1, qr[d0], p1, 0, 0, 0); }
}
__device__ __forceinline__ int v_st(int k, int c) { const int kk = (k & ~0xC) | ((k & 4) << 1) | ((k & 8) >> 1); return ((kk >> 3) * 4 + (c >> 5)) * 512 + ((kk & 7) * 32 + (c & 31)) * 2; }
__device__ __forceinline__ int v_rd_base(int lane) { return ((lane & 3) << 3) | (((lane >> 2) & 3) << 6) | (((lane >> 4) & 1) << 5) | (((lane >> 5) & 1) << 8); }
constexpr int v_rd_off(int d0, int ks, int half) { return d0 * 512 + ks * 4096 + half * 2048; }
template <int OFF> __device__ __forceinline__ s16x4 tr_read(int vb) {
  s16x4 r; asm volatile("ds_read_b64_tr_b16 %0, %1 offset:%2" : "=&v"(r) : "v"(vb), "i"(OFF) : "memory"); return r;
}
template <int D0> __device__ __forceinline__ void pv_one(f32x16& od, int vb, bf16x8 pa0, bf16x8 pa1, bf16x8 pa2, bf16x8 pa3) {
  const s16x4 l0 = tr_read<v_rd_off(D0, 0, 0)>(vb), h0 = tr_read<v_rd_off(D0, 0, 1)>(vb), l1 = tr_read<v_rd_off(D0, 1, 0)>(vb), h1 = tr_read<v_rd_off(D0, 1, 1)>(vb);
  const s16x4 l2 = tr_read<v_rd_off(D0, 2, 0)>(vb), h2 = tr_read<v_rd_off(D0, 2, 1)>(vb), l3 = tr_read<v_rd_off(D0, 3, 0)>(vb), h3 = tr_read<v_rd_off(D0, 3, 1)>(vb);
  asm volatile("s_waitcnt lgkmcnt(0)" ::: "memory"); SBAR();
#define PK(L, H) (bf16x8){L[0], L[1], L[2], L[3], H[0], H[1], H[2], H[3]}
  od = __builtin_amdgcn_mfma_f32_32x32x16_bf16(pa0, PK(l0, h0), od, 0, 0, 0);
  od = __builtin_amdgcn_mfma_f32_32x32x16_bf16(pa1, PK(l1, h1), od, 0, 0, 0);
  od = __builtin_amdgcn_mfma_f32_32x32x16_bf16(pa2, PK(l2, h2), od, 0, 0, 0);
  od = __builtin_amdgcn_mfma_f32_32x32x16_bf16(pa3, PK(l3, h3), od, 0, 0, 0);
#undef PK
}
__device__ __forceinline__ void pv_d0(f32x16* o, int vb, bf16x8 pa0, bf16x8 pa1, bf16x8 pa2, bf16x8 pa3) {
  pv_one<0>(o[0], vb, pa0, pa1, pa2, pa3); pv_one<1>(o[1], vb, pa0, pa1, pa2, pa3); pv_one<2>(o[2], vb, pa0, pa1, pa2, pa3); pv_one<3>(o[3], vb, pa0, pa1, pa2, pa3);
}
__device__ __forceinline__ float bf2f(unsigned short u) { return __uint_as_float((unsigned)u << 16); }
__device__ __forceinline__ unsigned short f2bf(float f) { unsigned u = __float_as_uint(f); return (unsigned short)((u + 0x7fffu + ((u >> 16) & 1u)) >> 16); }

__device__ __forceinline__ void diff_unit(const bf16r* __restrict__ Qb, const bf16r* __restrict__ Kh, const bf16r* __restrict__ Vh, const bf16r* __restrict__ Gb,
                                          bf16r* __restrict__ Ob, float lam, const float* __restrict__ nw, float nwscale, char* lds, int wave_s) {
  int tid_ = wave_s * 64 + lane_id_opaque(); asm volatile("" : "+v"(tid_));
  const int tid = tid_, wid = tid >> 6, lane = tid & 63, r32 = lane & 31, hi = lane >> 5;
  const int mp = wid >> 2, rg = wid & 3;
  char* V_lds = lds; char* K_lds = lds + 2 * SHM_V;
  float* ws = (float*)(lds + 2 * SHM_V + 2 * SHM_K) + wid * 64; float* li_l = ws; float* al_l = ws + 32;
  float m_reg = -1e30f, l_reg = 0; f32x16 o[4] = {}; bf16x8 qr[4];
  const bf16r* Qw = Qb + (long)(rg * QBLK + r32) * LDP + mp * 64 + hi * 8;
#pragma unroll
  for (int d0 = 0; d0 < 4; ++d0) qr[d0] = *reinterpret_cast<const bf16x8*>(Qw + d0 * 16);
  const int colb0 = mp * 128;
  const int sr = tid >> 4, sc = (tid & 15) * 8, vst0 = v_st(sr, sc), vst1 = v_st(32 + sr, sc);
  const int vb0 = (int)(uintptr_t)V_lds + v_rd_base(lane);
  struct { bf16x8 vs0, vs1, ks0, ks1; } sr_[2];
#define SLOAD(i, k0) do { sr_[i].vs0 = *reinterpret_cast<const bf16x8*>(&Vh[(long)((k0) + sr) * LDP + sc]); sr_[i].vs1 = *reinterpret_cast<const bf16x8*>(&Vh[(long)((k0) + 32 + sr) * LDP + sc]); \
    sr_[i].ks0 = *reinterpret_cast<const bf16x8*>(&Kh[(long)((k0) + sr) * LDP + sc]); sr_[i].ks1 = *reinterpret_cast<const bf16x8*>(&Kh[(long)((k0) + 32 + sr) * LDP + sc]); } while (0)
#define SWRITE(b, i) do { *(bf16x8*)(V_lds + (b) * SHM_V + vst0) = sr_[i].vs0;          \
    *(bf16x8*)(V_lds + (b) * SHM_V + vst1) = sr_[i].vs1; int kc = sc * 2;               \
    *(bf16x8*)(K_lds + (b) * SHM_K + KSWZ(sr, kc)) = sr_[i].ks0;                       \
    *(bf16x8*)(K_lds + (b) * SHM_K + KSWZ(32 + sr, kc)) = sr_[i].ks1; } while (0)
#define SWAIT() asm volatile("s_waitcnt vmcnt(4)" ::: "memory")
#define RESC(a) do { if (__any((a) < 1.f)) { if (hi == 0) al_l[r32] = (a); asm volatile("s_waitcnt lgkmcnt(0)" ::: "memory"); \
    _Pragma("unroll") for (int d = 0; d < 4; ++d) _Pragma("unroll") for (int r = 0; r < 16; ++r) o[d][r] *= al_l[crow(r, hi)]; } } while (0)
  f32x16 pA0, pA1, pB0, pB1; float mnA, mnB, alA, alB; bf16x8 pa0, pa1, pa2, pa3; const int NT = SEQ / KVBLK;
  constexpr int SE = 0, SO = 1;
  SLOAD(SE, 0); asm volatile("s_waitcnt vmcnt(0)" ::: "memory"); SWRITE(0, SE); __syncthreads();
  qkt(pA0, pA1, K_lds, qr, r32, hi, colb0); partialSM(pA0, pA1, m_reg, mnA, alA);
  SLOAD(SO, KVBLK); SLOAD(SE, 2 * KVBLK);
  SWAIT(); SWRITE(1, SO); __syncthreads();
  for (int j = 1; j + 1 < NT; j += 2) {
    SBAR(); qkt(pB0, pB1, K_lds + SHM_K, qr, r32, hi, colb0);
    finishSM(pA0, pA1, alA, l_reg, pa0, pa1, pa2, pa3); SBAR();
    SLOAD(SO, (j + 2) * KVBLK); SBAR();
    pv_d0(o, vb0, pa0, pa1, pa2, pa3); partialSM(pB0, pB1, m_reg, mnB, alB);
    __syncthreads(); SWAIT(); SWRITE(0, SE);
    RESC(alB); __syncthreads();
    SBAR(); qkt(pA0, pA1, K_lds, qr, r32, hi, colb0);
    finishSM(pB0, pB1, alB, l_reg, pa0, pa1, pa2, pa3); SBAR();
    if (j + 3 < NT) SLOAD(SE, (j + 3) * KVBLK); SBAR();
    pv_d0(o, vb0 + (int)SHM_V, pa0, pa1, pa2, pa3); partialSM(pA0, pA1, m_reg, mnA, alA);
    __syncthreads(); SWAIT(); SWRITE(1, SO);
    RESC(alA); __syncthreads();
  }
  SBAR(); qkt(pB0, pB1, K_lds + SHM_K, qr, r32, hi, colb0);
  finishSM(pA0, pA1, alA, l_reg, pa0, pa1, pa2, pa3); SBAR();
  pv_d0(o, vb0, pa0, pa1, pa2, pa3); partialSM(pB0, pB1, m_reg, mnB, alB);
  __syncthreads(); RESC(alB);
  finishSM(pB0, pB1, alB, l_reg, pa0, pa1, pa2, pa3); SBAR();
  pv_d0(o, vb0 + (int)SHM_V, pa0, pa1, pa2, pa3);
  if (hi == 0) li_l[r32] = l_reg; asm volatile("s_waitcnt lgkmcnt(0)" ::: "memory");
  float rli[16];
#pragma unroll
  for (int r = 0; r < 16; ++r) rli[r] = __builtin_amdgcn_rcpf(li_l[crow(r, hi)]);
  __syncthreads();
  float* X = (float*)lds + rg * (16 * 4 * 64);
  float* Y = (float*)(lds + 67584);
  if (mp == 1) {
#pragma unroll
    for (int r = 0; r < 16; ++r)
#pragma unroll
      for (int d0 = 0; d0 < 4; ++d0) X[(r * 4 + d0) * 64 + lane] = o[d0][r] * rli[r];
  }
  __syncthreads();
  if (mp == 0) {
#pragma unroll
    for (int r = 0; r < 16; ++r)
#pragma unroll
      for (int d0 = 0; d0 < 4; ++d0) Y[(rg * QBLK + crow(r, hi)) * 128 + d0 * 32 + r32] = o[d0][r] * rli[r] - lam * X[(r * 4 + d0) * 64 + lane];
  }
  __syncthreads();
  { typedef float f32x4e __attribute__((ext_vector_type(4)));
    const int c0 = (lane & 15) * 8;
    const f32x4e w0 = *(const f32x4e*)(nw + c0) * nwscale, w1 = *(const f32x4e*)(nw + c0 + 4) * nwscale;
#pragma unroll 1
    for (int it = 0; it < 4; ++it) { const int row = wid * 16 + it * 4 + (lane >> 4);
      const f32x4e a0 = *(const f32x4e*)(Y + row * 128 + c0), a1 = *(const f32x4e*)(Y + row * 128 + c0 + 4);
      float s = (a0[0] * a0[0] + a0[1] * a0[1]) + (a0[2] * a0[2] + a0[3] * a0[3]) + (a1[0] * a1[0] + a1[1] * a1[1]) + (a1[2] * a1[2] + a1[3] * a1[3]);
      s += xor_shfl<1>(s); s += xor_shfl<2>(s); s += xor_shfl<4>(s); s += xor_shfl<8>(s);
      const float rs = 1.f / sqrtf(s * (1.f / 128.f) + 1e-6f);
      const u32x4 gq = *reinterpret_cast<const u32x4*>(Gb + (long)row * LDP + c0);
      float gv[8];
#pragma unroll
      for (int e = 0; e < 4; ++e) { gv[2 * e] = __uint_as_float(gq[e] << 16); gv[2 * e + 1] = __uint_as_float(gq[e] & 0xffff0000u); }
      float ov[8];
#pragma unroll
      for (int e = 0; e < 8; ++e) { const float g = gv[e]; const float sg = g / (1.f + __expf(-g)); const float a = e < 4 ? a0[e] : a1[e - 4]; const float w = e < 4 ? w0[e] : w1[e - 4]; ov[e] = a * rs * w * sg; }
      u32x4 ow; ow[0] = cvtpk(ov[0], ov[1]); ow[1] = cvtpk(ov[2], ov[3]); ow[2] = cvtpk(ov[4], ov[5]); ow[3] = cvtpk(ov[6], ov[7]);
      *reinterpret_cast<u32x4*>(Ob + (long)row * 1024 + c0) = ow; }
  }
  __syncthreads();
#undef SLOAD
#undef SWRITE
#undef SWAIT
#undef RESC
}
#undef KSWZ
#undef SBAR
}
#define GAS __attribute__((address_space(1)))
#define LAS __attribute__((address_space(3)))
typedef unsigned short bf16;
typedef unsigned v4u __attribute__((ext_vector_type(4)));
typedef float f32x4 __attribute__((ext_vector_type(4)));
typedef short bf16x8 __attribute__((ext_vector_type(8)));
constexpr int NWAVES = 8;
constexpr int BATCH = 16, SEQ = 2048, DM = 1024, DEPTH = 4, M = BATCH * SEQ;
constexpr int IN_W = 4128, NP = 4096, NPA = 4128;
constexpr float EPS = 1e-6f;
constexpr int PQ_GQ = 0, PQ_GK = 128, PQ_GV = 256, PQ_GG = 512, PQ_DQ = 768, PQ_DK = 1280, PQ_DV = 1792, PQ_DG = 2304, PQ_HQ = 2816, PQ_HZF = 3072, PQ_HZB = 3328, PQ_HI = 3584, PQ_HG = 3840;
constexpr size_t MiB = 1u << 20;
constexpr size_t WS_CTL = 0;
constexpr size_t WS_WIN = 1 * MiB;
constexpr size_t WS_WOUT = 34 * MiB;
constexpr size_t WS_ROPE = 42 * MiB;
constexpr size_t WS_A = 43 * MiB;
constexpr size_t WS_H = 48 * MiB;
constexpr size_t WS_MIX = 112 * MiB;
constexpr size_t WS_PROJ = 176 * MiB;
constexpr size_t WS_Y = WS_PROJ;
constexpr size_t WS_OSC = WS_H;
constexpr size_t WS_XCH = 432 * MiB;
constexpr size_t WS_END = 468 * MiB;
static_assert(WS_WIN + (size_t)DEPTH * NPA * DM * 2 <= WS_WOUT && WS_XCH + (size_t)128 * 266240 <= WS_END, "ws map");
constexpr int LDS_BYTES = 147456;

__device__ __forceinline__ float bf2f(unsigned short u) { return __uint_as_float((unsigned)u << 16); }
__device__ __forceinline__ unsigned f2bf(float f) { unsigned u = __float_as_uint(f); return (u + 0x7fffu + ((u >> 16) & 1u)) >> 16; }
__device__ __forceinline__ unsigned pk2(float lo, float hi) { return f2bf(lo) | (f2bf(hi) << 16); }
__device__ __forceinline__ float wave_sum(float v) {
    v += xor_shfl<1>(v); v += xor_shfl<2>(v); v += xor_shfl<4>(v); v += xor_shfl<8>(v); v += xor_shfl<16>(v); v += xor_shfl<32>(v);
    return v;
}
#define LDS_WAIT() asm volatile("s_waitcnt lgkmcnt(0)" ::: "memory")
#define VM_WAIT() asm volatile("s_waitcnt vmcnt(0)" ::: "memory")

struct Args {
    const float* x; const float* norm_pre; const float* norm_post; const float* w_in; const float* w_out;
    const float* gla_wa2_f; const float* gla_ba_f; const float* gla_wa2_b; const float* gla_ba_b; const float* gla_norm;
    const float* lq1; const float* lk1; const float* lq2; const float* lk2; const float* diff_norm; const float* lb_logits; const float* hgrn_norm;
    float* out; unsigned char* ws; int ph_lo, ph_hi;
};
struct Frame { LAS unsigned char* lds; int tid, lane, wave, vcu, G; };

__device__ __forceinline__ int src_col(int p) {
    if (p >= NP) return 768 + (p - NP);
    if (p < 768) return p;
    if (p < 1792) { const int base = p & ~63, e = p & 63, j8 = e >> 3, e8 = e & 7; const int d = (e8 < 4) ? 4 * j8 + e8 : 32 + 4 * j8 + (e8 - 4); return base + d + 32; }
    return p + 32;
}
__device__ __forceinline__ void transpose_item(const float* W, int srcN, bool remap, bf16* WT, LAS float* scr, int kb, int nb, int lane) {
    const int k0 = 64 * kb, n0 = 32 * nb; const int sc = remap ? src_col(n0 + (lane & 31)) : n0 + (lane & 31);
#pragma unroll 8
    for (int i = 0; i < 32; ++i) { const int kk = 2 * i + (lane >> 5); scr[kk * 33 + (lane & 31)] = W[(size_t)(k0 + kk) * srcN + sc]; }
    LDS_WAIT(); asm volatile("" ::: "memory");
    const int c = lane & 7;
#pragma unroll
    for (int j = 0; j < 4; ++j) { const int n = (lane >> 3) + 8 * j; const LAS float* s = scr + (8 * c) * 33 + n;
        v4u o; o.x = pk2(s[0 * 33], s[1 * 33]); o.y = pk2(s[2 * 33], s[3 * 33]); o.z = pk2(s[4 * 33], s[5 * 33]); o.w = pk2(s[6 * 33], s[7 * 33]);
        *(GAS v4u*)(WT + (size_t)(n0 + n) * DM + k0 + 8 * c) = o; }
    LDS_WAIT(); asm volatile("" ::: "memory");
}
__device__ __forceinline__ void rms_row_to_bf16(const f32x4 (&v)[4], const float* w, bf16* orow, int lane) {
    float s = 0.f;
#pragma unroll
    for (int j = 0; j < 4; ++j) s += (v[j].x * v[j].x + v[j].y * v[j].y) + (v[j].z * v[j].z + v[j].w * v[j].w);
    const float r = 1.f / sqrtf(wave_sum(s) * (1.f / DM) + EPS);
    GAS unsigned long long* o8 = (GAS unsigned long long*)orow + lane;
#pragma unroll
    for (int j = 0; j < 4; ++j) { const f32x4 ww = *((const f32x4*)w + lane + 64 * j);
        o8[64 * j] = (unsigned long long)pk2(v[j].x * r * ww.x, v[j].y * r * ww.y) | ((unsigned long long)pk2(v[j].z * r * ww.z, v[j].w * r * ww.w) << 32); }
}

__device__ __forceinline__ void p0_prologue(const Frame& F, const Args& a) {
    LAS float* scr = (LAS float*)(F.lds + F.wave * 16384);
    const int gw = F.vcu * NWAVES + F.wave, NGW = F.G * NWAVES;
    bf16* WinT = (bf16*)(a.ws + WS_WIN); bf16* WoutT = (bf16*)(a.ws + WS_WOUT);
    constexpr int I_IN = 16 * (NPA / 32), I_OUT = 16 * 32;
    constexpr int NITEMS = DEPTH * (I_IN + I_OUT);
    for (int it = gw; it < NITEMS; it += NGW) {
        const int l = it / (I_IN + I_OUT); int r = it % (I_IN + I_OUT);
        if (r < I_IN) transpose_item(a.w_in + (size_t)l * DM * IN_W, IN_W, true, WinT + (size_t)l * NPA * DM, scr, r / (NPA / 32), r % (NPA / 32), F.lane);
        else { r -= I_IN; transpose_item(a.w_out + (size_t)l * DM * DM, DM, false, WoutT + (size_t)l * DM * DM, scr, r / 32, r % 32, F.lane); }
    }
    float* cosT = (float*)(a.ws + WS_ROPE); float* sinT = cosT + SEQ * 32;
    for (int e = gw * 64 + F.lane; e < SEQ * 32; e += NGW * 64) { const int pos = e >> 5, i = e & 31;
        const float inv = __builtin_amdgcn_exp2f(-(float)i * (13.287712379549449f / 32.f));
        const float ang = (float)pos * inv; float rev = ang * 0.15915494309189535f; rev = rev - floorf(rev);
        cosT[e] = __builtin_amdgcn_cosf(rev); sinT[e] = __builtin_amdgcn_sinf(rev); }
    bf16* H = (bf16*)(a.ws + WS_H);
    for (int m = gw; m < M; m += NGW) { const GAS f32x4* xr = (const GAS f32x4*)(a.x + (size_t)m * DM) + F.lane; f32x4 v[4];
#pragma unroll
        for (int j = 0; j < 4; ++j) v[j] = xr[64 * j];
        rms_row_to_bf16(v, a.norm_pre, H + (size_t)m * DM, F.lane); }
}

__device__ __forceinline__ void lowrank_phase(const Frame& F, const Args& a, int layer) {
    typedef float f32x4v __attribute__((ext_vector_type(4)));
    const bf16* H = (const bf16*)(a.ws + WS_H); const bf16* Wa = (const bf16*)(a.ws + WS_WIN) + ((size_t)layer * NPA + NP) * DM; float* A = (float*)(a.ws + WS_A);
    const int gw = F.vcu * NWAVES + F.wave, NGW = F.G * NWAVES, lane = F.lane;
    for (int u = gw; u < M / 16; u += NGW) {
        const bf16* ap = H + (size_t)(u * 16 + (lane & 15)) * DM + 8 * (lane >> 4);
        const bf16* b0 = Wa + (size_t)(lane & 15) * DM + 8 * (lane >> 4); const bf16* b1 = b0 + 16 * DM;
        f32x4v c0 = {0.f, 0.f, 0.f, 0.f}, c1 = {0.f, 0.f, 0.f, 0.f};
#pragma unroll 8
        for (int ks = 0; ks < 32; ++ks) { const bf16x8 av = *(const bf16x8*)(ap + ks * 32), bv0 = *(const bf16x8*)(b0 + ks * 32), bv1 = *(const bf16x8*)(b1 + ks * 32);
            c0 = __builtin_amdgcn_mfma_f32_16x16x32_bf16(av, bv0, c0, 0, 0, 0); c1 = __builtin_amdgcn_mfma_f32_16x16x32_bf16(av, bv1, c1, 0, 0, 0); }
#pragma unroll
        for (int r = 0; r < 4; ++r) { float* o = A + (size_t)(u * 16 + 4 * (lane >> 4) + r) * 32 + (lane & 15); o[0] = c0[r]; o[16] = c1[r]; }
    }
}

__device__ __forceinline__ void postnorm_phase(const Frame& F, const Args& a, int layer) {
    const float* Y = (const float*)(a.ws + WS_Y); bf16* H = (bf16*)(a.ws + WS_H);
    const float* xin = layer == 0 ? a.x : a.out; const float* wpost = a.norm_post + layer * DM;
    const int gw = F.vcu * NWAVES + F.wave, NGW = F.G * NWAVES, lane = F.lane;
    for (int m = gw; m < M; m += NGW) {
        const GAS f32x4* yr = (const GAS f32x4*)(Y + (size_t)m * DM) + lane; const GAS f32x4* xr = (const GAS f32x4*)(xin + (size_t)m * DM) + lane;
        f32x4 y[4], x[4]; float s = 0.f;
#pragma unroll
        for (int j = 0; j < 4; ++j) { y[j] = yr[64 * j]; x[j] = xr[64 * j]; s += (y[j].x * y[j].x + y[j].y * y[j].y) + (y[j].z * y[j].z + y[j].w * y[j].w); }
        const float r = 1.f / sqrtf(wave_sum(s) * (1.f / DM) + EPS);
        GAS f32x4* orow = (GAS f32x4*)(a.out + (size_t)m * DM) + lane;
#pragma unroll
        for (int j = 0; j < 4; ++j) { const f32x4 ww = *((const f32x4*)wpost + lane + 64 * j); x[j] = x[j] + y[j] * r * ww; orow[64 * j] = x[j]; }
        if (layer + 1 < DEPTH) rms_row_to_bf16(x, a.norm_pre + (layer + 1) * DM, H + (size_t)m * DM, lane);
    }
}
namespace scan {
typedef float f32x16 __attribute__((ext_vector_type(16)));
typedef float f32x4s __attribute__((ext_vector_type(4)));
typedef short bf16x8s __attribute__((ext_vector_type(8)));
typedef unsigned u32x4s __attribute__((ext_vector_type(4)));
typedef unsigned u32x2s __attribute__((ext_vector_type(2)));
constexpr int CH = 32, SEGT = 256, NCH = SEGT / CH;
constexpr int WAVE_LDS = 14336;
constexpr size_t XCH_UNIT = (size_t)8 * 2 * 4 * 16 * 64 * 4 + 8 * 2 * 64 * 4;
__device__ __forceinline__ int crow(int r, int hi) { return (r & 3) + 8 * (r >> 2) + 4 * hi; }
__device__ __forceinline__ int tokT(int e, int hh) { return 16 * (e >> 3) + 8 * ((e >> 2) & 1) + 4 * hh + (e & 3); }
__device__ __forceinline__ int pi16(int k) { return (k & ~12) | ((k & 4) << 1) | ((k & 8) >> 1); }
__device__ __forceinline__ unsigned cvtpk(float lo, float hi) { unsigned r; asm volatile("v_cvt_pk_bf16_f32 %0, %1, %2" : "=v"(r) : "v"(lo), "v"(hi)); return r; }
__device__ __forceinline__ float other_half(float x, int hh) { auto rr = __builtin_amdgcn_permlane32_swap(__float_as_uint(x), __float_as_uint(x), false, false); return __uint_as_float(hh ? rr[0] : rr[1]); }

template <int DK, bool HG> struct Ctx {
    const bf16* P; const float* A; int lane, r, hh; LAS unsigned char* lw;
    int qcol, kcol[2], vcol;
    float lb[DK / 32];
    bf16x8s wbf[2]; float ba[2];
};
constexpr int pitchE(int DK) { return DK + 8; }

template <int DK, bool HG, int DIR, bool FULL>
__device__ __forceinline__ void chunk_step(const Ctx<DK, HG>& c, size_t row0, f32x16 (&S)[DK / 32][2], float (&Bseg)[DK / 32], f32x16 (&O)[2]) {
    constexpr int NKB = DK / 32, PE = pitchE(DK), TB = 32 * PE * 2;
    LAS unsigned char* TQ = c.lw; LAS unsigned char* TZ = c.lw + TB; LAS unsigned char* TV = c.lw + 2 * TB; LAS float* VEC = (LAS float*)(TV + 4096);
    int lane_ = c.lane; asm volatile("" : "+v"(lane_));
    const int lane = lane_, r = lane & 31, hh = lane >> 5;
    const bf16* Pr = c.P + row0 * NP;
    {
        constexpr int PPR = DK / 8, NP_ = 32 * PPR / 64;
#pragma unroll
        for (int i = 0; i < NP_; ++i) { const int p = lane + 64 * i, rw = p / PPR, ch = p % PPR;
            if (FULL) { const v4u q = *(const GAS v4u*)(Pr + (unsigned)(rw * NP + c.qcol + ch * 8)); *(LAS v4u*)(TQ + rw * PE * 2 + ch * 16) = q; }
            const v4u z = *(const GAS v4u*)(Pr + (unsigned)(rw * NP + c.kcol[DIR] + ch * 8)); *(LAS v4u*)(TZ + rw * PE * 2 + ch * 16) = z; }
#pragma unroll
        for (int i = 0; i < 4; ++i) { const int p = lane + 64 * i, rw = p >> 3, ch = p & 7;
            const v4u v = *(const GAS v4u*)(Pr + (unsigned)(rw * NP + c.vcol + ch * 8)); *(LAS v4u*)(TV + rw * 128 + ch * 16) = v; }
    }
    LDS_WAIT(); asm volatile("" ::: "memory");
    __builtin_amdgcn_sched_barrier(0);
    bf16x8s KT[NKB][2];
    float gS[NKB], gU[NKB], eR[NKB];
    f32x16 zg = {};
    if (!HG) { const float* Ar = c.A + row0 * 32; const f32x4s a0 = *(const GAS f32x4s*)(Ar + (unsigned)(r * 32 + DIR * 16 + 8 * hh)), a1 = *(const GAS f32x4s*)(Ar + (unsigned)(r * 32 + DIR * 16 + 8 * hh + 4));
        u32x4s w; w[0] = cvtpk(a0[0], a0[1]); w[1] = cvtpk(a0[2], a0[3]); w[2] = cvtpk(a1[0], a1[1]); w[3] = cvtpk(a1[2], a1[3]);
        zg = __builtin_amdgcn_mfma_f32_32x32x16_bf16(__builtin_bit_cast(bf16x8s, w), c.wbf[DIR], zg, 0, 0, 0); }
#pragma unroll
    for (int kb = 0; kb < NKB; ++kb) {
        float lg[16], kk[16];
#pragma unroll
        for (int e = 0; e < 16; ++e) { const int t = tokT(e, hh);
            const float zr = bf2f(*(const LAS unsigned short*)(TZ + (t * PE + 32 * kb + r) * 2));
            if (HG) {
                const float ez = __expf(-fabsf(zr)), rc = __builtin_amdgcn_rcpf(1.f + ez); const float sp = rc, sn = ez * rc;
                const float sig = zr >= 0.f ? sp : sn, sneg = zr >= 0.f ? sn : sp;
                const float f = c.lb[kb] + (1.f - c.lb[kb]) * sig; kk[e] = (1.f - c.lb[kb]) * sneg; lg[e] = __logf(fmaxf(f, 1e-30f));
            } else {
                const float z = zg[e] + c.ba[DIR];
                lg[e] = (fminf(z, 0.f) - __logf(1.f + __expf(-fabsf(z)))) * (1.f / 16.f); kk[e] = zr;
            }
            if ((e & 3) == 3) __builtin_amdgcn_sched_barrier(0);
        }
        float T[4], To[4], off[4];
#pragma unroll
        for (int ro = 0; ro < 4; ++ro) { T[ro] = (lg[4 * ro] + lg[4 * ro + 1]) + (lg[4 * ro + 2] + lg[4 * ro + 3]); To[ro] = other_half(T[ro], hh); }
        float Btot, ref;
        if (DIR == 0) { float pre = 0.f;
#pragma unroll
            for (int ro = 0; ro < 4; ++ro) { off[ro] = pre + (hh ? To[ro] : 0.f); pre += T[ro] + To[ro]; }
            Btot = pre; ref = (T[0] + To[0]) + (T[1] + To[1]);
#pragma unroll
            for (int ro = 0; ro < 4; ++ro) { float a = off[ro];
#pragma unroll
                for (int i = 0; i < 4; ++i) { a += lg[4 * ro + i]; lg[4 * ro + i] = a; } }
        } else { float suf = 0.f;
#pragma unroll
            for (int ro = 3; ro >= 0; --ro) { off[ro] = suf + (hh ? 0.f : To[ro]); suf += T[ro] + To[ro]; }
            Btot = suf; ref = (T[2] + To[2]) + (T[3] + To[3]);
#pragma unroll
            for (int ro = 0; ro < 4; ++ro) { float a = off[ro];
#pragma unroll
                for (int i = 3; i >= 0; --i) { a += lg[4 * ro + i]; lg[4 * ro + i] = a; } }
        }
        Bseg[kb] += Btot;
        gS[kb] = __expf(Btot); gU[kb] = __expf(fmaxf(Btot - ref, -80.f)); eR[kb] = __expf(fmaxf(ref, -80.f));
        float kt[16];
#pragma unroll
        for (int e = 0; e < 16; ++e) { const float x = fminf(fmaxf(lg[e] - ref, -80.f), 80.f); const float eq = __expf(x), ek = __builtin_amdgcn_rcpf(eq);
            kt[e] = kk[e] * ek;
            if (FULL) { const int t = tokT(e, hh); const int col = pi16(32 * kb + r);
                float qv = bf2f(*(const LAS unsigned short*)(TQ + (t * PE + 32 * kb + r) * 2)); if (!HG) qv *= 0.17677669529663687f;
                lg[e] = qv * eq; (void)col; }
            if ((e & 3) == 3) __builtin_amdgcn_sched_barrier(0); }
        if (!FULL) {
#pragma unroll
            for (int ss = 0; ss < 2; ++ss) { u32x4s w;
#pragma unroll
                for (int jj = 0; jj < 4; ++jj) w[jj] = cvtpk(kt[ss * 8 + 2 * jj], kt[ss * 8 + 2 * jj + 1]);
                KT[kb][ss] = __builtin_bit_cast(bf16x8s, w); }
        }
        if (FULL) {
            const int col = pi16(32 * kb + r);
#pragma unroll
            for (int e = 0; e < 16; ++e) { const int t = tokT(e, hh);
                *(LAS unsigned short*)(TQ + (t * PE + col) * 2) = (unsigned short)f2bf(lg[e]);
                *(LAS unsigned short*)(TZ + (t * PE + col) * 2) = (unsigned short)f2bf(kt[e]); }
        }
        __builtin_amdgcn_sched_barrier(0);
    }
    if (hh == 0) {
#pragma unroll
        for (int kb = 0; kb < NKB; ++kb) { VEC[32 * kb + r] = gS[kb]; VEC[DK + 32 * kb + r] = gU[kb]; VEC[2 * DK + 32 * kb + r] = eR[kb]; }
    }
    LDS_WAIT(); asm volatile("" ::: "memory"); __builtin_amdgcn_sched_barrier(0);
    bf16x8s Vf[2][2];
#pragma unroll
    for (int vb = 0; vb < 2; ++vb)
#pragma unroll
        for (int ss = 0; ss < 2; ++ss) { u32x4s w;
#pragma unroll
            for (int jj = 0; jj < 4; ++jj) { const int e0 = ss * 8 + 2 * jj;
                const unsigned lo = *(const LAS unsigned short*)(TV + tokT(e0, hh) * 128 + (32 * vb + r) * 2), hi = *(const LAS unsigned short*)(TV + tokT(e0 + 1, hh) * 128 + (32 * vb + r) * 2);
                w[jj] = lo | (hi << 16); }
            Vf[vb][ss] = __builtin_bit_cast(bf16x8s, w); }
    __builtin_amdgcn_sched_barrier(0);
    if (FULL) {
        bf16x8s QR[DK / 16], KR[DK / 16];
#pragma unroll
        for (int ks = 0; ks < DK / 16; ++ks) { QR[ks] = *(const LAS bf16x8s*)(TQ + (r * PE + 16 * ks + 8 * hh) * 2); KR[ks] = *(const LAS bf16x8s*)(TZ + (r * PE + 16 * ks + 8 * hh) * 2); }
        f32x16 Pm = {};
#pragma unroll
        for (int ks = 0; ks < DK / 16; ++ks) Pm = __builtin_amdgcn_mfma_f32_32x32x16_bf16(KR[ks], QR[ks], Pm, 0, 0, 0);
        bf16x8s Pf[2];
#pragma unroll
        for (int ss = 0; ss < 2; ++ss) { u32x4s w;
#pragma unroll
            for (int jj = 0; jj < 4; ++jj) { const int g0 = 8 * ss + 2 * jj; const int s0 = crow(g0, hh), s1 = crow(g0 + 1, hh);
                const float p0 = (DIR == 0 ? (s0 <= r) : (s0 >= r)) ? Pm[g0] : 0.f, p1 = (DIR == 0 ? (s1 <= r) : (s1 >= r)) ? Pm[g0 + 1] : 0.f;
                w[jj] = cvtpk(p0, p1); }
            Pf[ss] = __builtin_bit_cast(bf16x8s, w); }
        __builtin_amdgcn_sched_barrier(0);
#pragma unroll
        for (int vb = 0; vb < 2; ++vb)
#pragma unroll
            for (int ss = 0; ss < 2; ++ss) O[vb] = __builtin_amdgcn_mfma_f32_32x32x16_bf16(Vf[vb][ss], Pf[ss], ss == 0 ? f32x16{} : O[vb], 0, 0, 0);
#ifndef SC_NO3
#pragma unroll
        for (int kb = 0; kb < NKB; ++kb) {
            __builtin_amdgcn_sched_barrier(0);
            f32x4s er[4];
#pragma unroll
            for (int g = 0; g < 4; ++g) er[g] = *(const LAS f32x4s*)(VEC + 2 * DK + 32 * kb + 8 * g + 4 * hh);
#pragma unroll
            for (int vb = 0; vb < 2; ++vb)
#pragma unroll
                for (int ss = 0; ss < 2; ++ss) { u32x4s w;
#pragma unroll
                    for (int jj = 0; jj < 4; ++jj) { const int g0 = 8 * ss + 2 * jj; w[jj] = cvtpk(S[kb][vb][g0] * er[g0 >> 2][g0 & 3], S[kb][vb][g0 + 1] * er[(g0 + 1) >> 2][(g0 + 1) & 3]); }
                    O[vb] = __builtin_amdgcn_mfma_f32_32x32x16_bf16(__builtin_bit_cast(bf16x8s, w), QR[2 * kb + ss], O[vb], 0, 0, 0); }
        }
#endif
    }
    __builtin_amdgcn_sched_barrier(0);
#ifndef SC_NO4
#pragma unroll
    for (int kb = 0; kb < NKB; ++kb) {
        __builtin_amdgcn_sched_barrier(0);
        if (FULL) {
            const int col = pi16(32 * kb + r);
#pragma unroll
            for (int ss = 0; ss < 2; ++ss) { u32x4s w;
#pragma unroll
                for (int jj = 0; jj < 4; ++jj) { const int e0 = ss * 8 + 2 * jj;
                    const unsigned lo = *(const LAS unsigned short*)(TZ + (tokT(e0, hh) * PE + col) * 2), hi = *(const LAS unsigned short*)(TZ + (tokT(e0 + 1, hh) * PE + col) * 2);
                    w[jj] = lo | (hi << 16); }
                KT[kb][ss] = __builtin_bit_cast(bf16x8s, w); }
        }
        f32x4s gs[4], gu[4];
#pragma unroll
        for (int g = 0; g < 4; ++g) { gs[g] = *(const LAS f32x4s*)(VEC + 32 * kb + 8 * g + 4 * hh); gu[g] = *(const LAS f32x4s*)(VEC + DK + 32 * kb + 8 * g + 4 * hh); }
#pragma unroll
        for (int vb = 0; vb < 2; ++vb) { f32x16 U = {};
#pragma unroll
            for (int ss = 0; ss < 2; ++ss) U = __builtin_amdgcn_mfma_f32_32x32x16_bf16(KT[kb][ss], Vf[vb][ss], U, 0, 0, 0);
#pragma unroll
            for (int g = 0; g < 16; ++g) S[kb][vb][g] = S[kb][vb][g] * gs[g >> 2][g & 3] + U[g] * gu[g >> 2][g & 3]; }
    }
#endif
    LDS_WAIT(); asm volatile("" ::: "memory");
}

template <int DK, bool HG>
__device__ __forceinline__ void scan_unit(const Frame& F, const Args& a, int layer, int b, int h, int unit) {
    constexpr int NKB = DK / 32;
    int lane0 = F.lane; asm volatile("" : "+v"(lane0));
    Ctx<DK, HG> c; c.P = (const bf16*)(a.ws + WS_PROJ); c.A = (const float*)(a.ws + WS_A); c.lane = lane0; c.r = lane0 & 31; c.hh = lane0 >> 5; c.lw = F.lds + F.wave * WAVE_LDS;
    c.qcol = HG ? PQ_HQ + h * 64 : PQ_GQ + h * 32; c.kcol[0] = HG ? PQ_HZF + h * 64 : PQ_GK + h * 32; c.kcol[1] = HG ? PQ_HZB + h * 64 : PQ_GK + h * 32; c.vcol = HG ? PQ_HI + h * 64 : PQ_GV + h * 64;
    const int r = c.r, hh = c.hh, w = F.wave, lane = lane0;
    if (HG) {
#pragma unroll
        for (int kb = 0; kb < NKB; ++kb) { float lgt[DEPTH], mx = -1e30f;
#pragma unroll
            for (int l = 0; l < DEPTH; ++l) { lgt[l] = a.lb_logits[l * 256 + h * 64 + 32 * kb + r]; mx = fmaxf(mx, lgt[l]); }
            float sum = 0.f;
#pragma unroll
            for (int l = 0; l < DEPTH; ++l) { lgt[l] = __expf(lgt[l] - mx); sum += lgt[l]; }
            float cum = 0.f;
#pragma unroll
            for (int l = 1; l < DEPTH; ++l) { if (l <= layer) cum += lgt[l] / sum; }
            c.lb[kb] = cum; }
    } else { c.lb[0] = 0.f; }
#pragma unroll
    for (int d = 0; d < 2; ++d) { u32x4s w = {0u, 0u, 0u, 0u}; c.ba[d] = 0.f;
        if (!HG) { const float* w2 = (d ? a.gla_wa2_b : a.gla_wa2_f) + (size_t)layer * 16 * 128 + (size_t)(8 * hh) * 128 + h * 32 + r;
#pragma unroll
            for (int jj = 0; jj < 4; ++jj) w[jj] = cvtpk(w2[(2 * jj) * 128], w2[(2 * jj + 1) * 128]);
            c.ba[d] = (d ? a.gla_ba_b : a.gla_ba_f)[layer * 128 + h * 32 + r]; }
        c.wbf[d] = __builtin_bit_cast(bf16x8s, w); }
    float* XS = (float*)(a.ws + WS_XCH + (size_t)unit * XCH_UNIT); float* XB = XS + 8 * 2 * 4 * 16 * 64;
    float* OSC = (float*)(a.ws + WS_OSC) + (size_t)unit * (64 * 32 * 64);
    const size_t rowseg = (size_t)b * SEQ + w * SEGT;
    f32x16 S[NKB][2]; f32x16 O[2]; float Bseg[NKB];
#if !defined(SCAN_NO_L1)
#pragma unroll
    for (int dir = 0; dir < 2; ++dir) {
#pragma unroll
        for (int kb = 0; kb < NKB; ++kb) { S[kb][0] = f32x16{}; S[kb][1] = f32x16{}; Bseg[kb] = 0.f; }
#pragma unroll 1
        for (int ci = 0; ci < NCH; ++ci) { const int cc = dir ? NCH - 1 - ci : ci;
            if (dir == 0) chunk_step<DK, HG, 0, false>(c, rowseg + cc * CH, S, Bseg, O); else chunk_step<DK, HG, 1, false>(c, rowseg + cc * CH, S, Bseg, O); }
        { int ln = lane; asm volatile("" : "+v"(ln));
        float* xs = XS + (size_t)((w * 2 + dir) * 4) * 16 * 64;
#pragma unroll
        for (int kb = 0; kb < NKB; ++kb)
#pragma unroll
            for (int vb = 0; vb < 2; ++vb)
#pragma unroll
                for (int g = 0; g < 16; ++g) xs[(unsigned)(((kb * 2 + vb) * 16 + g) * 64 + ln)] = S[kb][vb][g];
        if ((ln >> 5) == 0) {
#pragma unroll
            for (int kb = 0; kb < NKB; ++kb) XB[(unsigned)((w * 2 + dir) * 64 + 32 * kb + (ln & 31))] = Bseg[kb]; } }
    }
#endif
    VM_WAIT(); __syncthreads();
    __builtin_amdgcn_fence(__ATOMIC_ACQUIRE, "agent"); VM_WAIT();
#if !defined(SCAN_NO_L3)
#pragma unroll
    for (int dir = 0; dir < 2; ++dir) {
#pragma unroll
        for (int kb = 0; kb < NKB; ++kb) { S[kb][0] = f32x16{}; S[kb][1] = f32x16{}; Bseg[kb] = 0.f; }
#pragma unroll 1
        for (int i = 0; i < (dir ? 7 - w : w); ++i) { const int wp = dir ? 7 - i : i; int ln = lane; asm volatile("" : "+v"(ln)); const int hq = ln >> 5;
            const float* xs = XS + (size_t)((wp * 2 + dir) * 4) * 16 * 64; const float* xb = XB + (wp * 2 + dir) * 64;
#pragma unroll
            for (int kb = 0; kb < NKB; ++kb) {
                f32x4s gg[4];
#pragma unroll
                for (int g = 0; g < 4; ++g) { gg[g] = *(const f32x4s*)(xb + (unsigned)(32 * kb + 8 * g + 4 * hq));
#pragma unroll
                    for (int q = 0; q < 4; ++q) gg[g][q] = __expf(gg[g][q]); }
#pragma unroll
                for (int vb = 0; vb < 2; ++vb)
#pragma unroll
                    for (int g = 0; g < 16; ++g) S[kb][vb][g] = S[kb][vb][g] * gg[g >> 2][g & 3] + xs[(unsigned)(((kb * 2 + vb) * 16 + g) * 64 + ln)]; }
        }
#pragma unroll 1
        for (int ci = 0; ci < NCH; ++ci) { const int cc = dir ? NCH - 1 - ci : ci; const size_t row0 = rowseg + cc * CH;
            float* osc = OSC + (size_t)((w * NCH + cc) * 32) * 64; int ln = lane; asm volatile("" : "+v"(ln)); const int rq = ln & 31, hq = ln >> 5;
            if (dir == 0) {
                chunk_step<DK, HG, 0, true>(c, row0, S, Bseg, O);
#pragma unroll
                for (int vb = 0; vb < 2; ++vb)
#pragma unroll
                    for (int g = 0; g < 16; ++g) osc[(unsigned)((vb * 16 + g) * 64 + ln)] = O[vb][g];
            } else {
                chunk_step<DK, HG, 1, true>(c, row0, S, Bseg, O);
                float ss = 0.f;
#pragma unroll
                for (int vb = 0; vb < 2; ++vb)
#pragma unroll
                    for (int g = 0; g < 16; ++g) { const float v = O[vb][g] + osc[(unsigned)((vb * 16 + g) * 64 + ln)]; O[vb][g] = v; ss += v * v; }
                ss += other_half(ss, hq);
                const float rs = 1.f / sqrtf(ss * (1.f / 64.f) + EPS);
                const bf16* gp = c.P + row0 * NP + (HG ? PQ_HG : PQ_GG) + h * 64; bf16* mp = (bf16*)(a.ws + WS_MIX) + row0 * DM + (HG ? 768 : 0) + h * 64;
                const float* nwp = (HG ? a.hgrn_norm : a.gla_norm) + layer * 64;
#pragma unroll
                for (int vb = 0; vb < 2; ++vb)
#pragma unroll
                    for (int g = 0; g < 4; ++g) { const u32x2s gq = *(const u32x2s*)(gp + (unsigned)(rq * NP + 4 * hq + 32 * vb + 8 * g)); const f32x4s nw = *(const f32x4s*)(nwp + (unsigned)(4 * hq + 32 * vb + 8 * g));
                        float gv[4] = {__uint_as_float(gq[0] << 16), __uint_as_float(gq[0] & 0xffff0000u), __uint_as_float(gq[1] << 16), __uint_as_float(gq[1] & 0xffff0000u)}; float ov[4];
#pragma unroll
                        for (int q = 0; q < 4; ++q) { const float sg = gv[q] / (1.f + __expf(-gv[q])); ov[q] = O[vb][4 * g + q] * rs * nw[q] * sg; }
                        u32x2s ow; ow[0] = cvtpk(ov[0], ov[1]); ow[1] = cvtpk(ov[2], ov[3]); *(u32x2s*)(mp + (unsigned)(rq * DM + 4 * hq + 32 * vb + 8 * g)) = ow; }
            }
        }
        if (dir == 0) { VM_WAIT(); }
    }
#endif
}
}

__device__ __forceinline__ void scan_phase_mfma(const Frame& F, const Args& a, int layer) {
    const int step = (F.G >= 2) ? (F.G >> 1) : 1;
    for (int p = (F.vcu & 1) ? 128 : (F.vcu >> 1); p < 128; p += step) {
        const int type = p >> 6, b = (p & 63) >> 2, h = p & 3;
#if !defined(SCAN_NO_HG)
        if (type) scan::scan_unit<64, true>(F, a, layer, b, h, p);
#endif
#if !defined(SCAN_NO_GLA)
        if (!type) scan::scan_unit<32, false>(F, a, layer, b, h, p);
#endif
        VM_WAIT(); __syncthreads();
    }
}
#define SCAN_PHASE scan_phase_mfma
__device__ __forceinline__ void attn_phase(const Frame& F, const Args& a, int layer) {
    const bf16* P = (const bf16*)(a.ws + WS_PROJ); bf16* MX = (bf16*)(a.ws + WS_MIX);
    const float linit = 0.8f - 0.6f * expf(-0.3f * (float)layer);
    const float d1 = wave_sum(a.lq1[layer * 64 + F.lane] * a.lk1[layer * 64 + F.lane]), d2 = wave_sum(a.lq2[layer * 64 + F.lane] * a.lk2[layer * 64 + F.lane]);
    const float lam = expf(d1) - expf(d2) + linit;
    const int NU = BATCH * 4 * (SEQ / 128), per = (NU + F.G - 1) / F.G;
    for (int i = 0; i < per; ++i) { const int u = F.vcu * per + i; if (u >= NU) break;
        const int bh = u >> 4, qb = u & 15, b = bh >> 2, h = bh & 3; const size_t row0 = (size_t)b * SEQ + qb * 128;
        dattn::diff_unit(P + row0 * NP + PQ_DQ + h * 128, P + (size_t)b * SEQ * NP + PQ_DK + h * 128, P + (size_t)b * SEQ * NP + PQ_DV + h * 128,
                         P + row0 * NP + PQ_DG + h * 128, MX + row0 * DM + 256 + h * 128, lam, a.diff_norm + layer * 128, 1.f - linit, (char*)F.lds, F.wave); }
}

__global__ void __launch_bounds__(NWAVES * 64, 2) fwd_mega(Args args) {
    extern __shared__ __attribute__((aligned(16))) unsigned char lds[];
    cg::grid_group grid = cg::this_grid();
    const int wave_s = __builtin_amdgcn_readfirstlane((int)threadIdx.x >> 6);
#define MKFRAME() Frame F; { int t_ = wave_s * 64 + lane_id_opaque(); asm volatile("" : "+v"(t_)); F.lds = (LAS unsigned char*)lds; F.tid = t_; F.lane = t_ & 63; F.wave = wave_s; \
    F.G = gridDim.x; const int bx = blockIdx.x; F.vcu = (F.G % 8 == 0) ? (bx % 8) * (F.G / 8) + bx / 8 : bx; }
    constexpr int ARGTAB = LDS_BYTES - 256, NARGW = (int)(sizeof(Args) / 4);
    { const unsigned* src = (const unsigned*)&args; if (threadIdx.x < NARGW) ((LAS unsigned*)(lds + ARGTAB))[threadIdx.x] = src[threadIdx.x]; }
    __syncthreads();
    const int lo = args.ph_lo, hi = args.ph_hi;
#define LDARGS() Args A_; { unsigned off_ = ARGTAB; asm volatile("" : "+s"(off_)); const LAS unsigned* tab_ = (const LAS unsigned*)((LAS unsigned char*)lds + off_); unsigned* dst_ = (unsigned*)&A_; \
    _Pragma("unroll") for (int i_ = 0; i_ < NARGW; ++i_) dst_[i_] = __builtin_amdgcn_readfirstlane(tab_[i_]); }
#define IN(k) (lo <= (k) && (k) < hi)
#define SEAM(k) do { if (IN(k) && IN((k) + 1)) grid.sync(); } while (0)
#ifndef NO_P0
    if (IN(0)) { MKFRAME(); LDARGS(); p0_prologue(F, A_); }
#endif
    SEAM(0);
    for (int layer = 0; layer < DEPTH; ++layer) {
        const int pb = 1 + 4 * layer;
        if (IN(pb)) {
            MKFRAME(); LDARGS(); const Args& args = A_;
            pg8::Gemm g{(const pg8::bf16_t*)(args.ws + WS_H), (const pg8::bf16_t*)(args.ws + WS_WIN) + (size_t)layer * NPA * DM, M, NP, DM};
            pg8::StaticOrder S; S.init(M, NP, F.G, (int)blockIdx.x);
            pg8::EpiProj E{(pg8::bf16_t*)(args.ws + WS_PROJ), (const float*)(args.ws + WS_ROPE), (const float*)(args.ws + WS_ROPE) + SEQ * 32};
#ifndef NO_GA
            pg8::gemm_phase<pg8::EpiProj, pg8::StaticOrder, true, true>(F.lds, g, S, E, wave_s);
#endif
#ifndef NO_LR
            lowrank_phase(F, args, layer);
#endif
        }
        SEAM(pb);
        if (IN(pb + 1)) {
#ifndef NO_SCAN
            { MKFRAME(); LDARGS(); SCAN_PHASE(F, A_, layer); }
#endif
#ifndef NO_ATTN
            { MKFRAME(); LDARGS(); attn_phase(F, A_, layer); }
#endif
        }
        SEAM(pb + 1);
        if (IN(pb + 2)) {
            MKFRAME(); LDARGS(); const Args& args = A_;
            pg8::Gemm g{(const pg8::bf16_t*)(args.ws + WS_MIX), (const pg8::bf16_t*)(args.ws + WS_WOUT) + (size_t)layer * DM * DM, M, DM, DM};
            pg8::StaticOrder S; S.init(M, DM, F.G, (int)blockIdx.x);
            pg8::EpiF32 E{(float*)(args.ws + WS_Y), DM, nullptr};
#ifndef NO_GC
            pg8::gemm_phase<pg8::EpiF32, pg8::StaticOrder, true, true>(F.lds, g, S, E, wave_s);
#endif
        }
        SEAM(pb + 2);
#ifndef NO_PD
        if (IN(pb + 3)) { MKFRAME(); LDARGS(); postnorm_phase(F, A_, layer); }
#endif
        if (layer + 1 < DEPTH) SEAM(pb + 3);
    }
#undef IN
#undef SEAM
}
constexpr int N_PHASES = 1 + 4 * DEPTH;

extern "C" void kernel_launch(void* const* d_in, const int* in_sizes, int n_in, void* d_out, int out_size, void* d_ws, size_t ws_size, hipStream_t stream) {
    static int grid = 0;
    if (grid == 0) {
        if (n_in != 17 || in_sizes[0] != M * DM || out_size != M * DM || ws_size < WS_END) {
            fprintf(stderr, "kernel_launch: shape mismatch n_in %d in0 %d out %d ws %zu (need %zu)\n", n_in, n_in > 0 ? in_sizes[0] : -1, out_size, ws_size, (size_t)WS_END); grid = -1; return; }
        int dev = 0, cus = 0, per_cu = 0;
        if (hipGetDevice(&dev) != hipSuccess || hipDeviceGetAttribute(&cus, hipDeviceAttributeMultiprocessorCount, dev) != hipSuccess) { grid = -1; return; }
        if (hipFuncSetAttribute((const void*)fwd_mega, hipFuncAttributeMaxDynamicSharedMemorySize, LDS_BYTES) != hipSuccess) { fprintf(stderr, "kernel_launch: hipFuncSetAttribute failed\n"); grid = -1; return; }
        if (hipOccupancyMaxActiveBlocksPerMultiprocessor(&per_cu, (const void*)fwd_mega, NWAVES * 64, LDS_BYTES) != hipSuccess || per_cu < 1) { fprintf(stderr, "kernel_launch: occupancy query says %d\n", per_cu); (void)hipGetLastError(); grid = -1; return; }
        grid = cus;
        fprintf(stderr, "kernel_launch: cus %d per_cu %d grid %d ws %zu\n", cus, per_cu, grid, ws_size);
    }
    if (grid < 0) return;
    Args a{};
    a.x = (const float*)d_in[0]; a.norm_pre = (const float*)d_in[1]; a.norm_post = (const float*)d_in[2]; a.w_in = (const float*)d_in[3]; a.w_out = (const float*)d_in[4];
    a.gla_wa2_f = (const float*)d_in[5]; a.gla_ba_f = (const float*)d_in[6]; a.gla_wa2_b = (const float*)d_in[7]; a.gla_ba_b = (const float*)d_in[8]; a.gla_norm = (const float*)d_in[9];
    a.lq1 = (const float*)d_in[10]; a.lk1 = (const float*)d_in[11]; a.lq2 = (const float*)d_in[12]; a.lk2 = (const float*)d_in[13]; a.diff_norm = (const float*)d_in[14];
    a.lb_logits = (const float*)d_in[15]; a.hgrn_norm = (const float*)d_in[16];
    a.out = (float*)d_out; a.ws = (unsigned char*)d_ws; a.ph_lo = 0; a.ph_hi = N_PHASES;
    void* kargs[] = {&a};
    const hipError_t e = hipLaunchCooperativeKernel((const void*)fwd_mega, dim3(grid), dim3(NWAVES * 64), kargs, LDS_BYTES, stream);
    if (e != hipSuccess) fprintf(stderr, "kernel_launch: cooperative launch failed: %s (grid %d)\n", hipGetErrorString(e), grid);
}
```

```cpp
#include <hip/hip_runtime.h>
#include <hip/hip_cooperative_groups.h>
#include <hip/hip_bf16.h>
#include <cstdio>
#include <cstdint>
#include <cmath>
namespace cg = cooperative_groups;
__device__ __forceinline__ int lane_id_opaque() { int x; asm volatile("v_mbcnt_lo_u32_b32 %0, -1, 0\n\tv_mbcnt_hi_u32_b32 %0, -1, %0" : "=v"(x)); return x; }
template <int MASK> __device__ __forceinline__ float xor_shfl(float v) {
    if constexpr (MASK == 32) { auto rr = __builtin_amdgcn_permlane32_swap(__float_as_uint(v), __float_as_uint(v), false, false);
        return __uint_as_float(rr[0] ^ rr[1] ^ __float_as_uint(v)); }
    else return __int_as_float(__builtin_amdgcn_ds_swizzle(__float_as_int(v), (MASK << 10) | 0x1f));
}
namespace pg8 {
#define PG8_LAS __attribute__((address_space(3)))
typedef unsigned short bf16_t;
typedef short bf16x8 __attribute__((ext_vector_type(8)));
typedef float f32x4 __attribute__((ext_vector_type(4)));
typedef unsigned u32x4 __attribute__((ext_vector_type(4)));
constexpr int BM = 256, BK = 64, HALF = 128, HTB = HALF * BK * 2  , STAGE_BYTES = 8 * HTB, NXCD = 8, WGM = 8;

__host__ __device__ __forceinline__ int lds_byte(int r, int c) { const int st = (r >> 4) * 2 + (c >> 5), rr = r & 15, cc = c & 31, ob = rr * 64 + cc * 2; return st * 1024 + (ob ^ (((ob >> 9) & 1) << 5)); }
__host__ __device__ __forceinline__ void stage_rc(int b, int& R, int& C) { const int st = b / 1024, sb = b % 1024, swz = sb ^ (((sb >> 9) & 1) << 5); R = (st >> 1) * 16 + swz / 64; C = (st & 1) * 32 + (swz % 64) / 2; }
__host__ __device__ __forceinline__ int perm32(int rho) { const int n = rho >> 4, i = rho & 15; return 8 * (i >> 2) + 4 * n + (i & 3); }

struct Unit { int pm, pn; };
struct Gemm { const bf16_t* A; const bf16_t* Bt; int M, N, K; };

struct StaticOrder {
    int nM, nN, nwg, G, c;
    __host__ __device__ void init(int M, int N, int G_, int c_) { nM = M / BM; nN = N / BM; nwg = nM * nN; G = G_; c = c_; }
    __host__ __device__ bool next(int i, Unit& u) const {
        const long L = (long)i * G + c; if (L >= nwg) return false;
        int wgid = (int)L; { const int q = nwg / NXCD, r = nwg % NXCD, xcd = wgid % NXCD, off = wgid / NXCD; wgid = (xcd < r ? xcd * (q + 1) : r * (q + 1) + (xcd - r) * q) + off; }
        const int nig = WGM * nN, gid = wgid / nig, fm = gid * WGM, gsz = (nM - fm) < WGM ? (nM - fm) : WGM;
        u.pm = fm + ((wgid % nig) % gsz); u.pn = (wgid % nig) / gsz; return true;
    }
    __device__ __forceinline__ void a_ready(const Unit&) const {}
    __device__ __forceinline__ void done(const Unit&) const {}
};
__device__ __forceinline__ unsigned cvt_pk_bf16(float lo, float hi) { unsigned r; asm volatile("v_cvt_pk_bf16_f32 %0, %1, %2" : "=v"(r) : "v"(lo), "v"(hi)); return r; }
typedef float f32x2 __attribute__((ext_vector_type(2)));
struct EpiF32 {
    static constexpr bool PERM = false, AFTER_DRAIN = false;
    float* C; int ldc; const float* bias;
    __device__ __forceinline__ void operator()(const f32x4 (&acc)[2][2][4][2], const Unit& u, int wr, int wc, int fr, int fq) const {
        const int row0 = u.pm * BM + wr * 64 + fr, col0 = u.pn * BM + wc * 32 + 4 * fq;
        f32x4 bv[2][2];
#pragma unroll
        for (int bj = 0; bj < 2; ++bj)
#pragma unroll
            for (int n = 0; n < 2; ++n) bv[bj][n] = bias ? *(const f32x4*)(bias + col0 + bj * HALF + n * 16) : (f32x4){0.f, 0.f, 0.f, 0.f};
#pragma unroll
        for (int ai = 0; ai < 2; ++ai)
#pragma unroll
            for (int m = 0; m < 4; ++m) { float* rowp = C + (size_t)(row0 + ai * HALF + m * 16) * ldc + col0;
#pragma unroll
                for (int bj = 0; bj < 2; ++bj)
#pragma unroll
                    for (int n = 0; n < 2; ++n) *(f32x4*)(rowp + bj * HALF + n * 16) = acc[ai][bj][m][n] + bv[bj][n]; }
    }
};
#define PG8_GAS __attribute__((address_space(1)))
constexpr float QSCALE = 0.125f * 1.4426950408889634f;
struct EpiProj {
    static constexpr bool PERM = true, AFTER_DRAIN = false; static constexpr int NST = 16;
    bf16_t* O; const float* cosT; const float* sinT; const float* lbrow; const float* rstd;
    __device__ __forceinline__ void operator()(const f32x4 (&acc)[2][2][4][2], const Unit& u, int wr, int wc, int fr, int fq) const {
        const int row0 = u.pm * BM + wr * 64 + fr, col0 = u.pn * BM + wc * 32 + 8 * fq;
        const bool rope = (u.pn >= 3 && u.pn <= 6), hgt = (u.pn >= 12);
        const int j8 = (wc & 1) * 4 + fq;
        float rs[2][4];
#pragma unroll
        for (int ai = 0; ai < 2; ++ai)
#pragma unroll
            for (int m = 0; m < 4; ++m) rs[ai][m] = *(const PG8_GAS float*)(rstd + row0 + ai * HALF + m * 16);
        if (rope) {
            const float qs = (u.pn == 3 || u.pn == 4) ? QSCALE : 1.f;
#pragma unroll
            for (int ai = 0; ai < 2; ++ai) { f32x4 c4[4], s4[4];
#pragma unroll
                for (int m = 0; m < 4; ++m) { const int pos = (row0 + ai * HALF + m * 16) & 2047; c4[m] = *(const PG8_GAS f32x4*)(cosT + pos * 32 + 4 * j8); s4[m] = *(const PG8_GAS f32x4*)(sinT + pos * 32 + 4 * j8); }
#pragma unroll
                for (int m = 0; m < 4; ++m) { bf16_t* rowp = O + (size_t)(row0 + ai * HALF + m * 16) * 4096 + col0; const float r = rs[ai][m] * qs;
#pragma unroll
                    for (int bj = 0; bj < 2; ++bj) { const f32x4 a0 = acc[ai][bj][m][0] * r, a1 = acc[ai][bj][m][1] * r;
                        const f32x4 v0 = a0 * c4[m] - a1 * s4[m], v1 = a1 * c4[m] + a0 * s4[m];
                        u32x4 w; w.x = cvt_pk_bf16(v0[0], v0[1]); w.y = cvt_pk_bf16(v0[2], v0[3]); w.z = cvt_pk_bf16(v1[0], v1[1]); w.w = cvt_pk_bf16(v1[2], v1[3]);
                        *(PG8_GAS u32x4*)(rowp + bj * HALF) = w; } } }
            return;
        }
        f32x4 lb0 = (f32x4){0.f, 0.f, 0.f, 0.f}, lb1 = lb0;
        if (hgt) { lb0 = *(const PG8_GAS f32x4*)(lbrow + (u.pn & 1) * 128 + wc * 32 + 8 * fq); lb1 = *(const PG8_GAS f32x4*)(lbrow + (u.pn & 1) * 128 + wc * 32 + 8 * fq + 4); }
#pragma unroll
        for (int ai = 0; ai < 2; ++ai)
#pragma unroll
            for (int m = 0; m < 4; ++m) { bf16_t* rowp = O + (size_t)(row0 + ai * HALF + m * 16) * 4096 + col0; const float r = rs[ai][m];
#pragma unroll
                for (int bj = 0; bj < 2; ++bj) { f32x4 v0 = acc[ai][bj][m][0] * r, v1 = acc[ai][bj][m][1] * r;
                    if (hgt && bj == 0) {
#pragma unroll
                        for (int e = 0; e < 4; ++e) { const float z0 = v0[e], z1 = v1[e];
                            const float e0 = __expf(-fabsf(z0)), r0 = __builtin_amdgcn_rcpf(1.f + e0), sg0 = z0 >= 0.f ? r0 : e0 * r0;
                            const float e1 = __expf(-fabsf(z1)), r1 = __builtin_amdgcn_rcpf(1.f + e1), sg1 = z1 >= 0.f ? r1 : e1 * r1;
                            v0[e] = __builtin_amdgcn_logf(fmaxf(lb0[e] + (1.f - lb0[e]) * sg0, 1e-30f)); v1[e] = __builtin_amdgcn_logf(fmaxf(lb1[e] + (1.f - lb1[e]) * sg1, 1e-30f)); } }
                    u32x4 w; w.x = cvt_pk_bf16(v0[0], v0[1]); w.y = cvt_pk_bf16(v0[2], v0[3]); w.z = cvt_pk_bf16(v1[0], v1[1]); w.w = cvt_pk_bf16(v1[2], v1[3]);
                    *(PG8_GAS u32x4*)(rowp + bj * HALF) = w; } }
    }
};
struct EpiY {
    static constexpr bool PERM = true, AFTER_DRAIN = false; static constexpr int NST = 16;
    bf16_t* O;
    __device__ __forceinline__ void operator()(const f32x4 (&acc)[2][2][4][2], const Unit& u, int wr, int wc, int fr, int fq) const {
        const int row0 = u.pm * BM + wr * 64 + fr, col0 = u.pn * BM + wc * 32 + 8 * fq;
#pragma unroll
        for (int ai = 0; ai < 2; ++ai)
#pragma unroll
            for (int m = 0; m < 4; ++m) { bf16_t* rowp = O + (size_t)(row0 + ai * HALF + m * 16) * 1024 + col0;
#pragma unroll
                for (int bj = 0; bj < 2; ++bj) { const f32x4 v0 = acc[ai][bj][m][0], v1 = acc[ai][bj][m][1];
                    u32x4 w; w.x = cvt_pk_bf16(v0[0], v0[1]); w.y = cvt_pk_bf16(v0[2], v0[3]); w.z = cvt_pk_bf16(v1[0], v1[1]); w.w = cvt_pk_bf16(v1[2], v1[3]);
                    *(PG8_GAS u32x4*)(rowp + bj * HALF) = w; } }
    }
};
template <class Epi, class Sched, bool ALIGN_EPI = false, bool SP2 = false>
__device__ __forceinline__ void gemm_phase(PG8_LAS unsigned char* lds, const Gemm g, const Sched& S, const Epi& E, int wave_s, int epi_rep = 0) {
    int tid_ = wave_s * 64 + lane_id_opaque(); asm volatile("" : "+v"(tid_));
    const int tid = tid_, wid = __builtin_amdgcn_readfirstlane(tid >> 6), lane = tid & 63, wr = wid >> 2, wc = wid & 3, fr = lane & 15, fq = lane >> 4;
    const int K = g.K, nt = K / BK;
    unsigned voffA[2], voffB[2];
#pragma unroll
    for (int i = 0; i < 2; ++i) { int R, C; stage_rc(tid * 16 + i * 8192, R, C); const int Rb = Epi::PERM ? ((R & ~31) + perm32(R & 31)) : R;
        voffA[i] = (unsigned)(R * K + C) * 2u; voffB[i] = (unsigned)(Rb * K + C) * 2u; }
    const size_t kstep = (size_t)(BK * 2);
    const size_t hstep = (size_t)HALF * K * 2;
    const size_t tstep = 2 * hstep;
    const unsigned ldsw = (unsigned)wid * 1024u;
    const int aoff = lds_byte(wr * 64 + fr, fq * 8), boff = lds_byte(wc * 32 + fr, fq * 8);
#define PG8_SA(b, h) (((b) * 2 + (h)) * HTB)
#define PG8_SB(b, h) ((4 + (b) * 2 + (h)) * HTB)
#define PG8_STAGE(bufoff, gbase, voff) do { _Pragma("unroll") for (int _i = 0; _i < 2; ++_i) \
        __builtin_amdgcn_global_load_lds((const unsigned*)((const char*)(gbase) + (voff)[_i]), (PG8_LAS unsigned*)(lds + (bufoff) + ldsw + _i * 8192), 16, 0, 0); } while (0)
#define PG8_LDA(dst, b, h) do { _Pragma("unroll") for (int m = 0; m < 4; ++m) _Pragma("unroll") for (int k = 0; k < 2; ++k) dst[m][k] = *(const PG8_LAS bf16x8*)(lds + PG8_SA(b, h) + aoff + m * 2048 + k * 1024); } while (0)
#define PG8_LDB(dst, b, h) do { _Pragma("unroll") for (int n = 0; n < 2; ++n) _Pragma("unroll") for (int k = 0; k < 2; ++k) dst[n][k] = *(const PG8_LAS bf16x8*)(lds + PG8_SB(b, h) + boff + n * 2048 + k * 1024); } while (0)
#define PG8_MMA(ai, bj, At, Bt) do { __builtin_amdgcn_s_setprio(1); _Pragma("unroll") for (int m = 0; m < 4; ++m) _Pragma("unroll") for (int n = 0; n < 2; ++n) _Pragma("unroll") for (int k = 0; k < 2; ++k) \
        acc[ai][bj][m][n] = __builtin_amdgcn_mfma_f32_16x16x32_bf16(Bt[n][k], At[m][k], acc[ai][bj][m][n], 0, 0, 0); __builtin_amdgcn_s_setprio(0); } while (0)
#define PG8_WAIT_V(n) asm volatile("s_waitcnt vmcnt(" #n ")" ::: "memory")
#define PG8_WAIT_L(n) asm volatile("s_waitcnt lgkmcnt(" #n ")" ::: "memory")
#define PG8_BAR __builtin_amdgcn_s_barrier()
#define PG8_SCHED __builtin_amdgcn_sched_barrier(0)
    Unit cur, nxt; int ui = 0;
    if (!S.next(0, cur)) return;
    f32x4 acc[2][2][4][2];
#pragma unroll
    for (int a = 0; a < 2; ++a)
#pragma unroll
        for (int b = 0; b < 2; ++b)
#pragma unroll
            for (int m = 0; m < 4; ++m)
#pragma unroll
                for (int n = 0; n < 2; ++n) acc[a][b][m][n] = (f32x4){0.f, 0.f, 0.f, 0.f};
    bf16x8 At[4][2], B0[2][2], B1[2][2];
    const char* cA = (const char*)g.A + (size_t)cur.pm * tstep; const char* cB = (const char*)g.Bt + (size_t)cur.pn * tstep;
    S.a_ready(cur);
    if constexpr (SP2) {
        PG8_STAGE(PG8_SB(0, 0), cB, voffB); PG8_STAGE(PG8_SB(0, 1), cB + hstep, voffB); PG8_STAGE(PG8_SA(0, 0), cA, voffA); PG8_STAGE(PG8_SA(0, 1), cA + hstep, voffA);
        if (wr == 1) PG8_BAR;
        PG8_WAIT_V(2); PG8_BAR;
        PG8_STAGE(PG8_SB(1, 0), cB + kstep, voffB); PG8_STAGE(PG8_SA(1, 0), cA + kstep, voffA); PG8_STAGE(PG8_SB(1, 1), cB + hstep + kstep, voffB);
        PG8_WAIT_V(6); PG8_BAR;
    } else {
        PG8_STAGE(PG8_SB(0, 0), cB, voffB); PG8_STAGE(PG8_SA(0, 0), cA, voffA); PG8_STAGE(PG8_SB(0, 1), cB + hstep, voffB); PG8_STAGE(PG8_SA(0, 1), cA + hstep, voffA);
        if (wr == 1) PG8_BAR;
        PG8_WAIT_V(4); PG8_BAR;
        PG8_STAGE(PG8_SB(1, 0), cB + kstep, voffB); PG8_STAGE(PG8_SA(1, 0), cA + kstep, voffA); PG8_STAGE(PG8_SB(1, 1), cB + hstep + kstep, voffB);
        PG8_WAIT_V(6); PG8_BAR;
    }
    for (;;) {
        const bool has_next = S.next(ui + 1, nxt);
        const char* nA = has_next ? (const char*)g.A + (size_t)nxt.pm * tstep : cA; const char* nB = has_next ? (const char*)g.Bt + (size_t)nxt.pn * tstep : cB;
        for (int t = 0; t < nt; t += 2) {
            const bool last = (t == nt - 2);
            const char* a1 = cA + (size_t)(t + 1) * kstep;
            const char* a2 = last ? nA : cA + (size_t)(t + 2) * kstep; const char* b2 = last ? nB : cB + (size_t)(t + 2) * kstep;
            const char* a3 = a2 + kstep; const char* b3 = b2 + kstep;
            if (last && has_next) S.a_ready(nxt);
            if constexpr (SP2) {
            PG8_LDB(B0, 0, 0); PG8_LDB(B1, 0, 1); PG8_SCHED; PG8_LDA(At, 0, 0); PG8_STAGE(PG8_SA(1, 1), a1 + hstep, voffA);
            PG8_WAIT_V(8); PG8_WAIT_L(0); PG8_BAR; PG8_MMA(0, 0, At, B0); PG8_MMA(0, 1, At, B1); PG8_BAR; PG8_SCHED;
            PG8_LDA(At, 0, 1); PG8_STAGE(PG8_SB(0, 0), b2, voffB); PG8_STAGE(PG8_SB(0, 1), b2 + hstep, voffB); PG8_STAGE(PG8_SA(0, 0), a2, voffA);
            PG8_WAIT_V(8); PG8_WAIT_L(0); PG8_BAR; PG8_MMA(1, 0, At, B0); PG8_MMA(1, 1, At, B1); PG8_BAR; PG8_SCHED;
            PG8_LDB(B0, 1, 0); PG8_LDB(B1, 1, 1); PG8_SCHED; PG8_LDA(At, 1, 0); PG8_STAGE(PG8_SA(0, 1), a2 + hstep, voffA);
            PG8_WAIT_V(8); PG8_WAIT_L(0); PG8_BAR; PG8_MMA(0, 0, At, B0); PG8_MMA(0, 1, At, B1); PG8_BAR; PG8_SCHED;
            PG8_LDA(At, 1, 1); PG8_STAGE(PG8_SB(1, 0), b3, voffB); PG8_STAGE(PG8_SB(1, 1), b3 + hstep, voffB); PG8_STAGE(PG8_SA(1, 0), a3, voffA);
            PG8_WAIT_V(8); PG8_WAIT_L(0); PG8_BAR; PG8_MMA(1, 0, At, B0); PG8_MMA(1, 1, At, B1); PG8_BAR; PG8_SCHED;
            } else {
            PG8_LDB(B0, 0, 0); PG8_SCHED; PG8_LDA(At, 0, 0); PG8_STAGE(PG8_SA(1, 1), a1 + hstep, voffA);
            PG8_WAIT_L(8); PG8_BAR; PG8_WAIT_L(0); PG8_MMA(0, 0, At, B0); PG8_BAR; PG8_SCHED;
            PG8_LDB(B1, 0, 1); PG8_STAGE(PG8_SB(0, 0), b2, voffB);
            PG8_BAR; PG8_WAIT_L(0); PG8_MMA(0, 1, At, B1); PG8_BAR;
            PG8_LDA(At, 0, 1); PG8_STAGE(PG8_SA(0, 0), a2, voffA);
            PG8_BAR; PG8_WAIT_L(0); PG8_MMA(1, 0, At, B0); PG8_BAR; PG8_SCHED;
            PG8_STAGE(PG8_SB(0, 1), b2 + hstep, voffB);
            PG8_WAIT_V(6); PG8_BAR; PG8_MMA(1, 1, At, B1); PG8_BAR;
            PG8_LDB(B0, 1, 0); PG8_SCHED; PG8_LDA(At, 1, 0); PG8_STAGE(PG8_SA(0, 1), a2 + hstep, voffA);
            PG8_WAIT_L(8); PG8_BAR; PG8_WAIT_L(0); PG8_MMA(0, 0, At, B0); PG8_BAR; PG8_SCHED;
            PG8_LDB(B1, 1, 1); PG8_STAGE(PG8_SB(1, 0), b3, voffB);
            PG8_BAR; PG8_WAIT_L(0); PG8_MMA(0, 1, At, B1); PG8_BAR;
            PG8_LDA(At, 1, 1); PG8_STAGE(PG8_SA(1, 0), a3, voffA);
            PG8_BAR; PG8_WAIT_L(0); PG8_MMA(1, 0, At, B0); PG8_BAR; PG8_SCHED;
            PG8_STAGE(PG8_SB(1, 1), b3 + hstep, voffB);
            PG8_WAIT_V(6); PG8_BAR; PG8_MMA(1, 1, At, B1); PG8_BAR;
            }
        }
        if constexpr (ALIGN_EPI) { if (wr == 0) PG8_BAR; }
        if constexpr (!Epi::AFTER_DRAIN) { if (epi_rep >= 0) E(acc, cur, wr, wc, fr, fq); else {
#pragma unroll
                for (int a_ = 0; a_ < 2; ++a_)
#pragma unroll
                    for (int b_ = 0; b_ < 2; ++b_)
#pragma unroll
                        for (int m_ = 0; m_ < 4; ++m_) asm volatile("" :: "v"(acc[a_][b_][m_][0]), "v"(acc[a_][b_][m_][1])); }
            for (int er_ = 0; er_ < epi_rep; ++er_) E(acc, cur, wr, wc, fr, fq); S.done(cur); }
        if (!has_next) break;
#pragma unroll
        for (int a = 0; a < 2; ++a)
#pragma unroll
            for (int b = 0; b < 2; ++b)
#pragma unroll
                for (int m = 0; m < 4; ++m)
#pragma unroll
                    for (int n = 0; n < 2; ++n) acc[a][b][m][n] = (f32x4){0.f, 0.f, 0.f, 0.f};
        cur = nxt; cA = nA; cB = nB; ++ui;
        if constexpr (ALIGN_EPI) { if (wr == 1) PG8_BAR; }
    }
    PG8_WAIT_V(0);
    if constexpr (!ALIGN_EPI) { if (wr == 0) PG8_BAR; }
    PG8_BAR;
    if constexpr (Epi::AFTER_DRAIN) { E.fused(acc, cur, wr, wc, fr, fq, lds, wid, lane); S.done(cur); }
#undef PG8_SA
#undef PG8_SB
#undef PG8_STAGE
#undef PG8_LDA
#undef PG8_LDB
#undef PG8_MMA
#undef PG8_WAIT_V
#undef PG8_WAIT_L
#undef PG8_BAR
#undef PG8_SCHED
}
}
namespace dattn {
using bf16x8 = __attribute__((ext_vector_type(8))) short;
using s16x4  = __attribute__((ext_vector_type(4))) short;
using f32x16 = __attribute__((ext_vector_type(16))) float;
using u32x4  = __attribute__((ext_vector_type(4))) unsigned;
typedef unsigned short bf16r;
constexpr int NW = 8, QBLK = 32, KVBLK = 64, SEQ = 2048, LDP = 4096;
constexpr float SCALE = 0.125f, THR = 8.f;
constexpr int TILE_B = KVBLK * 128 * 2, NKSLOT = 3, NVSLOT = 5, VRING = NKSLOT * TILE_B; constexpr size_t SHM_WS = 131072;
#define KSWZ(row, colB) ((row) * 256 + ((colB) ^ ((((row) & 7) << 4) | ((((row) >> 3) & 1) << 7))))
#define SBAR() __builtin_amdgcn_sched_barrier(0)
__device__ __forceinline__ int crow(int r, int hi) { return (r & 3) + 8 * (r >> 2) + 4 * hi; }
__device__ __forceinline__ unsigned cvtpk(float lo, float hi) { unsigned r; asm volatile("v_cvt_pk_bf16_f32 %0, %1, %2" : "=v"(r) : "v"(lo), "v"(hi)); return r; }

constexpr float THR2 = THR * 1.4426950408889634f;
template <int VAR = 0, bool FIRST = false> __device__ __forceinline__ void partialSM(f32x16& p0, f32x16& p1, f32x16& negm, float& alpha) {
  if (VAR & 32) { alpha = 1.f; return; }
  float pmax = p0[0];
#pragma unroll
  for (int r = 1; r < 16; ++r) pmax = fmaxf(pmax, p0[r]);
#pragma unroll
  for (int r = 0; r < 16; ++r) pmax = fmaxf(pmax, p1[r]);
  { auto rr = __builtin_amdgcn_permlane32_swap(__float_as_uint(pmax), __float_as_uint(pmax), false, false);
    pmax = fmaxf(__uint_as_float(rr[0]), __uint_as_float(rr[1])); }
  alpha = 1.f;
  if (FIRST || !__builtin_expect(__all(pmax <= THR2), 1)) {
    const float dl = FIRST ? pmax : fmaxf(pmax, 0.f);
#pragma unroll
    for (int r = 0; r < 16; ++r) { p0[r] -= dl; p1[r] -= dl; }
    const float nm = negm[0] - dl;
#pragma unroll
    for (int r = 0; r < 16; ++r) negm[r] = nm;
    alpha = FIRST ? 1.f : __builtin_amdgcn_exp2f(-dl);
  }
#pragma unroll
  for (int r = 0; r < 16; ++r) p0[r] = (VAR & 1) ? p0[r] : __builtin_amdgcn_exp2f(p0[r]);
}
template <int VAR = 0> __device__ __forceinline__ void finishSM(f32x16& p0, f32x16& p1, float alpha, float& l_reg, bf16x8& pa0, bf16x8& pa1, bf16x8& pa2, bf16x8& pa3) {
#pragma unroll
  for (int r = 0; r < 16; ++r) p1[r] = (VAR & (1 | 32)) ? p1[r] : __builtin_amdgcn_exp2f(p1[r]);
  float ps = 0;
  if (!(VAR & 32)) {
#pragma unroll
  for (int r = 0; r < 16; ++r) ps += p0[r];
#pragma unroll
  for (int r = 0; r < 16; ++r) ps += p1[r];
  { auto rr = __builtin_amdgcn_permlane32_swap(__float_as_uint(ps), __float_as_uint(ps), false, false);
    ps = __uint_as_float(rr[0]) + __uint_as_float(rr[1]); }
  l_reg = l_reg * alpha + ps; }
#define PK4(P, BASE, OUT) do { unsigned a0 = cvtpk(P[BASE + 0], P[BASE + 1]), a1 = cvtpk(P[BASE + 2], P[BASE + 3]);   \
    unsigned b0 = cvtpk(P[BASE + 4], P[BASE + 5]), b1 = cvtpk(P[BASE + 6], P[BASE + 7]);                              \
    auto r0 = __builtin_amdgcn_permlane32_swap(a0, b0, false, false); auto r1 = __builtin_amdgcn_permlane32_swap(a1, b1, false, false); \
    u32x4 w = {r0[0], r1[0], r0[1], r1[1]}; OUT = *reinterpret_cast<bf16x8*>(&w); } while (0)
  PK4(p0, 0, pa0); PK4(p0, 8, pa1); PK4(p1, 0, pa2); PK4(p1, 8, pa3);
#undef PK4
}
template <int VAR = 0> __device__ __forceinline__ void qkt(f32x16& p0, f32x16& p1, const char* Ks, const bf16x8* qr, int r32, int hi, int colb0, const f32x16& negm) {
  p0 = negm; p1 = negm;
  if (VAR & 4) { asm volatile("" : "+v"(p0), "+v"(p1)); return; }
  bf16x8 kf[2][2];
  { const int cb = colb0 + (hi * 8) * 2; kf[0][0] = *reinterpret_cast<const bf16x8*>(Ks + KSWZ(r32, cb)); kf[0][1] = *reinterpret_cast<const bf16x8*>(Ks + KSWZ(32 + r32, cb)); }
#pragma unroll
  for (int d0 = 0; d0 < 4; ++d0) {
    if (d0 < 3) { const int cb = colb0 + ((d0 + 1) * 16 + hi * 8) * 2; kf[(d0 + 1) & 1][0] = *reinterpret_cast<const bf16x8*>(Ks + KSWZ(r32, cb)); kf[(d0 + 1) & 1][1] = *reinterpret_cast<const bf16x8*>(Ks + KSWZ(32 + r32, cb)); }
    __builtin_amdgcn_sched_group_barrier(0x100, 2, 0);
    p0 = __builtin_amdgcn_mfma_f32_32x32x16_bf16(kf[d0 & 1][0], qr[d0], p0, 0, 0, 0);
    p1 = __builtin_amdgcn_mfma_f32_32x32x16_bf16(kf[d0 & 1][1], qr[d0], p1, 0, 0, 0);
    __builtin_amdgcn_sched_group_barrier(0x008, 2, 0); }
}
__device__ __forceinline__ int v_st(int k, int c) { const int kk = (k & ~0xC) | ((k & 4) << 1) | ((k & 8) >> 1); return ((kk >> 3) * 4 + (c >> 5)) * 512 + ((kk & 7) * 32 + (c & 31)) * 2; }
__device__ __forceinline__ int v_rd_base(int lane) { return ((lane & 3) << 3) | (((lane >> 2) & 3) << 6) | (((lane >> 4) & 1) << 5) | (((lane >> 5) & 1) << 8); }
constexpr int v_rd_off(int d0, int ks, int half) { return d0 * 512 + ks * 4096 + half * 2048; }
template <int OFF> __device__ __forceinline__ s16x4 tr_read(int vb) {
  s16x4 r; asm volatile("ds_read_b64_tr_b16 %0, %1 offset:%2" : "=&v"(r) : "v"(vb), "i"(OFF) : "memory"); return r;
}
template <int D0> __device__ __forceinline__ void pv_one(f32x16& od, int vb, bf16x8 pa0, bf16x8 pa1, bf16x8 pa2, bf16x8 pa3) {
  const s16x4 l0 = tr_read<v_rd_off(D0, 0, 0)>(vb), h0 = tr_read<v_rd_off(D0, 0, 1)>(vb), l1 = tr_read<v_rd_off(D0, 1, 0)>(vb), h1 = tr_read<v_rd_off(D0, 1, 1)>(vb);
  const s16x4 l2 = tr_read<v_rd_off(D0, 2, 0)>(vb), h2 = tr_read<v_rd_off(D0, 2, 1)>(vb), l3 = tr_read<v_rd_off(D0, 3, 0)>(vb), h3 = tr_read<v_rd_off(D0, 3, 1)>(vb);
  asm volatile("s_waitcnt lgkmcnt(0)" ::: "memory"); SBAR();
#define PK(L, H) (bf16x8){L[0], L[1], L[2], L[3], H[0], H[1], H[2], H[3]}
  od = __builtin_amdgcn_mfma_f32_32x32x16_bf16(pa0, PK(l0, h0), od, 0, 0, 0);
  od = __builtin_amdgcn_mfma_f32_32x32x16_bf16(pa1, PK(l1, h1), od, 0, 0, 0);
  od = __builtin_amdgcn_mfma_f32_32x32x16_bf16(pa2, PK(l2, h2), od, 0, 0, 0);
  od = __builtin_amdgcn_mfma_f32_32x32x16_bf16(pa3, PK(l3, h3), od, 0, 0, 0);
#undef PK
}
template <int VAR = 0> __device__ __forceinline__ void pv_d0(f32x16* o, int vb, bf16x8 pa0, bf16x8 pa1, bf16x8 pa2, bf16x8 pa3) {
  if (VAR & 2) { asm volatile("" :: "v"(pa0), "v"(pa1), "v"(pa2), "v"(pa3)); return; }
  pv_one<0>(o[0], vb, pa0, pa1, pa2, pa3); pv_one<1>(o[1], vb, pa0, pa1, pa2, pa3); pv_one<2>(o[2], vb, pa0, pa1, pa2, pa3); pv_one<3>(o[3], vb, pa0, pa1, pa2, pa3);
}
struct VPre { s16x4 l0, h0, l1, h1; };
__device__ __forceinline__ void pv_load0(VPre& v, int vb) {
  v.l0 = tr_read<v_rd_off(0, 0, 0)>(vb); v.h0 = tr_read<v_rd_off(0, 0, 1)>(vb); v.l1 = tr_read<v_rd_off(0, 1, 0)>(vb); v.h1 = tr_read<v_rd_off(0, 1, 1)>(vb);
}
template <int VAR = 0> __device__ __forceinline__ void pv_d0p(f32x16* o, int vb, const VPre& v, bf16x8 pa0, bf16x8 pa1, bf16x8 pa2, bf16x8 pa3) {
  if (VAR & 2) { asm volatile("" :: "v"(pa0), "v"(pa1), "v"(pa2), "v"(pa3)); return; }
  const s16x4 l2 = tr_read<v_rd_off(0, 2, 0)>(vb), h2 = tr_read<v_rd_off(0, 2, 1)>(vb), l3 = tr_read<v_rd_off(0, 3, 0)>(vb), h3 = tr_read<v_rd_off(0, 3, 1)>(vb);
  asm volatile("s_waitcnt lgkmcnt(4)" ::: "memory"); SBAR();
#define PK(L, H) (bf16x8){L[0], L[1], L[2], L[3], H[0], H[1], H[2], H[3]}
  o[0] = __builtin_amdgcn_mfma_f32_32x32x16_bf16(pa0, PK(v.l0, v.h0), o[0], 0, 0, 0);
  o[0] = __builtin_amdgcn_mfma_f32_32x32x16_bf16(pa1, PK(v.l1, v.h1), o[0], 0, 0, 0);
  asm volatile("s_waitcnt lgkmcnt(0)" ::: "memory"); SBAR();
  o[0] = __builtin_amdgcn_mfma_f32_32x32x16_bf16(pa2, PK(l2, h2), o[0], 0, 0, 0);
  o[0] = __builtin_amdgcn_mfma_f32_32x32x16_bf16(pa3, PK(l3, h3), o[0], 0, 0, 0);
#undef PK
  pv_one<1>(o[1], vb, pa0, pa1, pa2, pa3); pv_one<2>(o[2], vb, pa0, pa1, pa2, pa3); pv_one<3>(o[3], vb, pa0, pa1, pa2, pa3);
}
__device__ __forceinline__ float bf2f(unsigned short u) { return __uint_as_float((unsigned)u << 16); }
__device__ __forceinline__ unsigned short f2bf(float f) { unsigned u = __float_as_uint(f); return (unsigned short)((u + 0x7fffu + ((u >> 16) & 1u)) >> 16); }

template <int VAR = 0> __device__ __forceinline__ void diff_unit(const bf16r* __restrict__ Qb, const bf16r* __restrict__ Kh, const bf16r* __restrict__ Vh, const bf16r* __restrict__ Gb,
                                          bf16r* __restrict__ Ob, float lam, const float* __restrict__ nw, float nwscale, char* lds, int wave_s,
                                          const bf16r* Qn, const bf16r* Kn, const bf16r* Vn, bool pre, bf16x8 (&qr)[4]) {
  int tid_ = wave_s * 64 + lane_id_opaque(); asm volatile("" : "+v"(tid_));
  const int tid = tid_, wid = tid >> 6, lane = tid & 63, r32 = lane & 31, hi = lane >> 5;
  const int mp = wid >> 2, rg = wid & 3;
  char* K_lds = lds; char* V_lds = lds + VRING;
  float* ws = (float*)(lds + SHM_WS) + wid * 64; float* li_l = ws; float* al_l = ws + 32;
  float l_reg = 0; f32x16 o[4] = {}; f32x16 negm = {};
  const long qoff = (long)(rg * QBLK + r32) * LDP + mp * 64 + hi * 8;
  if (!pre) {
#pragma unroll
    for (int d0 = 0; d0 < 4; ++d0) qr[d0] = *(const __attribute__((address_space(1))) bf16x8*)(Qb + qoff + d0 * 16); }
  const int colb0 = mp * 128;
  const int vb0 = (int)(uintptr_t)V_lds + v_rd_base(lane);
  unsigned ksrc[2], vsrc[2];
#pragma unroll
  for (int i = 0; i < 2; ++i) { const int q = 2 * wave_s + i;
    { const int row = 4 * q + (lane >> 4), slot = lane & 15; const int colB = (slot * 16) ^ (((row & 7) << 4) | (((row >> 3) & 1) << 7)); ksrc[i] = (unsigned)(row * LDP + colB / 2); }
    { const int sub = 2 * q + (lane >> 5), kk = (sub >> 2) * 8 + ((lane & 31) >> 2), key = (kk & ~0xC) | ((kk & 4) << 1) | ((kk & 8) >> 1), col = (sub & 3) * 32 + 8 * (lane & 3); vsrc[i] = (unsigned)(key * LDP + col); } }
  int kslot = 0, vslot = 0;
#define DMA_TILE(t) DMA_TILE_AT(Kh, Vh, t)
#define DMA_TILE_AT(KB_, VB_, t) do { if (VAR & 8) break; const int t_ = (t) < NT ? (t) : NT - 1; const bf16r* kg_ = (KB_) + (long)t_ * KVBLK * LDP; const bf16r* vg_ = (VB_) + (long)t_ * KVBLK * LDP; \
    _Pragma("unroll") for (int i_ = 0; i_ < 2; ++i_) { \
      __builtin_amdgcn_global_load_lds((const unsigned*)(kg_ + ksrc[i_]), (__attribute__((address_space(3))) unsigned*)(K_lds + kslot + (2 * wave_s + i_) * 1024), 16, 0, 0); \
      __builtin_amdgcn_global_load_lds((const unsigned*)(vg_ + vsrc[i_]), (__attribute__((address_space(3))) unsigned*)(V_lds + vslot + (2 * wave_s + i_) * 1024), 16, 0, 0); } \
    kslot = kslot == (NKSLOT - 1) * TILE_B ? 0 : kslot + TILE_B; vslot = vslot == (NVSLOT - 1) * TILE_B ? 0 : vslot + TILE_B; } while (0)
#define LAND_BAR() do { if (VAR & 64) asm volatile("s_waitcnt lgkmcnt(0)" ::: "memory"); else asm volatile("s_waitcnt vmcnt(4) lgkmcnt(0)" ::: "memory"); if (!(VAR & 16)) __builtin_amdgcn_s_barrier(); asm volatile("" ::: "memory"); } while (0)
#define RESC(a) do { if (__any((a) < 1.f)) { if (hi == 0) al_l[r32] = (a); asm volatile("s_waitcnt lgkmcnt(0)" ::: "memory"); \
    _Pragma("unroll") for (int d = 0; d < 4; ++d) _Pragma("unroll") for (int r = 0; r < 16; ++r) o[d][r] *= al_l[crow(r, hi)]; } } while (0)
  f32x16 pA0, pA1, pB0, pB1; float alA, alB; bf16x8 pa0, pa1, pa2, pa3; const int NT = SEQ / KVBLK;
  int kr = 0, vr = 0;
#define ADV_K() do { kr = kr == (NKSLOT - 1) * TILE_B ? 0 : kr + TILE_B; } while (0)
#define ADV_V() do { vr = vr == (NVSLOT - 1) * TILE_B ? 0 : vr + TILE_B; } while (0)
  if (pre) { kslot = TILE_B; vslot = TILE_B; } else DMA_TILE(0);
  DMA_TILE(1); LAND_BAR();
  if (mp == 0) {
  qkt<VAR>(pA0, pA1, K_lds + kr, qr, r32, hi, colb0, negm); partialSM<VAR, true>(pA0, pA1, negm, alA); ADV_K();
  DMA_TILE(2); LAND_BAR();
  VPre vpre;
  for (int j = 1; j + 1 < NT; j += 2) {
    SBAR(); DMA_TILE(j + 2); SBAR();
    qkt<VAR>(pB0, pB1, K_lds + kr, qr, r32, hi, colb0, negm); pv_load0(vpre, vb0 + vr);
    finishSM<VAR>(pA0, pA1, alA, l_reg, pa0, pa1, pa2, pa3); SBAR();
    pv_d0p<VAR>(o, vb0 + vr, vpre, pa0, pa1, pa2, pa3); partialSM<VAR>(pB0, pB1, negm, alB);
    RESC(alB); LAND_BAR(); ADV_K(); ADV_V();
    SBAR(); DMA_TILE(j + 3); SBAR();
    qkt<VAR>(pA0, pA1, K_lds + kr, qr, r32, hi, colb0, negm); pv_load0(vpre, vb0 + vr);
    finishSM<VAR>(pB0, pB1, alB, l_reg, pa0, pa1, pa2, pa3); SBAR();
    pv_d0p<VAR>(o, vb0 + vr, vpre, pa0, pa1, pa2, pa3); partialSM<VAR>(pA0, pA1, negm, alA);
    RESC(alA); LAND_BAR(); ADV_K(); ADV_V();
  }
  SBAR(); qkt<VAR>(pB0, pB1, K_lds + kr, qr, r32, hi, colb0, negm);
  finishSM<VAR>(pA0, pA1, alA, l_reg, pa0, pa1, pa2, pa3); SBAR();
  pv_d0<VAR>(o, vb0 + vr, pa0, pa1, pa2, pa3); partialSM<VAR>(pB0, pB1, negm, alB); ADV_V();
  RESC(alB);
  finishSM<VAR>(pB0, pB1, alB, l_reg, pa0, pa1, pa2, pa3); SBAR();
  pv_d0<VAR>(o, vb0 + vr, pa0, pa1, pa2, pa3);
  } else {
  VPre vpre;
  SBAR(); DMA_TILE(2); SBAR();
  qkt<VAR>(pA0, pA1, K_lds + kr, qr, r32, hi, colb0, negm); ADV_K(); LAND_BAR();
  SBAR(); DMA_TILE(3); SBAR();
  partialSM<VAR, true>(pA0, pA1, negm, alA);
  qkt<VAR>(pB0, pB1, K_lds + kr, qr, r32, hi, colb0, negm); pv_load0(vpre, vb0 + vr);
  finishSM<VAR>(pA0, pA1, alA, l_reg, pa0, pa1, pa2, pa3); ADV_K(); LAND_BAR();
  for (int j = 2; j < NT; j += 2) {
    SBAR(); DMA_TILE(j + 2); SBAR();
    pv_d0p<VAR>(o, vb0 + vr, vpre, pa0, pa1, pa2, pa3); partialSM<VAR>(pB0, pB1, negm, alB); RESC(alB); ADV_V(); SBAR();
    qkt<VAR>(pA0, pA1, K_lds + kr, qr, r32, hi, colb0, negm); pv_load0(vpre, vb0 + vr);
    finishSM<VAR>(pB0, pB1, alB, l_reg, pa0, pa1, pa2, pa3); ADV_K(); LAND_BAR();
    SBAR(); DMA_TILE(j + 3); SBAR();
    pv_d0p<VAR>(o, vb0 + vr, vpre, pa0, pa1, pa2, pa3); partialSM<VAR>(pA0, pA1, negm, alA); RESC(alA); ADV_V(); SBAR();
    qkt<VAR>(pB0, pB1, K_lds + kr, qr, r32, hi, colb0, negm); pv_load0(vpre, vb0 + vr);
    finishSM<VAR>(pA0, pA1, alA, l_reg, pa0, pa1, pa2, pa3); ADV_K();
    if (j + 2 < NT) LAND_BAR();
  }
  SBAR(); pv_d0p<VAR>(o, vb0 + vr, vpre, pa0, pa1, pa2, pa3); partialSM<VAR>(pB0, pB1, negm, alB); RESC(alB); ADV_V();
  finishSM<VAR>(pB0, pB1, alB, l_reg, pa0, pa1, pa2, pa3); SBAR();
  pv_d0<VAR>(o, vb0 + vr, pa0, pa1, pa2, pa3);
  }
  asm volatile("s_waitcnt vmcnt(0)" ::: "memory");
#undef LAND_BAR
#undef ADV_K
#undef ADV_V
  if (hi == 0) li_l[r32] = l_reg; asm volatile("s_waitcnt lgkmcnt(0)" ::: "memory");
  float rli[16];
#pragma unroll
  for (int r = 0; r < 16; ++r) rli[r] = __builtin_amdgcn_rcpf(li_l[crow(r, hi)]);
  u32x4 gpre[4];
#pragma unroll
  for (int it = 0; it < 4; ++it) gpre[it] = *(const __attribute__((address_space(1))) u32x4*)(Gb + (long)(wid * 16 + it * 4 + (lane >> 4)) * LDP + (lane & 15) * 8);
  typedef float f32x4e __attribute__((ext_vector_type(4)));
  const int c0 = (lane & 15) * 8;
  const f32x4e w0 = *(const __attribute__((address_space(1))) f32x4e*)(nw + c0) * nwscale, w1 = *(const __attribute__((address_space(1))) f32x4e*)(nw + c0 + 4) * nwscale;
  __syncthreads();
  float* X = (float*)lds + rg * (16 * 4 * 64);
  float* Y = (float*)(lds + 65536);
  if (mp == 1) {
#pragma unroll
    for (int r = 0; r < 16; ++r)
#pragma unroll
      for (int d0 = 0; d0 < 4; ++d0) X[(r * 4 + d0) * 64 + lane] = o[d0][r] * rli[r];
  }
  __syncthreads();
  if (mp == 0) {
#pragma unroll
    for (int r = 0; r < 16; ++r)
#pragma unroll
      for (int d0 = 0; d0 < 4; ++d0) Y[(rg * QBLK + crow(r, hi)) * 128 + d0 * 32 + r32] = o[d0][r] * rli[r] - lam * X[(r * 4 + d0) * 64 + lane];
  }
  __syncthreads();
  if (Qn) {
#pragma unroll
    for (int d0 = 0; d0 < 4; ++d0) qr[d0] = *(const __attribute__((address_space(1))) bf16x8*)(Qn + qoff + d0 * 16);
    kslot = 0; vslot = 0; DMA_TILE_AT(Kn, Vn, 0); }
  {
#pragma unroll
    for (int it = 0; it < 4; ++it) { const int row = wid * 16 + it * 4 + (lane >> 4);
      const f32x4e a0 = *(const f32x4e*)(Y + row * 128 + c0), a1 = *(const f32x4e*)(Y + row * 128 + c0 + 4);
      float s = (a0[0] * a0[0] + a0[1] * a0[1]) + (a0[2] * a0[2] + a0[3] * a0[3]) + (a1[0] * a1[0] + a1[1] * a1[1]) + (a1[2] * a1[2] + a1[3] * a1[3]);
      s += xor_shfl<1>(s); s += xor_shfl<2>(s); s += xor_shfl<4>(s); s += xor_shfl<8>(s);
      const float rs = 1.f / sqrtf(s * (1.f / 128.f) + 1e-6f);
      const u32x4 gq = gpre[it];
      float gv[8];
#pragma unroll
      for (int e = 0; e < 4; ++e) { gv[2 * e] = __uint_as_float(gq[e] << 16); gv[2 * e + 1] = __uint_as_float(gq[e] & 0xffff0000u); }
      float ov[8];
#pragma unroll
      for (int e = 0; e < 8; ++e) { const float g = gv[e]; const float sg = g / (1.f + __expf(-g)); const float a = e < 4 ? a0[e] : a1[e - 4]; const float w = e < 4 ? w0[e] : w1[e - 4]; ov[e] = a * rs * w * sg; }
      u32x4 ow; ow[0] = cvtpk(ov[0], ov[1]); ow[1] = cvtpk(ov[2], ov[3]); ow[2] = cvtpk(ov[4], ov[5]); ow[3] = cvtpk(ov[6], ov[7]);
      *(__attribute__((address_space(1))) u32x4*)(Ob + (long)row * 1024 + c0) = ow; }
  }
  asm volatile("s_waitcnt lgkmcnt(0)" ::: "memory"); __builtin_amdgcn_s_barrier(); asm volatile("" ::: "memory");
#undef RESC
#undef DMA_TILE
#undef DMA_TILE_AT
}
#undef KSWZ
#undef SBAR
}
#define GAS __attribute__((address_space(1)))
#define LAS __attribute__((address_space(3)))
typedef unsigned short bf16;
typedef unsigned v4u __attribute__((ext_vector_type(4)));
typedef float f32x4 __attribute__((ext_vector_type(4)));
typedef short bf16x8 __attribute__((ext_vector_type(8)));
constexpr int NWAVES = 8;
constexpr int BATCH = 16, SEQ = 2048, DM = 1024, DEPTH = 4, M = BATCH * SEQ;
constexpr int IN_W = 4128, NP = 4096, NPA = 4128;
constexpr float EPS = 1e-6f;
constexpr int PQ_GQ = 0, PQ_GK = 128, PQ_GV = 256, PQ_GG = 512, PQ_DQ = 768, PQ_DK = 1280, PQ_DV = 1792, PQ_DG = 2304, PQ_HQ = 2816;
__host__ __device__ constexpr int col_hzf(int h) { return 3072 + (h >> 1) * 256 + (h & 1) * 64; }
__host__ __device__ constexpr int col_hi(int h) { return col_hzf(h) + 128; }
__host__ __device__ constexpr int col_hzb(int h) { return 3584 + (h >> 1) * 256 + (h & 1) * 64; }
__host__ __device__ constexpr int col_hg(int h) { return col_hzb(h) + 128; }
constexpr size_t MiB = 1u << 20;
constexpr size_t WS_CTL = 0;
constexpr size_t WS_WIN = 1 * MiB;
constexpr size_t WS_WOUT = WS_WIN + (size_t)4 * 4128 * 1024 * 2;
constexpr size_t WS_ROPE = WS_WOUT + 8 * MiB;
constexpr size_t WS_LB = WS_ROPE + 512 * 1024;
constexpr size_t WS_A = WS_LB + 65536;
constexpr size_t WS_RSTD = WS_CTL + 256 * 1024;
constexpr size_t WS_H = 46 * MiB;
constexpr size_t WS_MIX = 110 * MiB;
constexpr size_t WS_PROJ = 174 * MiB;
constexpr size_t WS_Y = WS_PROJ;
constexpr size_t WS_OSC0 = WS_H;
constexpr size_t WS_OSC1 = WS_H + 32 * MiB;
constexpr size_t WS_XB = 430 * MiB;
constexpr size_t WS_END = 494 * MiB;
static_assert(WS_A + (size_t)M * 32 * 4 <= WS_H, "ws map");
constexpr int LDS_BYTES = 147456;

__device__ __forceinline__ float bf2f(unsigned short u) { return __uint_as_float((unsigned)u << 16); }
__device__ __forceinline__ unsigned f2bf(float f) { unsigned u = __float_as_uint(f); return (u + 0x7fffu + ((u >> 16) & 1u)) >> 16; }
__device__ __forceinline__ unsigned pk2(float lo, float hi) { return f2bf(lo) | (f2bf(hi) << 16); }
__device__ __forceinline__ float wave_sum(float v) {
    v += xor_shfl<1>(v); v += xor_shfl<2>(v); v += xor_shfl<4>(v); v += xor_shfl<8>(v); v += xor_shfl<16>(v); v += xor_shfl<32>(v);
    return v;
}
#define LDS_WAIT() asm volatile("s_waitcnt lgkmcnt(0)" ::: "memory")
#define VM_WAIT() asm volatile("s_waitcnt vmcnt(0)" ::: "memory")

struct Args {
    const float* x; const float* norm_pre; const float* norm_post; const float* w_in; const float* w_out;
    const float* gla_wa2_f; const float* gla_ba_f; const float* gla_wa2_b; const float* gla_ba_b; const float* gla_norm;
    const float* lq1; const float* lk1; const float* lq2; const float* lk2; const float* diff_norm; const float* lb_logits; const float* hgrn_norm;
    float* out; unsigned char* ws; int ph_lo, ph_hi, rep, pad;
};
struct Frame { LAS unsigned char* lds; int tid, lane, wave, vcu, G; };

__device__ __forceinline__ int src_col(int p) {
    if (p >= NP) return 768 + (p - NP);
    if (p < 768) return p;
    if (p < 1792) { const int base = p & ~63, e = p & 63, j8 = e >> 3, e8 = e & 7; const int d = (e8 < 4) ? 4 * j8 + e8 : 32 + 4 * j8 + (e8 - 4); return base + d + 32; }
    if (p < 3072) return p + 32;
    { const int t = (p - 3072) >> 8, w = (p - 3072) & 255, half = w >> 7, h = (t & 1) * 2 + ((w & 127) >> 6), k = w & 63;
      const int base = (t < 2) ? (half ? 3616 : 3104) : (half ? 3872 : 3360); return base + h * 64 + k; }
}
__device__ __forceinline__ void transpose_item(const float* W, int srcN, bool remap, bf16* WT, LAS float* scr, int kb, int nb, int lane, const float* kscale = nullptr) {
    const int k0 = 64 * kb, n0 = 32 * nb; const int sc = remap ? src_col(n0 + (lane & 31)) : n0 + (lane & 31);
    float wv[32];
#pragma unroll
    for (int i = 0; i < 32; ++i) { const int kk = 2 * i + (lane >> 5); wv[i] = *(const GAS float*)(W + (size_t)(k0 + kk) * srcN + sc); }
    if (kscale) {
#pragma unroll
        for (int i = 0; i < 32; ++i) { const int kk = 2 * i + (lane >> 5); wv[i] *= *(const GAS float*)(kscale + k0 + kk); } }
#pragma unroll
    for (int i = 0; i < 32; ++i) { const int kk = 2 * i + (lane >> 5); scr[kk * 33 + (lane & 31)] = wv[i]; }
    LDS_WAIT(); asm volatile("" ::: "memory");
    const int c = lane & 7;
#pragma unroll
    for (int j = 0; j < 4; ++j) { const int n = (lane >> 3) + 8 * j; const LAS float* s = scr + (8 * c) * 33 + n;
        v4u o; o.x = pk2(s[0 * 33], s[1 * 33]); o.y = pk2(s[2 * 33], s[3 * 33]); o.z = pk2(s[4 * 33], s[5 * 33]); o.w = pk2(s[6 * 33], s[7 * 33]);
        *(GAS v4u*)(WT + (size_t)(n0 + n) * DM + k0 + 8 * c) = o; }
    LDS_WAIT(); asm volatile("" ::: "memory");
}
__device__ __forceinline__ void row_to_bf16_rstd(const f32x4 (&v)[4], bf16* orow, float* rstd, int lane) {
    float s = 0.f;
#pragma unroll
    for (int j = 0; j < 4; ++j) s += (v[j].x * v[j].x + v[j].y * v[j].y) + (v[j].z * v[j].z + v[j].w * v[j].w);
    const float r = 1.f / sqrtf(wave_sum(s) * (1.f / DM) + EPS);
    GAS unsigned long long* o8 = (GAS unsigned long long*)orow + lane;
#pragma unroll
    for (int j = 0; j < 4; ++j) o8[64 * j] = (unsigned long long)pk2(v[j].x, v[j].y) | ((unsigned long long)pk2(v[j].z, v[j].w) << 32);
    if (lane == 0) *(GAS float*)rstd = r;
}

__device__ __forceinline__ void p0_prologue(const Frame& F, const Args& a, int parts) {
    LAS float* scr = (LAS float*)(F.lds + F.wave * 16384);
    const int gw = F.vcu * NWAVES + F.wave, NGW = F.G * NWAVES;
    bf16* WinT = (bf16*)(a.ws + WS_WIN); bf16* WoutT = (bf16*)(a.ws + WS_WOUT);
    constexpr int I_IN = 16 * (NPA / 32), I_OUT = 16 * 32;
    constexpr int NITEMS = DEPTH * (I_IN + I_OUT);
    if (parts & 1)
    for (int it = gw; it < NITEMS; it += NGW) {
        const int l = it / (I_IN + I_OUT); int r = it % (I_IN + I_OUT);
        if (r < I_IN) transpose_item(a.w_in + (size_t)l * DM * IN_W, IN_W, true, WinT + (size_t)l * NPA * DM, scr, r / (NPA / 32), r % (NPA / 32), F.lane, a.norm_pre + l * DM);
        else { r -= I_IN; transpose_item(a.w_out + (size_t)l * DM * DM, DM, false, WoutT + (size_t)l * DM * DM, scr, r / 32, r % 32, F.lane); }
    }
    if (!(parts & 2)) return;
    float* cosT = (float*)(a.ws + WS_ROPE); float* sinT = cosT + SEQ * 32;
    for (int e = gw * 64 + F.lane; e < SEQ * 32; e += NGW * 64) { const int pos = e >> 5, i = e & 31;
        const float inv = __builtin_amdgcn_exp2f(-(float)i * (13.287712379549449f / 32.f));
        const float ang = (float)pos * inv; float rev = ang * 0.15915494309189535f; rev = rev - floorf(rev);
        cosT[e] = __builtin_amdgcn_cosf(rev); sinT[e] = __builtin_amdgcn_sinf(rev); }
    float* LB = (float*)(a.ws + WS_LB);
    for (int e = gw * 64 + F.lane; e < 256; e += NGW * 64) { float lg[DEPTH], mx = -1e30f;
#pragma unroll
        for (int l = 0; l < DEPTH; ++l) { lg[l] = a.lb_logits[l * 256 + e]; mx = fmaxf(mx, lg[l]); }
        float sum = 0.f;
#pragma unroll
        for (int l = 0; l < DEPTH; ++l) { lg[l] = expf(lg[l] - mx); sum += lg[l]; }
        float cum = 0.f; LB[e] = 0.f;
#pragma unroll
        for (int l = 1; l < DEPTH; ++l) { cum += lg[l] / sum; LB[l * 256 + e] = cum; } }
    bf16* H = (bf16*)(a.ws + WS_XB); float* RS = (float*)(a.ws + WS_RSTD);
    for (int m0 = 4 * gw; m0 < M; m0 += 4 * NGW) { f32x4 v[4][4];
#pragma unroll
        for (int t = 0; t < 4; ++t) { const GAS f32x4* xr = (const GAS f32x4*)(a.x + (size_t)(m0 + t) * DM) + F.lane;
#pragma unroll
            for (int j = 0; j < 4; ++j) v[t][j] = xr[64 * j]; }
#pragma unroll
        for (int t = 0; t < 4; ++t) row_to_bf16_rstd(v[t], H + (size_t)(m0 + t) * DM, RS + m0 + t, F.lane); }
}

__device__ __forceinline__ void lowrank_phase(const Frame& F, const Args& a, int layer) {
    typedef float f32x4v __attribute__((ext_vector_type(4)));
    const bf16* H = (const bf16*)(a.ws + WS_XB); const bf16* Wa = (const bf16*)(a.ws + WS_WIN) + ((size_t)layer * NPA + NP) * DM; float* A = (float*)(a.ws + WS_A); const float* RS = (const float*)(a.ws + WS_RSTD);
    const int gw = F.vcu * NWAVES + F.wave, NGW = F.G * NWAVES, lane = F.lane;
    for (int u = gw; u < M / 16; u += NGW) {
        const bf16* ap = H + (size_t)(u * 16 + (lane & 15)) * DM + 8 * (lane >> 4);
        const bf16* b0 = Wa + (size_t)(lane & 15) * DM + 8 * (lane >> 4); const bf16* b1 = b0 + 16 * DM;
        f32x4v c0 = {0.f, 0.f, 0.f, 0.f}, c1 = {0.f, 0.f, 0.f, 0.f};
#pragma unroll 16
        for (int ks = 0; ks < 32; ++ks) { const bf16x8 av = *(const GAS bf16x8*)(ap + ks * 32), bv0 = *(const GAS bf16x8*)(b0 + ks * 32), bv1 = *(const GAS bf16x8*)(b1 + ks * 32);
            c0 = __builtin_amdgcn_mfma_f32_16x16x32_bf16(av, bv0, c0, 0, 0, 0); c1 = __builtin_amdgcn_mfma_f32_16x16x32_bf16(av, bv1, c1, 0, 0, 0); }
#pragma unroll
        for (int r = 0; r < 4; ++r) { const int row = u * 16 + 4 * (lane >> 4) + r; const float rs = *(const GAS float*)(RS + row); GAS float* o = (GAS float*)(A + (size_t)row * 32 + (lane & 15)); o[0] = c0[r] * rs; o[16] = c1[r] * rs; }
    }
}

__device__ __forceinline__ void postnorm_rows(const Frame& F, const Args& a, int layer, int gw, int NGW, int row_base, int nrows, bool dry = false) {
    const bf16* Y = (const bf16*)(a.ws + WS_Y); float* RS = (float*)(a.ws + (dry ? WS_PROJ + 128 * MiB : WS_RSTD)); const bf16* XBr = (const bf16*)(a.ws + WS_XB); bf16* XB = (bf16*)(a.ws + (dry ? WS_MIX : WS_XB));
    float* outp = dry ? (float*)(a.ws + WS_PROJ + 128 * MiB) : a.out;
    const float* wpost = a.norm_post + layer * DM;
    const int lane = F.lane;
    const bool first = layer == 0, last = layer + 1 == DEPTH;
    f32x4 wp[4];
#pragma unroll
    for (int j = 0; j < 4; ++j) { const int c = (j >> 1) * 512 + 8 * lane + 4 * (j & 1); wp[j] = *(const GAS f32x4*)(wpost + c); }
    constexpr int RPW = 4;
    for (int m0 = row_base + RPW * gw; m0 < row_base + nrows; m0 += RPW * NGW) {
        v4u yr[RPW][2]; f32x4 x[RPW][4];
#pragma unroll
        for (int t = 0; t < RPW; ++t) { const size_t m = (size_t)m0 + t;
#pragma unroll
            for (int hf = 0; hf < 2; ++hf) yr[t][hf] = *(const GAS v4u*)(Y + m * DM + hf * 512 + 8 * lane);
            if (first) {
#pragma unroll
                for (int j = 0; j < 4; ++j) x[t][j] = *(const GAS f32x4*)(a.x + m * DM + (j >> 1) * 512 + 8 * lane + 4 * (j & 1));
            } else {
#pragma unroll
                for (int hf = 0; hf < 2; ++hf) { const v4u xr = *(const GAS v4u*)(XBr + m * DM + hf * 512 + 8 * lane);
                    x[t][2 * hf] = (f32x4){__uint_as_float(xr.x << 16), __uint_as_float(xr.x & 0xffff0000u), __uint_as_float(xr.y << 16), __uint_as_float(xr.y & 0xffff0000u)};
                    x[t][2 * hf + 1] = (f32x4){__uint_as_float(xr.z << 16), __uint_as_float(xr.z & 0xffff0000u), __uint_as_float(xr.w << 16), __uint_as_float(xr.w & 0xffff0000u)}; }
            } }
#pragma unroll
        for (int t = 0; t < RPW; ++t) { const size_t m = (size_t)m0 + t;
            f32x4 y[4]; float s = 0.f;
#pragma unroll
            for (int j = 0; j < 4; ++j) { const unsigned w0 = yr[t][j >> 1][2 * (j & 1)], w1 = yr[t][j >> 1][2 * (j & 1) + 1];
                y[j] = (f32x4){__uint_as_float(w0 << 16), __uint_as_float(w0 & 0xffff0000u), __uint_as_float(w1 << 16), __uint_as_float(w1 & 0xffff0000u)};
                s += (y[j].x * y[j].x + y[j].y * y[j].y) + (y[j].z * y[j].z + y[j].w * y[j].w); }
            const float r = 1.f / sqrtf(wave_sum(s) * (1.f / DM) + EPS);
            float s2 = 0.f;
#pragma unroll
            for (int j = 0; j < 4; ++j) { x[t][j] = x[t][j] + y[j] * r * wp[j];
                if (last) *(GAS f32x4*)(outp + m * DM + (j >> 1) * 512 + 8 * lane + 4 * (j & 1)) = x[t][j];
                s2 += (x[t][j].x * x[t][j].x + x[t][j].y * x[t][j].y) + (x[t][j].z * x[t][j].z + x[t][j].w * x[t][j].w); }
            if (!last) { const float r2 = 1.f / sqrtf(wave_sum(s2) * (1.f / DM) + EPS);
#pragma unroll
                for (int hf = 0; hf < 2; ++hf) { const f32x4 b0 = x[t][2 * hf], b1 = x[t][2 * hf + 1];
                    v4u ox; ox.x = pk2(b0.x, b0.y); ox.y = pk2(b0.z, b0.w); ox.z = pk2(b1.x, b1.y); ox.w = pk2(b1.z, b1.w);
                    *(GAS v4u*)(XB + m * DM + hf * 512 + 8 * lane) = ox; }
                if (lane == 0) *(GAS float*)(RS + m) = r2; }
        }
    }
}
__device__ __forceinline__ void postnorm_phase(const Frame& F, const Args& a, int layer, bool dry = false) { postnorm_rows(F, a, layer, F.vcu * NWAVES + F.wave, F.G * NWAVES, 0, M, dry); }
#define XB_TMO      128
#define XB_XCNT(j)  (256  + 64 * (j))
#define XB_XSUB(j)  (1280 + 64 * (j))
#define XB_XGEN(j)  (2304 + 64 * (j))
#define XB_TOP      3328
#define XB_TOPGEN   3392
#define XCD_BAR_WORDS 3456
#define XB_SPIN_CAP (1u << 18)

__device__ __forceinline__ unsigned xb_ld(unsigned* p)              { return __hip_atomic_load(p, __ATOMIC_RELAXED, __HIP_MEMORY_SCOPE_AGENT); }
__device__ __forceinline__ unsigned xb_add(unsigned* p, unsigned v) { return __hip_atomic_fetch_add(p, v, __ATOMIC_RELAXED, __HIP_MEMORY_SCOPE_AGENT); }
__device__ __forceinline__ unsigned xb_xcc_id() { return (unsigned)__builtin_amdgcn_s_getreg((3 << 11) | 20) & 0xFu; }
#define XB_SPIN(cond, bar) do { unsigned _sp = 0; while (cond) { __builtin_amdgcn_s_sleep(1); \
    if ((++_sp & 255u) == 0u) { if (xb_ld(&(bar)[XB_TMO])) break; if (_sp > XB_SPIN_CAP) { atomicAdd(&(bar)[XB_TMO], 1u); break; } } } } while (0)

struct XcdBarrier {
    unsigned* bar; unsigned x;
    volatile LAS unsigned* st;
};

__device__ __forceinline__ XcdBarrier xcd_barrier_post(unsigned* bar, volatile LAS unsigned* st) {
    XcdBarrier b; b.bar = bar; b.x = xb_xcc_id(); b.st = st;
    if (threadIdx.x == 0) (void)xb_add(&bar[XB_XCNT(b.x)], 1u);
    return b;
}
__device__ __forceinline__ void xcd_barrier_complete(unsigned* bar, unsigned x, unsigned& nloc, unsigned& nx) {
    const unsigned G = gridDim.x * gridDim.y * gridDim.z;
    unsigned sum, cnt, mine, sp = 0u;
    for (;;) {
        sum = 0u; cnt = 0u; mine = 0u;
#pragma unroll
        for (unsigned j = 0; j < 16; ++j) { const unsigned c = xb_ld(&bar[XB_XCNT(j)]); sum += c; cnt += (c > 0u) ? 1u : 0u; mine = (j == x) ? c : mine; }
        if (sum == G) break;
        __builtin_amdgcn_s_sleep(1);
        if ((++sp & 255u) == 0u) { if (xb_ld(&bar[XB_TMO])) break; if (sp > XB_SPIN_CAP) { atomicAdd(&bar[XB_TMO], 1u); break; } }
    }
    nloc = mine > 0u ? mine : 1u; nx = cnt > 0u ? cnt : 1u;
}

__device__ __forceinline__ void xcd_barrier(const XcdBarrier& b) {
    asm volatile("s_waitcnt vmcnt(0)" ::: "memory");
    __syncthreads();
    if (threadIdx.x == 0) {
        unsigned* bar = b.bar;
        __builtin_amdgcn_s_waitcnt(0);
        unsigned nloc = b.st[0], nx = b.st[1];
        if (nloc == 0u) { xcd_barrier_complete(bar, b.x, nloc, nx); b.st[0] = nloc; b.st[1] = nx; }
        const unsigned old = xb_add(&bar[XB_XSUB(b.x)], 1u);
        const unsigned gen = old / nloc;
        if (old + 1u == (gen + 1u) * nloc) {
            __builtin_amdgcn_fence(__ATOMIC_RELEASE, "agent");
            asm volatile("s_waitcnt vmcnt(0)" ::: "memory");
            const unsigned og = xb_add(&bar[XB_TOP], 1u);
            const unsigned tg = og / nx;
            if (og + 1u == (tg + 1u) * nx) xb_add(&bar[XB_TOPGEN], 1u);
            else XB_SPIN(xb_ld(&bar[XB_TOPGEN]) == tg, bar);
            __builtin_amdgcn_fence(__ATOMIC_ACQUIRE, "agent");
            xb_add(&bar[XB_XGEN(b.x)], 1u);
            asm volatile("s_waitcnt vmcnt(0)" ::: "memory");
        } else {
            XB_SPIN(xb_ld(&bar[XB_XGEN(b.x)]) == gen, bar);
            __builtin_amdgcn_fence(__ATOMIC_ACQUIRE, "agent");
            asm volatile("s_waitcnt vmcnt(0)" ::: "memory");
        }
    }
    __syncthreads();
}
namespace scan {
typedef float f32x16 __attribute__((ext_vector_type(16)));
typedef float f32x4s __attribute__((ext_vector_type(4)));
typedef short bf16x8s __attribute__((ext_vector_type(8)));
typedef short s16x4s __attribute__((ext_vector_type(4)));
typedef unsigned u32x4s __attribute__((ext_vector_type(4)));
typedef unsigned u32x2s __attribute__((ext_vector_type(2)));
constexpr int CH = 32, SEGT = 256, NCH = SEGT / CH;
constexpr int WAVE_LDS = 15360;
constexpr int PT = 72, PTB = PT * 2;
constexpr size_t OSC_UNIT = (size_t)64 * 16 * 64 * 4;
__device__ __forceinline__ int crow(int r, int hi) { return (r & 3) + 8 * (r >> 2) + 4 * hi; }
__device__ __forceinline__ unsigned cvtpk(float lo, float hi) { unsigned r; asm volatile("v_cvt_pk_bf16_f32 %0, %1, %2" : "=v"(r) : "v"(lo), "v"(hi)); return r; }
__device__ __forceinline__ float other_half(float x, int hh) { auto rr = __builtin_amdgcn_permlane32_swap(__float_as_uint(x), __float_as_uint(x), false, false); return __uint_as_float(hh ? rr[0] : rr[1]); }
typedef short v4i16_t __attribute__((ext_vector_type(4)));
__device__ __forceinline__ s16x4s trd(LAS const unsigned char* p) { return __builtin_bit_cast(s16x4s, __builtin_amdgcn_ds_read_tr16_b64_v4i16((LAS v4i16_t*)p)); }
#define SC_STEP(N) "v_add_f32_dpp %0, %0, %0 row_shr:" #N " row_mask:0xa bank_mask:0xf bound_ctrl:1\n\tv_add_f32_dpp %1, %1, %1 row_shr:" #N " row_mask:0xa bank_mask:0xf bound_ctrl:1\n\t" \
                   "v_add_f32_dpp %2, %2, %2 row_shr:" #N " row_mask:0xa bank_mask:0xf bound_ctrl:1\n\tv_add_f32_dpp %3, %3, %3 row_shr:" #N " row_mask:0xa bank_mask:0xf bound_ctrl:1\n\t" \
                   "v_add_f32_dpp %0, %0, %0 row_shl:" #N " row_mask:0x5 bank_mask:0xf bound_ctrl:1\n\tv_add_f32_dpp %1, %1, %1 row_shl:" #N " row_mask:0x5 bank_mask:0xf bound_ctrl:1\n\t" \
                   "v_add_f32_dpp %2, %2, %2 row_shl:" #N " row_mask:0x5 bank_mask:0xf bound_ctrl:1\n\tv_add_f32_dpp %3, %3, %3 row_shl:" #N " row_mask:0x5 bank_mask:0xf bound_ctrl:1\n\t"
__device__ __forceinline__ void rowscan4(float& a, float& b, float& c, float& d) {
    asm volatile("s_nop 1\n\t" SC_STEP(1) SC_STEP(2) SC_STEP(4) SC_STEP(8) "s_nop 1" : "+v"(a), "+v"(b), "+v"(c), "+v"(d));
}
#undef SC_STEP
__device__ __forceinline__ void tri_frags(bf16x8s (&T)[2], int r, int hh) {
    const bool row1 = (r & 16) != 0;
#pragma unroll
    for (int ss = 0; ss < 2; ++ss) { u32x4s t;
#pragma unroll
        for (int jj = 0; jj < 4; ++jj) { const int k0 = 16 * ss + 4 * hh + ((2 * jj) & 3) + 8 * ((2 * jj) >> 2), k1 = k0 + 1;
            const bool i0 = row1 ? (k0 >= 16 && k0 <= r) : (k0 >= r && k0 <= 15), i1 = row1 ? (k1 >= 16 && k1 <= r) : (k1 >= r && k1 <= 15);
            t[jj] = (i0 ? 0x3F80u : 0u) | (i1 ? 0x3F800000u : 0u); }
        T[ss] = __builtin_bit_cast(bf16x8s, t); }
}
__device__ __forceinline__ f32x16 tri_cumsum(LAS const unsigned char* TK, int tb, int kb, const bf16x8s (&T)[2]) {
    f32x16 sc = {};
#pragma unroll
    for (int ss = 0; ss < 2; ++ss) { const s16x4s lo = trd(TK + tb + (16 * ss) * PTB + 64 * kb), hi = trd(TK + tb + (16 * ss + 8) * PTB + 64 * kb);
        sc = __builtin_amdgcn_mfma_f32_32x32x16_bf16((bf16x8s){lo[0], lo[1], lo[2], lo[3], hi[0], hi[1], hi[2], hi[3]}, T[ss], sc, 0, 0, 0); }
    return sc;
}

template <int DK, bool HG> struct Ctx {
    const bf16* P; const float* A; int lane; LAS unsigned char* lw;
    int qcol, kcol, vcol, dir;
    bf16x8s wbf; float bav[16];
};
template <int DK> struct Raw { v4u g[DK / 16]; f32x4s a0, a1; };

template <int DK, bool HG, bool FULL, int VAR = 0>
__device__ __forceinline__ void load_raw(const Ctx<DK, HG>& c, size_t row0, Raw<DK>& w, int lane) {
    if (VAR & 8) return;
    const int r = lane & 31, hh = lane >> 5; const bf16* Pr = c.P + row0 * NP;
#pragma unroll
    for (int i = 0; i < DK / 16; ++i) { const int p = lane + 64 * i; w.g[i] = *(const GAS v4u*)(Pr + c.kcol + (unsigned)((p / (DK / 8)) * NP + (p % (DK / 8)) * 8)); }
    if (!HG) { const float* Ar = c.A + row0 * 32; w.a0 = *(const GAS f32x4s*)(Ar + (unsigned)(r * 32 + c.dir * 16 + 8 * hh)); w.a1 = *(const GAS f32x4s*)(Ar + (unsigned)(r * 32 + c.dir * 16 + 8 * hh + 4)); }
}

template <int DK, bool HG, int DIR, bool FULL, int VAR>
__device__ __forceinline__ void chunk_step(const Ctx<DK, HG>& c, size_t row_cur, size_t row_next, Raw<DK>& w, f32x16 (&S)[DK / 32][2], f32x16 (&O)[2]) {
    constexpr int NKB = DK / 32, NKS = DK / 16;
    const int lane_ = lane_id_opaque();
    const int lane = lane_, r = lane & 31, hh = lane >> 5;
    LAS unsigned char* TK = c.lw; LAS unsigned char* TV = c.lw + 32 * PTB; LAS float* VEC = (LAS float*)(c.lw + 64 * PTB);
#pragma unroll
    for (int i = 0; i < NKS; ++i) { const int p = lane + 64 * i; *(LAS v4u*)(TK + (p / (DK / 8)) * PTB + (p % (DK / 8)) * 16) = w.g[i]; }
    v4u vraw[4]; v4u qraw[NKS]; LAS unsigned char* TQ = c.lw + 64 * PTB + 1536;
    { const bf16* Pv = c.P + row_cur * NP;
        if (FULL) {
#pragma unroll
            for (int i = 0; i < NKS; ++i) { const int p = lane + 64 * i; qraw[i] = *(const GAS v4u*)(Pv + c.qcol + (unsigned)((p / (DK / 8)) * NP + (p % (DK / 8)) * 8)); } }
#pragma unroll
        for (int i = 0; i < 4; ++i) { const int p = lane + 64 * i; vraw[i] = *(const GAS v4u*)(Pv + (unsigned)((p >> 3) * NP + c.vcol + (p & 7) * 8)); } }
    f32x16 zg = {};
    if (!HG) { u32x4s t; t[0] = cvtpk(w.a0[0], w.a0[1]); t[1] = cvtpk(w.a0[2], w.a0[3]); t[2] = cvtpk(w.a1[0], w.a1[1]); t[3] = cvtpk(w.a1[2], w.a1[3]);
        zg = __builtin_amdgcn_mfma_f32_32x32x16_bf16(c.wbf, __builtin_bit_cast(bf16x8s, t), zg, 0, 0, 0); }
    bf16x8s QR[NKS], KR[NKS]; float eqv[FULL ? NKS : 1][8];
    const bool row1 = (r & 16) != 0;
    const int tb = (4 * hh + ((r & 15) >> 2)) * PTB + (16 * ((r >> 4) & 1) + 4 * (r & 3)) * 2;
    bf16x8s TRI[2]; f32x16 SCm[HG ? NKB : 1]; if (HG) tri_frags(TRI, r, hh);
    u32x2s G0a[NKS], G1a[NKS];
#pragma unroll
    for (int ks = 0; ks < NKS; ++ks) { G0a[ks] = *(const LAS u32x2s*)(TK + r * PTB + (16 * ks + 4 * hh) * 2); G1a[ks] = *(const LAS u32x2s*)(TK + r * PTB + (16 * ks + 8 + 4 * hh) * 2); }
#pragma unroll
    for (int ks = 0; ks < NKS; ++ks) {
        float x[8], kk[8], sc[8];
        if (HG && (ks & 1) == 0) SCm[HG ? (ks >> 1) : 0] = tri_cumsum(TK, tb, ks >> 1, TRI);
        const u32x2s g0_ = G0a[ks], g1_ = G1a[ks];
#pragma unroll
        for (int j = 0; j < 8; ++j) { const unsigned rawg = (j >> 2) ? g1_[(j >> 1) & 1] : g0_[(j >> 1) & 1]; const float gv = __uint_as_float((j & 1) ? (rawg & 0xffff0000u) : (rawg << 16));
            if (HG) { x[j] = gv; kk[j] = 1.f - __builtin_amdgcn_exp2f(gv); }
            else { const float z = zg[8 * ks + j] + c.bav[8 * ks + j]; x[j] = (fminf(z, 0.f) - __logf(1.f + __expf(-fabsf(z)))) * (1.4426950408889634f / 16.f); kk[j] = gv; }
            sc[j] = HG ? SCm[HG ? (ks >> 1) : 0][8 * (ks & 1) + j] : x[j]; }
        if (!HG && !(VAR & 1)) { rowscan4(sc[0], sc[1], sc[2], sc[3]); rowscan4(sc[4], sc[5], sc[6], sc[7]); }
        if (r == 0) { *(LAS f32x4s*)(VEC + 16 * ks + 4 * hh) = (f32x4s){sc[0], sc[1], sc[2], sc[3]}; *(LAS f32x4s*)(VEC + 16 * ks + 8 + 4 * hh) = (f32x4s){sc[4], sc[5], sc[6], sc[7]}; }
        if (r == 31) { *(LAS f32x4s*)(VEC + 64 + 16 * ks + 4 * hh) = (f32x4s){sc[0], sc[1], sc[2], sc[3]}; *(LAS f32x4s*)(VEC + 64 + 16 * ks + 8 + 4 * hh) = (f32x4s){sc[4], sc[5], sc[6], sc[7]}; }
        float kt[8];
#pragma unroll
        for (int j = 0; j < 8; ++j) { const float d = x[j] - sc[j]; const float e = (DIR == 0) ? (row1 ? sc[j] : d) : (row1 ? d : sc[j]);
            const float eq = __builtin_amdgcn_exp2f(__builtin_amdgcn_fmed3f(e, -115.f, 115.f)), ek = __builtin_amdgcn_rcpf(eq); kt[j] = kk[j] * ek; if (FULL) eqv[ks][j] = eq; }
        u32x4s tk; tk[0] = cvtpk(kt[0], kt[1]); tk[1] = cvtpk(kt[2], kt[3]); tk[2] = cvtpk(kt[4], kt[5]); tk[3] = cvtpk(kt[6], kt[7]); KR[ks] = __builtin_bit_cast(bf16x8s, tk);
        *(LAS u32x2s*)(TK + r * PTB + (16 * ks + 4 * hh) * 2) = (u32x2s){tk[0], tk[1]}; *(LAS u32x2s*)(TK + r * PTB + (16 * ks + 8 + 4 * hh) * 2) = (u32x2s){tk[2], tk[3]};
    }
    if (!FULL) load_raw<DK, HG, FULL, VAR>(c, row_next, w, lane);
#pragma unroll
    for (int i = 0; i < 4; ++i) { const int p = lane + 64 * i; *(LAS v4u*)(TV + (p >> 3) * PTB + (p & 7) * 16) = vraw[i]; }
    if (FULL) {
#pragma unroll
        for (int i = 0; i < NKS; ++i) { const int p = lane + 64 * i; *(LAS v4u*)(TQ + (p / (DK / 8)) * PTB + (p % (DK / 8)) * 16) = qraw[i]; } }
    LDS_WAIT(); asm volatile("" ::: "memory");
    if (FULL) {
#pragma unroll
        for (int ks = 0; ks < NKS; ++ks) { const u32x2s q0_ = *(const LAS u32x2s*)(TQ + r * PTB + (16 * ks + 4 * hh) * 2), q1_ = *(const LAS u32x2s*)(TQ + r * PTB + (16 * ks + 8 + 4 * hh) * 2); float qt[8];
#pragma unroll
            for (int j = 0; j < 8; ++j) { const unsigned rawq = (j >> 2) ? q1_[(j >> 1) & 1] : q0_[(j >> 1) & 1]; float qv = __uint_as_float((j & 1) ? (rawq & 0xffff0000u) : (rawq << 16)); if (!HG) qv *= 0.17677669529663687f; qt[j] = qv * eqv[ks][j]; }
            u32x4s tq; tq[0] = cvtpk(qt[0], qt[1]); tq[1] = cvtpk(qt[2], qt[3]); tq[2] = cvtpk(qt[4], qt[5]); tq[3] = cvtpk(qt[6], qt[7]); QR[ks] = __builtin_bit_cast(bf16x8s, tq); } }
    { const float t0 = VEC[lane], t1 = VEC[64 + lane]; VEC[128 + lane] += t0 + t1;
      const float er_ = __builtin_amdgcn_exp2f(fmaxf(DIR == 0 ? t0 : t1, -115.f)), eu_ = __builtin_amdgcn_exp2f(fmaxf(DIR == 0 ? t1 : t0, -115.f));
      VEC[192 + lane] = er_; VEC[256 + lane] = eu_; VEC[320 + lane] = er_ * eu_; }
    LDS_WAIT(); asm volatile("" ::: "memory");
    bf16x8s Vf[2][2];
#pragma unroll
    for (int vb = 0; vb < 2; ++vb)
#pragma unroll
        for (int ss = 0; ss < 2; ++ss) { const s16x4s lo = trd(TV + tb + (16 * ss) * PTB + 64 * vb), hi = trd(TV + tb + (16 * ss + 8) * PTB + 64 * vb);
            Vf[vb][ss] = (bf16x8s){lo[0], lo[1], lo[2], lo[3], hi[0], hi[1], hi[2], hi[3]}; }
    if (FULL) {
        f32x16 Pm = {};
#pragma unroll
        for (int ks = 0; ks < NKS; ++ks) Pm = __builtin_amdgcn_mfma_f32_32x32x16_bf16(KR[ks], QR[ks], Pm, 0, 0, 0);
        bf16x8s Pf[2];
#pragma unroll
        for (int ss = 0; ss < 2; ++ss) { u32x4s t;
#pragma unroll
            for (int jj = 0; jj < 4; ++jj) { const int g0 = 8 * ss + 2 * jj; const int s0 = crow(g0, hh), s1 = crow(g0 + 1, hh);
                const float p0 = (DIR == 0 ? (s0 <= r) : (s0 >= r)) ? Pm[g0] : 0.f, p1 = (DIR == 0 ? (s1 <= r) : (s1 >= r)) ? Pm[g0 + 1] : 0.f;
                t[jj] = cvtpk(p0, p1); }
            Pf[ss] = __builtin_bit_cast(bf16x8s, t); }
#pragma unroll
        for (int vb = 0; vb < 2; ++vb)
#pragma unroll
            for (int ss = 0; ss < 2; ++ss) O[vb] = __builtin_amdgcn_mfma_f32_32x32x16_bf16(Vf[vb][ss], Pf[ss], ss == 0 ? f32x16{} : O[vb], 0, 0, 0);
        __builtin_amdgcn_sched_barrier(0);
        load_raw<DK, HG, FULL, VAR>(c, row_next, w, lane);
#pragma unroll
        for (int kb = 0; kb < NKB; ++kb) {
            f32x4s er[4];
#pragma unroll
            for (int g = 0; g < 4; ++g) er[g] = *(const LAS f32x4s*)(VEC + 192 + 32 * kb + 8 * g + 4 * hh);
#pragma unroll
            for (int vb = 0; vb < 2; ++vb)
#pragma unroll
                for (int ss = 0; ss < 2; ++ss) { u32x4s t;
#pragma unroll
                    for (int jj = 0; jj < 4; ++jj) { const int g0 = 8 * ss + 2 * jj; t[jj] = cvtpk(S[kb][vb][g0] * er[g0 >> 2][g0 & 3], S[kb][vb][g0 + 1] * er[(g0 + 1) >> 2][(g0 + 1) & 3]); }
                    O[vb] = __builtin_amdgcn_mfma_f32_32x32x16_bf16(__builtin_bit_cast(bf16x8s, t), QR[2 * kb + ss], O[vb], 0, 0, 0); }
        }
    }
#pragma unroll
    for (int kb = 0; kb < NKB; ++kb) {
        bf16x8s KT[2];
#pragma unroll
        for (int ss = 0; ss < 2; ++ss) { const s16x4s lo = trd(TK + tb + (16 * ss) * PTB + 64 * kb), hi = trd(TK + tb + (16 * ss + 8) * PTB + 64 * kb);
            KT[ss] = (bf16x8s){lo[0], lo[1], lo[2], lo[3], hi[0], hi[1], hi[2], hi[3]}; }
        f32x4s gs[4], gu[4];
#pragma unroll
        for (int g = 0; g < 4; ++g) { gs[g] = *(const LAS f32x4s*)(VEC + 320 + 32 * kb + 8 * g + 4 * hh); gu[g] = *(const LAS f32x4s*)(VEC + 256 + 32 * kb + 8 * g + 4 * hh); }
#pragma unroll
        for (int vb = 0; vb < 2; ++vb) { f32x16 U = {};
#pragma unroll
            for (int ss = 0; ss < 2; ++ss) U = __builtin_amdgcn_mfma_f32_32x32x16_bf16(KT[ss], Vf[vb][ss], U, 0, 0, 0);
#pragma unroll
            for (int g = 0; g < 16; ++g) S[kb][vb][g] = S[kb][vb][g] * gs[g >> 2][g & 3] + U[g] * gu[g >> 2][g & 3]; }
    }
    LDS_WAIT(); asm volatile("" ::: "memory");
}

template <int DK, bool HG, int DIR, int VAR>
__device__ __forceinline__ void l1_step(const Ctx<DK, HG>& c, size_t row_cur, size_t row_next, Raw<DK>& w, f32x16 (&S)[DK / 32][2], float (&carry)[DK / 16][8]) {
    constexpr int NKB = DK / 32, NKS = DK / 16;
    const int lane_ = lane_id_opaque();
    const int lane = lane_, r = lane & 31, hh = lane >> 5;
    LAS unsigned char* TK = c.lw; LAS unsigned char* TV = c.lw + 32 * PTB; LAS float* VEC = (LAS float*)(c.lw + 64 * PTB);
    v4u vraw[4];
    { const bf16* Pv = c.P + row_cur * NP;
#pragma unroll
        for (int i = 0; i < 4; ++i) { const int p = lane + 64 * i; vraw[i] = *(const GAS v4u*)(Pv + (unsigned)((p >> 3) * NP + c.vcol + (p & 7) * 8)); } }
#pragma unroll
    for (int i = 0; i < NKS; ++i) { const int p = lane + 64 * i; *(LAS v4u*)(TK + (p / (DK / 8)) * PTB + (p % (DK / 8)) * 16) = w.g[i]; }
    f32x16 zg = {};
    if (!HG) { u32x4s t; t[0] = cvtpk(w.a0[0], w.a0[1]); t[1] = cvtpk(w.a0[2], w.a0[3]); t[2] = cvtpk(w.a1[0], w.a1[1]); t[3] = cvtpk(w.a1[2], w.a1[3]);
        zg = __builtin_amdgcn_mfma_f32_32x32x16_bf16(c.wbf, __builtin_bit_cast(bf16x8s, t), zg, 0, 0, 0); }
    const bool row1 = (r & 16) != 0;
    const int tb = (4 * hh + ((r & 15) >> 2)) * PTB + (16 * ((r >> 4) & 1) + 4 * (r & 3)) * 2;
    float x[NKS][8], kk[NKS][8], sc[NKS][8];
    if (HG) { bf16x8s TRI[2]; tri_frags(TRI, r, hh);
#pragma unroll
        for (int kb = 0; kb < NKB; ++kb) { const f32x16 t = tri_cumsum(TK, tb, kb, TRI);
#pragma unroll
            for (int g = 0; g < 16; ++g) sc[2 * kb + (g >> 3)][g & 7] = t[g]; } }
#pragma unroll
    for (int ks = 0; ks < NKS; ++ks) {
        const u32x2s g0_ = *(const LAS u32x2s*)(TK + r * PTB + (16 * ks + 4 * hh) * 2), g1_ = *(const LAS u32x2s*)(TK + r * PTB + (16 * ks + 8 + 4 * hh) * 2);
#pragma unroll
        for (int j = 0; j < 8; ++j) { const unsigned rawg = (j >> 2) ? g1_[(j >> 1) & 1] : g0_[(j >> 1) & 1]; const float gv = __uint_as_float((j & 1) ? (rawg & 0xffff0000u) : (rawg << 16));
            if (HG) { x[ks][j] = gv; kk[ks][j] = 1.f - __builtin_amdgcn_exp2f(gv); }
            else { const float z = zg[8 * ks + j] + c.bav[8 * ks + j]; x[ks][j] = (fminf(z, 0.f) - __logf(1.f + __expf(-fabsf(z)))) * (1.4426950408889634f / 16.f); kk[ks][j] = gv; }
            if (!HG) sc[ks][j] = x[ks][j]; }
        if (!HG && !(VAR & 1)) { rowscan4(sc[ks][0], sc[ks][1], sc[ks][2], sc[ks][3]); rowscan4(sc[ks][4], sc[ks][5], sc[ks][6], sc[ks][7]); }
        if (r == 0) { *(LAS f32x4s*)(VEC + 16 * ks + 4 * hh) = (f32x4s){sc[ks][0], sc[ks][1], sc[ks][2], sc[ks][3]}; *(LAS f32x4s*)(VEC + 16 * ks + 8 + 4 * hh) = (f32x4s){sc[ks][4], sc[ks][5], sc[ks][6], sc[ks][7]}; }
        if (r == 31) { *(LAS f32x4s*)(VEC + 64 + 16 * ks + 4 * hh) = (f32x4s){sc[ks][0], sc[ks][1], sc[ks][2], sc[ks][3]}; *(LAS f32x4s*)(VEC + 64 + 16 * ks + 8 + 4 * hh) = (f32x4s){sc[ks][4], sc[ks][5], sc[ks][6], sc[ks][7]}; }
    }
    load_raw<DK, HG, false, VAR>(c, row_next, w, lane);
#pragma unroll
    for (int i = 0; i < 4; ++i) { const int p = lane + 64 * i; *(LAS v4u*)(TV + (p >> 3) * PTB + (p & 7) * 16) = vraw[i]; }
    LDS_WAIT(); asm volatile("" ::: "memory");
#pragma unroll
    for (int ks = 0; ks < NKS; ++ks) { float kt[8];
#pragma unroll
        for (int jh = 0; jh < 2; ++jh) { const f32x4s S0 = *(const LAS f32x4s*)(VEC + 16 * ks + 8 * jh + 4 * hh), P1 = *(const LAS f32x4s*)(VEC + 64 + 16 * ks + 8 * jh + 4 * hh);
#pragma unroll
            for (int q = 0; q < 4; ++q) { const int j = 4 * jh + q;
                const float in_chunk = (DIR == 0) ? (row1 ? (P1[q] - sc[ks][j]) : (sc[ks][j] - x[ks][j] + P1[q])) : (row1 ? (S0[q] + sc[ks][j] - x[ks][j]) : (S0[q] - sc[ks][j]));
                kt[j] = kk[ks][j] * __builtin_amdgcn_exp2f(carry[ks][j] + in_chunk); carry[ks][j] += S0[q] + P1[q]; } }
        u32x4s tk; tk[0] = cvtpk(kt[0], kt[1]); tk[1] = cvtpk(kt[2], kt[3]); tk[2] = cvtpk(kt[4], kt[5]); tk[3] = cvtpk(kt[6], kt[7]);
        *(LAS u32x2s*)(TK + r * PTB + (16 * ks + 4 * hh) * 2) = (u32x2s){tk[0], tk[1]}; *(LAS u32x2s*)(TK + r * PTB + (16 * ks + 8 + 4 * hh) * 2) = (u32x2s){tk[2], tk[3]};
    }
    bf16x8s Vf[2][2];
#pragma unroll
    for (int vb = 0; vb < 2; ++vb)
#pragma unroll
        for (int ss = 0; ss < 2; ++ss) { const s16x4s lo = trd(TV + tb + (16 * ss) * PTB + 64 * vb), hi = trd(TV + tb + (16 * ss + 8) * PTB + 64 * vb);
            Vf[vb][ss] = (bf16x8s){lo[0], lo[1], lo[2], lo[3], hi[0], hi[1], hi[2], hi[3]}; }
#pragma unroll
    for (int kb = 0; kb < NKB; ++kb) {
        bf16x8s KT[2];
#pragma unroll
        for (int ss = 0; ss < 2; ++ss) { const s16x4s lo = trd(TK + tb + (16 * ss) * PTB + 64 * kb), hi = trd(TK + tb + (16 * ss + 8) * PTB + 64 * kb);
            KT[ss] = (bf16x8s){lo[0], lo[1], lo[2], lo[3], hi[0], hi[1], hi[2], hi[3]}; }
#pragma unroll
        for (int vb = 0; vb < 2; ++vb)
#pragma unroll
            for (int ss = 0; ss < 2; ++ss) S[kb][vb] = __builtin_amdgcn_mfma_f32_32x32x16_bf16(KT[ss], Vf[vb][ss], S[kb][vb], 0, 0, 0);
    }
    LDS_WAIT(); asm volatile("" ::: "memory");
}

template <int DK, bool HG, int DIR, int VAR>
__device__ __forceinline__ void scan_unit(const Frame& F, const Args& a, int layer, int b, int h, int unit) {
    constexpr int NKB = DK / 32;
    const int lane0 = lane_id_opaque();
    Ctx<DK, HG> c; c.P = (const bf16*)(a.ws + WS_PROJ); c.A = (const float*)(a.ws + WS_A); c.lane = lane0; c.lw = F.lds + F.wave * WAVE_LDS; c.dir = DIR;
    c.qcol = HG ? PQ_HQ + h * 64 : PQ_GQ + h * 32; c.kcol = HG ? (DIR ? col_hzb(h) : col_hzf(h)) : PQ_GK + h * 32; c.vcol = HG ? col_hi(h) : PQ_GV + h * 64;
    const int r = lane0 & 31, hh = lane0 >> 5, w = F.wave, lane = lane0;
    { u32x4s t = {0u, 0u, 0u, 0u};
#pragma unroll
        for (int g = 0; g < 16; ++g) c.bav[g] = 0.f;
        if (!HG) { const float* w2 = (DIR ? a.gla_wa2_b : a.gla_wa2_f) + (size_t)layer * 16 * 128 + (size_t)(8 * hh) * 128 + h * 32 + r;
#pragma unroll
            for (int jj = 0; jj < 4; ++jj) t[jj] = cvtpk(w2[(2 * jj) * 128], w2[(2 * jj + 1) * 128]);
            const float* bp = (DIR ? a.gla_ba_b : a.gla_ba_f) + layer * 128 + h * 32 + 4 * hh;
#pragma unroll
            for (int g = 0; g < 4; ++g) { const f32x4s bv = *(const f32x4s*)(bp + 8 * g); c.bav[4 * g] = bv[0]; c.bav[4 * g + 1] = bv[1]; c.bav[4 * g + 2] = bv[2]; c.bav[4 * g + 3] = bv[3]; } }
        c.wbf = __builtin_bit_cast(bf16x8s, t); }
    GAS float* OSC = (GAS float*)(a.ws + (DIR ? WS_OSC1 : WS_OSC0) + (size_t)(unit >> 1) * OSC_UNIT);
    GAS float* XS = OSC; GAS float* XB = XS + 8 * 4 * 16 * 64;
    const size_t rowseg = (size_t)b * SEQ + w * SEGT;
    LAS float* VEC = (LAS float*)(c.lw + 64 * PTB);
    f32x16 S[NKB][2]; f32x16 O[2]; Raw<DK> raw;
#pragma unroll
    for (int kb = 0; kb < NKB; ++kb) { S[kb][0] = f32x16{}; S[kb][1] = f32x16{}; }
    { float carry[DK / 16][8];
#pragma unroll
        for (int ks = 0; ks < DK / 16; ++ks)
#pragma unroll
            for (int j = 0; j < 8; ++j) carry[ks][j] = 0.f;
        load_raw<DK, HG, false>(c, rowseg + (DIR ? 0 : NCH - 1) * CH, raw, lane_id_opaque());
#pragma unroll 1
        for (int ci = 0; ci < ((VAR & 32) ? 0 : NCH); ++ci) { const int cc = DIR ? ci : NCH - 1 - ci; const int cn = ci + 1 < NCH ? ci + 1 : ci; const int ccn = DIR ? cn : NCH - 1 - cn;
            l1_step<DK, HG, DIR, VAR>(c, rowseg + cc * CH, rowseg + ccn * CH, raw, S, carry); }
        LDS_WAIT(); __syncthreads();
        const int ln = lane_id_opaque();
        LAS float* xs = (LAS float*)F.lds + (w * 4) * 16 * 64;
#pragma unroll
        for (int kb = 0; kb < NKB; ++kb)
#pragma unroll
            for (int vb = 0; vb < 2; ++vb)
#pragma unroll
                for (int g = 0; g < 16; ++g) xs[((kb * 2 + vb) * 16 + g) * 64 + ln] = S[kb][vb][g];
        if ((ln & 31) == 0) {
            LAS float* XT = (LAS float*)(F.lds + 131072);
#pragma unroll
            for (int ks = 0; ks < DK / 16; ++ks)
#pragma unroll
                for (int jh = 0; jh < 2; ++jh) *(LAS f32x4s*)(XT + w * 64 + 16 * ks + 8 * jh + 4 * (ln >> 5)) = (f32x4s){carry[ks][4 * jh], carry[ks][4 * jh + 1], carry[ks][4 * jh + 2], carry[ks][4 * jh + 3]}; } }
    LDS_WAIT(); __syncthreads();
    load_raw<DK, HG, true>(c, rowseg + (DIR ? NCH - 1 : 0) * CH, raw, lane_id_opaque());
    { const int t_ = F.wave * 64 + lane_id_opaque();
        LAS float* XL = (LAS float*)F.lds; LAS float* XT = (LAS float*)(F.lds + 131072);
        constexpr int NVEC = NKB * 2 * 16 * 64 / 4;
        for (int v = t_; v < NVEC; v += NWAVES * 64) {
            const int f = 4 * v, blk = f >> 10, g = (f & 1023) >> 6, l4 = f & 63, k = 32 * (blk >> 1) + crow(g, l4 >> 5);
            f32x4s sl[8]; float bg[8];
#pragma unroll
            for (int ww = 0; ww < 8; ++ww) { sl[ww] = *(const LAS f32x4s*)(XL + (ww * 4) * 16 * 64 + f); bg[ww] = XT[ww * 64 + k]; }
            float z_ = 0.f; asm volatile("" : "+v"(z_)); f32x4s acc = {z_, z_, z_, z_};
#pragma unroll
            for (int i = 0; i < 8; ++i) { const int ww = DIR ? 7 - i : i; const f32x4s nxt = acc * __builtin_amdgcn_exp2f(bg[ww]) + sl[ww];
                *(LAS f32x4s*)(XL + (ww * 4) * 16 * 64 + f) = acc; acc = nxt; }
        } }
    LDS_WAIT(); __syncthreads();
    { const int ln = lane_id_opaque(); const LAS float* xs = (const LAS float*)F.lds + (w * 4) * 16 * 64;
#pragma unroll
        for (int kb = 0; kb < NKB; ++kb)
#pragma unroll
            for (int vb = 0; vb < 2; ++vb)
#pragma unroll
                for (int g = 0; g < 16; ++g) S[kb][vb][g] = xs[((kb * 2 + vb) * 16 + g) * 64 + ln]; }
    LDS_WAIT();
    __syncthreads();
#pragma unroll 1
    for (int ci = 0; ci < ((VAR & 64) ? 0 : NCH); ++ci) { const int cc = DIR ? NCH - 1 - ci : ci; const int cn = ci + 1 < NCH ? ci + 1 : ci; const int ccn = DIR ? NCH - 1 - cn : cn;
        chunk_step<DK, HG, DIR, true, VAR>(c, rowseg + cc * CH, rowseg + ccn * CH, raw, S, O);
        GAS unsigned* osc = (GAS unsigned*)OSC + (size_t)((w * NCH + cc) * 16) * 64; const int ln = lane_id_opaque();
#pragma unroll
        for (int vb = 0; vb < 2; ++vb)
#pragma unroll
            for (int g = 0; g < 8; ++g) { const unsigned ov_ = cvtpk(O[vb][2 * g], O[vb][2 * g + 1]);
                asm volatile("global_store_dword %0, %1, off sc1" :: "v"(osc + (unsigned)((vb * 8 + g) * 64 + ln)), "v"(ov_) : "memory"); }
    }
}

struct FinRaw { v4u g[4]; unsigned a0[16], a1[16]; };
template <bool HG> __device__ __forceinline__ void fin_load(FinRaw& r, const Args& a, int b, int h, int pair, int cc, int ln) {
    const bf16* P = (const bf16*)(a.ws + WS_PROJ);
    const GAS unsigned* o0 = (const GAS unsigned*)(a.ws + WS_OSC0 + (size_t)pair * OSC_UNIT) + (size_t)(cc * 16) * 64; const GAS unsigned* o1 = (const GAS unsigned*)(a.ws + WS_OSC1 + (size_t)pair * OSC_UNIT) + (size_t)(cc * 16) * 64;
    const bf16* gp = P + ((size_t)b * SEQ + cc * CH) * NP + (HG ? col_hg(h) : PQ_GG + h * 64);
#pragma unroll
    for (int i = 0; i < 4; ++i) { const int p = ln + 64 * i; r.g[i] = *(const GAS v4u*)(gp + (unsigned)((p >> 3) * NP + (p & 7) * 8)); }
#pragma unroll
    for (int i = 0; i < 16; ++i) { r.a0[i] = o0[(unsigned)(i * 64 + ln)]; r.a1[i] = o1[(unsigned)(i * 64 + ln)]; }
}
template <bool HG> __device__ __forceinline__ void fin_proc(const FinRaw& r, const Frame& F, const Args& a, int layer, int b, int h, int cc, int ln) {
    LAS unsigned char* TG = F.lds + F.wave * 8192; LAS unsigned char* TO = TG + 4096;
    const int rq = ln & 31, hq = ln >> 5;
    bf16* mp = (bf16*)(a.ws + WS_MIX) + ((size_t)b * SEQ + cc * CH) * DM + (HG ? 768 : 0) + h * 64;
    float ov[32], ss = 0.f;
#pragma unroll
    for (int i = 0; i < 16; ++i) { const unsigned a0 = r.a0[i], a1 = r.a1[i];
        const float v0 = __uint_as_float(a0 << 16) + __uint_as_float(a1 << 16), v1 = __uint_as_float(a0 & 0xffff0000u) + __uint_as_float(a1 & 0xffff0000u);
        ov[2 * i] = v0; ov[2 * i + 1] = v1; ss += v0 * v0 + v1 * v1; }
    ss += other_half(ss, hq);
    const float rs = 1.f / sqrtf(ss * (1.f / 64.f) + EPS);
#pragma unroll
    for (int i = 0; i < 4; ++i) { const int p = ln + 64 * i; *(LAS v4u*)(TG + (p >> 3) * 128 + (p & 7) * 16) = r.g[i]; }
    LDS_WAIT(); asm volatile("" ::: "memory");
    const float* nwp = (HG ? a.hgrn_norm : a.gla_norm) + layer * 64;
#pragma unroll
    for (int vb = 0; vb < 2; ++vb)
#pragma unroll
        for (int g = 0; g < 4; ++g) { const int col = 4 * hq + 32 * vb + 8 * g; const u32x2s gq = *(const LAS u32x2s*)(TG + rq * 128 + col * 2); const f32x4s nw = *(const GAS f32x4s*)(nwp + (unsigned)col);
            float gv[4] = {__uint_as_float(gq[0] << 16), __uint_as_float(gq[0] & 0xffff0000u), __uint_as_float(gq[1] << 16), __uint_as_float(gq[1] & 0xffff0000u)}; float out[4];
#pragma unroll
            for (int q = 0; q < 4; ++q) { const float sg = gv[q] / (1.f + __expf(-gv[q])); out[q] = ov[vb * 16 + 4 * g + q] * rs * nw[q] * sg; }
            u32x2s ow; ow[0] = cvtpk(out[0], out[1]); ow[1] = cvtpk(out[2], out[3]); *(LAS u32x2s*)(TO + rq * 128 + col * 2) = ow; }
    LDS_WAIT(); asm volatile("" ::: "memory");
#pragma unroll
    for (int i = 0; i < 4; ++i) { const int p = ln + 64 * i; const v4u o = *(const LAS v4u*)(TO + (p >> 3) * 128 + (p & 7) * 16); *(GAS v4u*)(mp + (unsigned)((p >> 3) * DM + (p & 7) * 8)) = o; }
    LDS_WAIT(); asm volatile("" ::: "memory");
}
template <bool HG>
__device__ __forceinline__ void finalize_chunks(const Frame& F, const Args& a, int layer, int b, int h, int pair, int c0, int nc) {
    int ln = F.lane; asm volatile("" : "+v"(ln));
    int cc = c0 + F.wave; const int ce = c0 + nc; if (cc >= ce) return;
    FinRaw A, B; fin_load<HG>(A, a, b, h, pair, cc, ln);
    for (;;) {
        const int n1 = cc + NWAVES; const bool h1 = n1 < ce; if (h1) fin_load<HG>(B, a, b, h, pair, n1, ln);
        fin_proc<HG>(A, F, a, layer, b, h, cc, ln); if (!h1) break;
        const int n2 = n1 + NWAVES; const bool h2 = n2 < ce; if (h2) fin_load<HG>(A, a, b, h, pair, n2, ln);
        fin_proc<HG>(B, F, a, layer, b, h, n1, ln); if (!h2) break;
        cc = n2;
    }
}
}

template <int VAR = 0> __device__ __forceinline__ void scan_phase_units(const Frame& F, const Args& a, int layer) {
    unsigned* flags = (unsigned*)(a.ws + WS_CTL) + 8192 + layer * 256;
    for (int u = F.vcu; u < 256; u += F.G) {
        const int pair = u >> 1, dir = u & 1, type = pair >> 6, b = (pair & 63) >> 2, h = pair & 3;
        if (type) { if (dir) scan::scan_unit<64, true, 1, VAR>(F, a, layer, b, h, u); else scan::scan_unit<64, true, 0, VAR>(F, a, layer, b, h, u); }
        else { if (dir) scan::scan_unit<32, false, 1, VAR>(F, a, layer, b, h, u); else scan::scan_unit<32, false, 0, VAR>(F, a, layer, b, h, u); }
        VM_WAIT(); __syncthreads();
        if (F.wave == 0 && lane_id_opaque() == 0) { unsigned ep = (unsigned)(layer + 1); unsigned long long fp = (unsigned long long)(flags + u); asm volatile("" : "+s"(ep), "+s"(fp));
            __builtin_amdgcn_fence(__ATOMIC_RELEASE, "agent"); VM_WAIT(); __hip_atomic_store((unsigned*)fp, ep, __ATOMIC_RELAXED, __HIP_MEMORY_SCOPE_AGENT); }
    }
}
#ifndef FIN_X
#define FIN_X 8
#endif
__device__ __forceinline__ void fin_wait(const Frame& F, unsigned* flag, int layer) {
    if (F.tid == 0) { unsigned spins = 0;
        while (__hip_atomic_load(flag, __ATOMIC_RELAXED, __HIP_MEMORY_SCOPE_AGENT) != (unsigned)(layer + 1)) { __builtin_amdgcn_s_sleep(2); if (++spins > (1u << 24)) break; }
        __builtin_amdgcn_fence(__ATOMIC_ACQUIRE, "agent"); VM_WAIT(); }
    __syncthreads();
}
__device__ __forceinline__ void scan_phase_finalize(const Frame& F, const Args& a, int layer) {
    unsigned* flags = (unsigned*)(a.ws + WS_CTL) + 8192 + layer * 256;
    for (int u = F.vcu; u < 256; u += F.G) {
        const int pair = u >> 1, dir = u & 1, type = pair >> 6, b = (pair & 63) >> 2, h = pair & 3;
        fin_wait(F, flags + (u ^ 1), layer);
        if (type) scan::finalize_chunks<true>(F, a, layer, b, h, pair, dir * 32, 32 - FIN_X);
        else { scan::finalize_chunks<false>(F, a, layer, b, h, pair, dir * 32, 32);
            if (FIN_X) { fin_wait(F, flags + 2 * (pair + 64), layer); fin_wait(F, flags + 2 * (pair + 64) + 1, layer);
                scan::finalize_chunks<true>(F, a, layer, b, h, pair + 64, dir * 32 + 32 - FIN_X, FIN_X); } }
    }
}
#define SCAN_PHASE scan_phase_units<0>
#define SCAN_HAS_FINALIZE 1
template <int VAR = 0> __device__ __forceinline__ void attn_phase(const Frame& F, const Args& a, int layer) {
    const bf16* P = (const bf16*)(a.ws + WS_PROJ); bf16* MX = (bf16*)(a.ws + WS_MIX);
    const float linit = 0.8f - 0.6f * expf(-0.3f * (float)layer);
    const float d1 = wave_sum(a.lq1[layer * 64 + F.lane] * a.lk1[layer * 64 + F.lane]), d2 = wave_sum(a.lq2[layer * 64 + F.lane] * a.lk2[layer * 64 + F.lane]);
    const float lam = expf(d1) - expf(d2) + linit;
    const int NU = BATCH * 4 * (SEQ / 128), per = (NU + F.G - 1) / F.G;
    auto unit_of = [&](int i) { int u = F.vcu * per + i;
        if (F.G == 256) { const int xcd = F.vcu >> 5, w = F.vcu & 31; u = ((xcd * 8 + i * 2 + (w >> 4)) << 4) | (w & 15); }
        return u; };
    dattn::bf16x8 qr[4]; bool pre = false;
    for (int i = 0; i < per; ++i) { if (F.vcu * per + i >= NU) break;
        const int u = unit_of(i); const int bh = u >> 4, qb = u & 15, b = bh >> 2, h = bh & 3; const size_t row0 = (size_t)b * SEQ + qb * 128;
        const bool hn = (i + 1 < per) && (F.vcu * per + i + 1 < NU); const int un = hn ? unit_of(i + 1) : u; const int bhn = un >> 4, bn = bhn >> 2, hh = bhn & 3; const size_t rown = (size_t)bn * SEQ + (un & 15) * 128;
        dattn::diff_unit<VAR>(P + row0 * NP + PQ_DQ + h * 128, P + (size_t)b * SEQ * NP + PQ_DK + h * 128, P + (size_t)b * SEQ * NP + PQ_DV + h * 128,
                         P + row0 * NP + PQ_DG + h * 128, MX + row0 * DM + 256 + h * 128, lam, a.diff_norm + layer * 128, 1.f - linit, (char*)F.lds, F.wave,
                         hn ? P + rown * NP + PQ_DQ + hh * 128 : nullptr, P + (size_t)bn * SEQ * NP + PQ_DK + hh * 128, P + (size_t)bn * SEQ * NP + PQ_DV + hh * 128, pre, qr);
        pre = hn; }
}

__global__ void __launch_bounds__(NWAVES * 64, 2) fwd_mega(Args args) {
    extern __shared__ __attribute__((aligned(16))) unsigned char lds[];
    cg::grid_group grid = cg::this_grid();
    const int wave_s = __builtin_amdgcn_readfirstlane((int)threadIdx.x >> 6);
#define MKFRAME() Frame F; { int t_ = wave_s * 64 + lane_id_opaque(); asm volatile("" : "+v"(t_)); F.lds = (LAS unsigned char*)lds; F.tid = t_; F.lane = t_ & 63; F.wave = wave_s; \
    F.G = gridDim.x; const int bx = blockIdx.x; F.vcu = (F.G % 8 == 0) ? (bx % 8) * (F.G / 8) + bx / 8 : bx; }
    constexpr int ARGTAB = LDS_BYTES - 256, NARGW = (int)(sizeof(Args) / 4);
    { const unsigned* src = (const unsigned*)&args; if (threadIdx.x < NARGW) ((LAS unsigned*)(lds + ARGTAB))[threadIdx.x] = src[threadIdx.x]; }
    { for (int u = threadIdx.x; u < 64; u += NWAVES * 64) ((LAS unsigned*)(lds + LDS_BYTES - 512))[u] = 0u; }
    __syncthreads();
    (void)xcd_barrier_post((unsigned*)(args.ws + WS_CTL) + 4096, (volatile LAS unsigned*)(lds + LDS_BYTES - 512));
    const int lo = args.ph_lo, hi = args.ph_hi, repm = args.rep;
#define LDARGS() Args A_; { unsigned off_ = ARGTAB; asm volatile("" : "+s"(off_)); const LAS unsigned* tab_ = (const LAS unsigned*)((LAS unsigned char*)lds + off_); unsigned* dst_ = (unsigned*)&A_; \
    _Pragma("unroll") for (int i_ = 0; i_ < NARGW; ++i_) dst_[i_] = __builtin_amdgcn_readfirstlane(tab_[i_]); }
#define IN(k) (lo <= (k) && (k) < hi)
#define SEAM(k) do { if (IN(k) && IN((k) + 1)) { for (int rep_ = 0; rep_ < 1 + 2 * ((repm >> 4) & 1); ++rep_) { if (repm == 0x40000000) grid.sync();   { LDARGS(); XcdBarrier b_; b_.bar = (unsigned*)(A_.ws + WS_CTL) + 4096; b_.x = xb_xcc_id(); b_.st = (volatile LAS unsigned*)(lds + LDS_BYTES - 512); xcd_barrier(b_); } } } } while (0)
#ifndef NO_P0
    if (IN(0)) { for (int rep_ = 0; rep_ < 1 + ((repm >> 6) & 1); ++rep_) { MKFRAME(); LDARGS(); p0_prologue(F, A_, 3); } for (int rep_ = 0; rep_ < ((repm >> 10) & 1); ++rep_) { MKFRAME(); LDARGS(); p0_prologue(F, A_, 1); } for (int rep_ = 0; rep_ < ((repm >> 11) & 1); ++rep_) { MKFRAME(); LDARGS(); p0_prologue(F, A_, 2); } }
#endif
    SEAM(0);
    for (int layer = 0; layer < DEPTH; ++layer) {
        const int pb = 1 + 4 * layer;
        if (IN(pb)) {
            MKFRAME(); LDARGS(); const Args& args = A_;
            pg8::Gemm g{(const pg8::bf16_t*)(args.ws + WS_XB), (const pg8::bf16_t*)(args.ws + WS_WIN) + (size_t)layer * NPA * DM, M, NP, DM};
            pg8::StaticOrder S; S.init(M, NP, F.G, (int)blockIdx.x);
            pg8::EpiProj E{(pg8::bf16_t*)(args.ws + WS_PROJ), (const float*)(args.ws + WS_ROPE), (const float*)(args.ws + WS_ROPE) + SEQ * 32, (const float*)(args.ws + WS_LB) + layer * 256, (const float*)(args.ws + WS_RSTD)};
            const bool lr_first = ((blockIdx.x >> 3) & 1) != 0;
#ifndef NO_LR
            if (lr_first) for (int rep_ = 0; rep_ < 1 + ((repm >> 5) & 1); ++rep_) lowrank_phase(F, args, layer);
#endif
#ifndef NO_GA
            for (int rep_ = -((repm >> 14) & 1); rep_ < 1 + (repm & 1); ++rep_)
            pg8::gemm_phase<pg8::EpiProj, pg8::StaticOrder, true, true>(F.lds, g, S, E, wave_s, rep_ < 0 ? -1 : ((repm >> 9) & 1));
#endif
#ifndef NO_LR
            if (!lr_first) for (int rep_ = 0; rep_ < 1 + ((repm >> 5) & 1); ++rep_) lowrank_phase(F, args, layer);
#endif
        }
        SEAM(pb);
        if (IN(pb + 1)) {
            int attn_first = (int)((blockIdx.x >> 4) & 1); asm volatile("" : "+s"(attn_first));
#ifndef NO_SCAN
            if (!attn_first) { for (int rep_ = 0; rep_ < 1 + ((repm >> 1) & 1); ++rep_) { MKFRAME(); LDARGS(); SCAN_PHASE(F, A_, layer); } }
#endif
#ifndef NO_ATTN
            for (int rep_ = 0; rep_ < 1 + ((repm >> 2) & 1); ++rep_) { MKFRAME(); LDARGS(); attn_phase<0>(F, A_, layer); }
#endif
#ifndef NO_SCAN
            if (attn_first) { for (int rep_ = 0; rep_ < 1 + ((repm >> 1) & 1); ++rep_) { MKFRAME(); LDARGS(); SCAN_PHASE(F, A_, layer); } }
#endif
#ifdef SCAN_HAS_FINALIZE
            for (int rep_ = 0; rep_ < 1 + ((repm >> 7) & 1); ++rep_) { MKFRAME(); LDARGS(); scan_phase_finalize(F, A_, layer); }
#endif
        }
        SEAM(pb + 1);
        if (IN(pb + 2)) {
            MKFRAME(); LDARGS(); const Args& args = A_;
            pg8::Gemm g{(const pg8::bf16_t*)(args.ws + WS_MIX), (const pg8::bf16_t*)(args.ws + WS_WOUT) + (size_t)layer * DM * DM, M, DM, DM};
            pg8::StaticOrder S; S.init(M, DM, F.G, (int)blockIdx.x);
            pg8::EpiY E{(pg8::bf16_t*)(args.ws + WS_Y)};
#ifndef NO_GC
            for (int rep_ = 0; rep_ < 1 + ((repm >> 3) & 1); ++rep_)
            pg8::gemm_phase<pg8::EpiY, pg8::StaticOrder, true, true>(F.lds, g, S, E, wave_s);
#endif
        }
        SEAM(pb + 2);
#ifndef NO_PD
        if (IN(pb + 3)) { MKFRAME(); LDARGS(); postnorm_phase(F, A_, layer); for (int rep_ = 0; rep_ < ((repm >> 8) & 1); ++rep_) postnorm_phase(F, A_, layer, true); }
#endif
        if (layer + 1 < DEPTH) SEAM(pb + 3);
    }
#undef IN
#undef SEAM
}
constexpr int N_PHASES = 1 + 4 * DEPTH;

extern "C" void kernel_launch(void* const* d_in, const int* in_sizes, int n_in, void* d_out, int out_size, void* d_ws, size_t ws_size, hipStream_t stream) {
    static int grid = 0;
    if (grid == 0) {
        if (n_in != 17 || in_sizes[0] != M * DM || out_size != M * DM || ws_size < WS_END) {
            fprintf(stderr, "kernel_launch: shape mismatch n_in %d in0 %d out %d ws %zu (need %zu)\n", n_in, n_in > 0 ? in_sizes[0] : -1, out_size, ws_size, (size_t)WS_END); grid = -1; return; }
        int dev = 0, cus = 0, per_cu = 0;
        if (hipGetDevice(&dev) != hipSuccess || hipDeviceGetAttribute(&cus, hipDeviceAttributeMultiprocessorCount, dev) != hipSuccess) { grid = -1; return; }
        if (hipFuncSetAttribute((const void*)fwd_mega, hipFuncAttributeMaxDynamicSharedMemorySize, LDS_BYTES) != hipSuccess) { fprintf(stderr, "kernel_launch: hipFuncSetAttribute failed\n"); grid = -1; return; }
        if (hipOccupancyMaxActiveBlocksPerMultiprocessor(&per_cu, (const void*)fwd_mega, NWAVES * 64, LDS_BYTES) != hipSuccess || per_cu < 1) { fprintf(stderr, "kernel_launch: occupancy query says %d\n", per_cu); (void)hipGetLastError(); grid = -1; return; }
        grid = cus;
        fprintf(stderr, "kernel_launch: cus %d per_cu %d grid %d ws %zu\n", cus, per_cu, grid, ws_size);
    }
    if (grid < 0) return;
    if (hipMemsetAsync((char*)d_ws + WS_CTL, 0, 65536, stream) != hipSuccess) { fprintf(stderr, "kernel_launch: memset failed\n"); return; }
    Args a{};
    a.x = (const float*)d_in[0]; a.norm_pre = (const float*)d_in[1]; a.norm_post = (const float*)d_in[2]; a.w_in = (const float*)d_in[3]; a.w_out = (const float*)d_in[4];
    a.gla_wa2_f = (const float*)d_in[5]; a.gla_ba_f = (const float*)d_in[6]; a.gla_wa2_b = (const float*)d_in[7]; a.gla_ba_b = (const float*)d_in[8]; a.gla_norm = (const float*)d_in[9];
    a.lq1 = (const float*)d_in[10]; a.lk1 = (const float*)d_in[11]; a.lq2 = (const float*)d_in[12]; a.lk2 = (const float*)d_in[13]; a.diff_norm = (const float*)d_in[14];
    a.lb_logits = (const float*)d_in[15]; a.hgrn_norm = (const float*)d_in[16];
    a.out = (float*)d_out; a.ws = (unsigned char*)d_ws; a.ph_lo = 0; a.ph_hi = N_PHASES;
#ifdef REP_MASK
    a.rep = REP_MASK;
#endif
    void* kargs[] = {&a};
    const hipError_t e = hipLaunchCooperativeKernel((const void*)fwd_mega, dim3(grid), dim3(NWAVES * 64), kargs, LDS_BYTES, stream);
    if (e != hipSuccess) fprintf(stderr, "kernel_launch: cooperative launch failed: %s (grid %d)\n", hipGetErrorString(e), grid);
}
```

```cpp
#include <hip/hip_runtime.h>
#include <hip/hip_cooperative_groups.h>
#include <hip/hip_bf16.h>
#include <cstdio>
#include <cstdint>
#include <cmath>
namespace cg = cooperative_groups;
__device__ __forceinline__ int lane_id_opaque() { int x; asm volatile("v_mbcnt_lo_u32_b32 %0, -1, 0\n\tv_mbcnt_hi_u32_b32 %0, -1, %0" : "=v"(x)); return x; }
template <int MASK> __device__ __forceinline__ float xor_shfl(float v) {
    if constexpr (MASK == 32) { auto rr = __builtin_amdgcn_permlane32_swap(__float_as_uint(v), __float_as_uint(v), false, false);
        return __uint_as_float(rr[0] ^ rr[1] ^ __float_as_uint(v)); }
    else return __int_as_float(__builtin_amdgcn_ds_swizzle(__float_as_int(v), (MASK << 10) | 0x1f));
}
namespace pg8 {
#define PG8_LAS __attribute__((address_space(3)))
typedef unsigned short bf16_t;
typedef short bf16x8 __attribute__((ext_vector_type(8)));
typedef float f32x4 __attribute__((ext_vector_type(4)));
typedef unsigned u32x4 __attribute__((ext_vector_type(4)));
constexpr int BM = 256, BK = 64, HALF = 128, HTB = HALF * BK * 2  , STAGE_BYTES = 8 * HTB, NXCD = 8, WGM = 8;

__host__ __device__ __forceinline__ int lds_byte(int r, int c) { const int st = (r >> 4) * 2 + (c >> 5), rr = r & 15, cc = c & 31, ob = rr * 64 + cc * 2; return st * 1024 + (ob ^ (((ob >> 9) & 1) << 5)); }
__host__ __device__ __forceinline__ void stage_rc(int b, int& R, int& C) { const int st = b / 1024, sb = b % 1024, swz = sb ^ (((sb >> 9) & 1) << 5); R = (st >> 1) * 16 + swz / 64; C = (st & 1) * 32 + (swz % 64) / 2; }
__host__ __device__ __forceinline__ int perm32(int rho) { const int n = rho >> 4, i = rho & 15; return 8 * (i >> 2) + 4 * n + (i & 3); }

struct Unit { int pm, pn; };
struct Gemm { const bf16_t* A; const bf16_t* Bt; int M, N, K; };

struct StaticOrder {
    int nM, nN, nwg, G, c;
    __host__ __device__ void init(int M, int N, int G_, int c_) { nM = M / BM; nN = N / BM; nwg = nM * nN; G = G_; c = c_; }
    __host__ __device__ bool next(int i, Unit& u) const {
        const long L = (long)i * G + c; if (L >= nwg) return false;
        int wgid = (int)L; { const int q = nwg / NXCD, r = nwg % NXCD, xcd = wgid % NXCD, off = wgid / NXCD; wgid = (xcd < r ? xcd * (q + 1) : r * (q + 1) + (xcd - r) * q) + off; }
        const int nig = WGM * nN, gid = wgid / nig, fm = gid * WGM, gsz = (nM - fm) < WGM ? (nM - fm) : WGM;
        u.pm = fm + ((wgid % nig) % gsz); u.pn = (wgid % nig) / gsz; return true;
    }
    __device__ __forceinline__ void a_ready(const Unit&) const {}
    __device__ __forceinline__ void done(const Unit&) const {}
};
__device__ __forceinline__ unsigned cvt_pk_bf16(float lo, float hi) { unsigned r; asm volatile("v_cvt_pk_bf16_f32 %0, %1, %2" : "=v"(r) : "v"(lo), "v"(hi)); return r; }
typedef float f32x2 __attribute__((ext_vector_type(2)));
struct EpiF32 {
    static constexpr bool PERM = false, AFTER_DRAIN = false;
    float* C; int ldc; const float* bias;
    __device__ __forceinline__ void operator()(const f32x4 (&acc)[2][2][4][2], const Unit& u, int wr, int wc, int fr, int fq) const {
        const int row0 = u.pm * BM + wr * 64 + fr, col0 = u.pn * BM + wc * 32 + 4 * fq;
        f32x4 bv[2][2];
#pragma unroll
        for (int bj = 0; bj < 2; ++bj)
#pragma unroll
            for (int n = 0; n < 2; ++n) bv[bj][n] = bias ? *(const f32x4*)(bias + col0 + bj * HALF + n * 16) : (f32x4){0.f, 0.f, 0.f, 0.f};
#pragma unroll
        for (int ai = 0; ai < 2; ++ai)
#pragma unroll
            for (int m = 0; m < 4; ++m) { float* rowp = C + (size_t)(row0 + ai * HALF + m * 16) * ldc + col0;
#pragma unroll
                for (int bj = 0; bj < 2; ++bj)
#pragma unroll
                    for (int n = 0; n < 2; ++n) *(f32x4*)(rowp + bj * HALF + n * 16) = acc[ai][bj][m][n] + bv[bj][n]; }
    }
};
#define PG8_GAS __attribute__((address_space(1)))
constexpr float QSCALE = 0.125f * 1.4426950408889634f;
struct EpiProj {
    static constexpr bool PERM = true, AFTER_DRAIN = false; static constexpr int NST = 16;
    bf16_t* O; const float* cosT; const float* sinT; const float* lbrow; const float* rstd;
    __device__ __forceinline__ void operator()(const f32x4 (&acc)[2][2][4][2], const Unit& u, int wr, int wc, int fr, int fq) const {
        const int row0 = u.pm * BM + wr * 64 + fr, col0 = u.pn * BM + wc * 32 + 8 * fq;
        const bool rope = (u.pn >= 3 && u.pn <= 6), hgt = (u.pn >= 12);
        const int j8 = (wc & 1) * 4 + fq;
        float rs[2][4];
#pragma unroll
        for (int ai = 0; ai < 2; ++ai)
#pragma unroll
            for (int m = 0; m < 4; ++m) rs[ai][m] = *(const PG8_GAS float*)(rstd + row0 + ai * HALF + m * 16);
        if (rope) {
            const float qs = (u.pn == 3 || u.pn == 4) ? QSCALE : 1.f;
#pragma unroll
            for (int ai = 0; ai < 2; ++ai) { f32x4 c4[4], s4[4];
#pragma unroll
                for (int m = 0; m < 4; ++m) { const int pos = (row0 + ai * HALF + m * 16) & 2047; c4[m] = *(const PG8_GAS f32x4*)(cosT + pos * 32 + 4 * j8); s4[m] = *(const PG8_GAS f32x4*)(sinT + pos * 32 + 4 * j8); }
#pragma unroll
                for (int m = 0; m < 4; ++m) { bf16_t* rowp = O + (size_t)(row0 + ai * HALF + m * 16) * 4096 + col0; const float r = rs[ai][m] * qs;
#pragma unroll
                    for (int bj = 0; bj < 2; ++bj) { const f32x4 a0 = acc[ai][bj][m][0] * r, a1 = acc[ai][bj][m][1] * r;
                        const f32x4 v0 = a0 * c4[m] - a1 * s4[m], v1 = a1 * c4[m] + a0 * s4[m];
                        u32x4 w; w.x = cvt_pk_bf16(v0[0], v0[1]); w.y = cvt_pk_bf16(v0[2], v0[3]); w.z = cvt_pk_bf16(v1[0], v1[1]); w.w = cvt_pk_bf16(v1[2], v1[3]);
                        *(PG8_GAS u32x4*)(rowp + bj * HALF) = w; } } }
            return;
        }
        f32x4 lb0 = (f32x4){0.f, 0.f, 0.f, 0.f}, lb1 = lb0;
        if (hgt) { lb0 = *(const PG8_GAS f32x4*)(lbrow + (u.pn & 1) * 128 + wc * 32 + 8 * fq); lb1 = *(const PG8_GAS f32x4*)(lbrow + (u.pn & 1) * 128 + wc * 32 + 8 * fq + 4); }
#pragma unroll
        for (int ai = 0; ai < 2; ++ai)
#pragma unroll
            for (int m = 0; m < 4; ++m) { bf16_t* rowp = O + (size_t)(row0 + ai * HALF + m * 16) * 4096 + col0; const float r = rs[ai][m];
#pragma unroll
                for (int bj = 0; bj < 2; ++bj) { f32x4 v0 = acc[ai][bj][m][0] * r, v1 = acc[ai][bj][m][1] * r;
                    if (hgt && bj == 0) {
#pragma unroll
                        for (int e = 0; e < 4; ++e) { const float z0 = v0[e], z1 = v1[e];
                            const float e0 = __expf(-fabsf(z0)), r0 = __builtin_amdgcn_rcpf(1.f + e0), sg0 = z0 >= 0.f ? r0 : e0 * r0;
                            const float e1 = __expf(-fabsf(z1)), r1 = __builtin_amdgcn_rcpf(1.f + e1), sg1 = z1 >= 0.f ? r1 : e1 * r1;
                            v0[e] = __builtin_amdgcn_logf(fmaxf(lb0[e] + (1.f - lb0[e]) * sg0, 1e-30f)); v1[e] = __builtin_amdgcn_logf(fmaxf(lb1[e] + (1.f - lb1[e]) * sg1, 1e-30f)); } }
                    u32x4 w; w.x = cvt_pk_bf16(v0[0], v0[1]); w.y = cvt_pk_bf16(v0[2], v0[3]); w.z = cvt_pk_bf16(v1[0], v1[1]); w.w = cvt_pk_bf16(v1[2], v1[3]);
                    *(PG8_GAS u32x4*)(rowp + bj * HALF) = w; } }
    }
};
struct EpiY {
    static constexpr bool PERM = true, AFTER_DRAIN = false; static constexpr int NST = 16;
    bf16_t* O;
    __device__ __forceinline__ void operator()(const f32x4 (&acc)[2][2][4][2], const Unit& u, int wr, int wc, int fr, int fq) const {
        const int row0 = u.pm * BM + wr * 64 + fr, col0 = u.pn * BM + wc * 32 + 8 * fq;
#pragma unroll
        for (int ai = 0; ai < 2; ++ai)
#pragma unroll
            for (int m = 0; m < 4; ++m) { bf16_t* rowp = O + (size_t)(row0 + ai * HALF + m * 16) * 1024 + col0;
#pragma unroll
                for (int bj = 0; bj < 2; ++bj) { const f32x4 v0 = acc[ai][bj][m][0], v1 = acc[ai][bj][m][1];
                    u32x4 w; w.x = cvt_pk_bf16(v0[0], v0[1]); w.y = cvt_pk_bf16(v0[2], v0[3]); w.z = cvt_pk_bf16(v1[0], v1[1]); w.w = cvt_pk_bf16(v1[2], v1[3]);
                    *(PG8_GAS u32x4*)(rowp + bj * HALF) = w; } }
    }
};
template <class Epi, class Sched, bool ALIGN_EPI = false, bool SP2 = false>
__device__ __forceinline__ void gemm_phase(PG8_LAS unsigned char* lds, const Gemm g, const Sched& S, const Epi& E, int wave_s, int epi_rep = 0) {
    int tid_ = wave_s * 64 + lane_id_opaque(); asm volatile("" : "+v"(tid_));
    const int tid = tid_, wid = __builtin_amdgcn_readfirstlane(tid >> 6), lane = tid & 63, wr = wid >> 2, wc = wid & 3, fr = lane & 15, fq = lane >> 4;
    const int K = g.K, nt = K / BK;
    unsigned voffA[2], voffB[2];
#pragma unroll
    for (int i = 0; i < 2; ++i) { int R, C; stage_rc(tid * 16 + i * 8192, R, C); const int Rb = Epi::PERM ? ((R & ~31) + perm32(R & 31)) : R;
        voffA[i] = (unsigned)(R * K + C) * 2u; voffB[i] = (unsigned)(Rb * K + C) * 2u; }
    const size_t kstep = (size_t)(BK * 2);
    const size_t hstep = (size_t)HALF * K * 2;
    const size_t tstep = 2 * hstep;
    const unsigned ldsw = (unsigned)wid * 1024u;
    const int aoff = lds_byte(wr * 64 + fr, fq * 8), boff = lds_byte(wc * 32 + fr, fq * 8);
#define PG8_SA(b, h) (((b) * 2 + (h)) * HTB)
#define PG8_SB(b, h) ((4 + (b) * 2 + (h)) * HTB)
#define PG8_STAGE(bufoff, gbase, voff) do { _Pragma("unroll") for (int _i = 0; _i < 2; ++_i) \
        __builtin_amdgcn_global_load_lds((const unsigned*)((const char*)(gbase) + (voff)[_i]), (PG8_LAS unsigned*)(lds + (bufoff) + ldsw + _i * 8192), 16, 0, 0); } while (0)
#define PG8_LDA(dst, b, h) do { _Pragma("unroll") for (int m = 0; m < 4; ++m) _Pragma("unroll") for (int k = 0; k < 2; ++k) dst[m][k] = *(const PG8_LAS bf16x8*)(lds + PG8_SA(b, h) + aoff + m * 2048 + k * 1024); } while (0)
#define PG8_LDB(dst, b, h) do { _Pragma("unroll") for (int n = 0; n < 2; ++n) _Pragma("unroll") for (int k = 0; k < 2; ++k) dst[n][k] = *(const PG8_LAS bf16x8*)(lds + PG8_SB(b, h) + boff + n * 2048 + k * 1024); } while (0)
#define PG8_MMA(ai, bj, At, Bt) do { __builtin_amdgcn_s_setprio(1); _Pragma("unroll") for (int m = 0; m < 4; ++m) _Pragma("unroll") for (int n = 0; n < 2; ++n) _Pragma("unroll") for (int k = 0; k < 2; ++k) \
        acc[ai][bj][m][n] = __builtin_amdgcn_mfma_f32_16x16x32_bf16(Bt[n][k], At[m][k], acc[ai][bj][m][n], 0, 0, 0); __builtin_amdgcn_s_setprio(0); } while (0)
#define PG8_WAIT_V(n) asm volatile("s_waitcnt vmcnt(" #n ")" ::: "memory")
#define PG8_WAIT_L(n) asm volatile("s_waitcnt lgkmcnt(" #n ")" ::: "memory")
#define PG8_BAR __builtin_amdgcn_s_barrier()
#define PG8_SCHED __builtin_amdgcn_sched_barrier(0)
    Unit cur, nxt; int ui = 0;
    if (!S.next(0, cur)) return;
    f32x4 acc[2][2][4][2];
#pragma unroll
    for (int a = 0; a < 2; ++a)
#pragma unroll
        for (int b = 0; b < 2; ++b)
#pragma unroll
            for (int m = 0; m < 4; ++m)
#pragma unroll
                for (int n = 0; n < 2; ++n) acc[a][b][m][n] = (f32x4){0.f, 0.f, 0.f, 0.f};
    bf16x8 At[4][2], B0[2][2], B1[2][2];
    const char* cA = (const char*)g.A + (size_t)cur.pm * tstep; const char* cB = (const char*)g.Bt + (size_t)cur.pn * tstep;
    S.a_ready(cur);
    if constexpr (SP2) {
        PG8_STAGE(PG8_SB(0, 0), cB, voffB); PG8_STAGE(PG8_SB(0, 1), cB + hstep, voffB); PG8_STAGE(PG8_SA(0, 0), cA, voffA); PG8_STAGE(PG8_SA(0, 1), cA + hstep, voffA);
        if (wr == 1) PG8_BAR;
        PG8_WAIT_V(2); PG8_BAR;
        PG8_STAGE(PG8_SB(1, 0), cB + kstep, voffB); PG8_STAGE(PG8_SA(1, 0), cA + kstep, voffA); PG8_STAGE(PG8_SB(1, 1), cB + hstep + kstep, voffB);
        PG8_WAIT_V(6); PG8_BAR;
    } else {
        PG8_STAGE(PG8_SB(0, 0), cB, voffB); PG8_STAGE(PG8_SA(0, 0), cA, voffA); PG8_STAGE(PG8_SB(0, 1), cB + hstep, voffB); PG8_STAGE(PG8_SA(0, 1), cA + hstep, voffA);
        if (wr == 1) PG8_BAR;
        PG8_WAIT_V(4); PG8_BAR;
        PG8_STAGE(PG8_SB(1, 0), cB + kstep, voffB); PG8_STAGE(PG8_SA(1, 0), cA + kstep, voffA); PG8_STAGE(PG8_SB(1, 1), cB + hstep + kstep, voffB);
        PG8_WAIT_V(6); PG8_BAR;
    }
    for (;;) {
        const bool has_next = S.next(ui + 1, nxt);
        const char* nA = has_next ? (const char*)g.A + (size_t)nxt.pm * tstep : cA; const char* nB = has_next ? (const char*)g.Bt + (size_t)nxt.pn * tstep : cB;
        for (int t = 0; t < nt; t += 2) {
            const bool last = (t == nt - 2);
            const char* a1 = cA + (size_t)(t + 1) * kstep;
            const char* a2 = last ? nA : cA + (size_t)(t + 2) * kstep; const char* b2 = last ? nB : cB + (size_t)(t + 2) * kstep;
            const char* a3 = a2 + kstep; const char* b3 = b2 + kstep;
            if (last && has_next) S.a_ready(nxt);
            if constexpr (SP2) {
            PG8_LDB(B0, 0, 0); PG8_LDB(B1, 0, 1); PG8_SCHED; PG8_LDA(At, 0, 0); PG8_STAGE(PG8_SA(1, 1), a1 + hstep, voffA);
            PG8_WAIT_V(8); PG8_WAIT_L(0); PG8_BAR; PG8_MMA(0, 0, At, B0); PG8_MMA(0, 1, At, B1); PG8_BAR; PG8_SCHED;
            PG8_LDA(At, 0, 1); PG8_STAGE(PG8_SB(0, 0), b2, voffB); PG8_STAGE(PG8_SB(0, 1), b2 + hstep, voffB); PG8_STAGE(PG8_SA(0, 0), a2, voffA);
            PG8_WAIT_V(8); PG8_WAIT_L(0); PG8_BAR; PG8_MMA(1, 0, At, B0); PG8_MMA(1, 1, At, B1); PG8_BAR; PG8_SCHED;
            PG8_LDB(B0, 1, 0); PG8_LDB(B1, 1, 1); PG8_SCHED; PG8_LDA(At, 1, 0); PG8_STAGE(PG8_SA(0, 1), a2 + hstep, voffA);
            PG8_WAIT_V(8); PG8_WAIT_L(0); PG8_BAR; PG8_MMA(0, 0, At, B0); PG8_MMA(0, 1, At, B1); PG8_BAR; PG8_SCHED;
            PG8_LDA(At, 1, 1); PG8_STAGE(PG8_SB(1, 0), b3, voffB); PG8_STAGE(PG8_SB(1, 1), b3 + hstep, voffB); PG8_STAGE(PG8_SA(1, 0), a3, voffA);
            PG8_WAIT_V(8); PG8_WAIT_L(0); PG8_BAR; PG8_MMA(1, 0, At, B0); PG8_MMA(1, 1, At, B1); PG8_BAR; PG8_SCHED;
            } else {
            PG8_LDB(B0, 0, 0); PG8_SCHED; PG8_LDA(At, 0, 0); PG8_STAGE(PG8_SA(1, 1), a1 + hstep, voffA);
            PG8_WAIT_L(8); PG8_BAR; PG8_WAIT_L(0); PG8_MMA(0, 0, At, B0); PG8_BAR; PG8_SCHED;
            PG8_LDB(B1, 0, 1); PG8_STAGE(PG8_SB(0, 0), b2, voffB);
            PG8_BAR; PG8_WAIT_L(0); PG8_MMA(0, 1, At, B1); PG8_BAR;
            PG8_LDA(At, 0, 1); PG8_STAGE(PG8_SA(0, 0), a2, voffA);
            PG8_BAR; PG8_WAIT_L(0); PG8_MMA(1, 0, At, B0); PG8_BAR; PG8_SCHED;
            PG8_STAGE(PG8_SB(0, 1), b2 + hstep, voffB);
            PG8_WAIT_V(6); PG8_BAR; PG8_MMA(1, 1, At, B1); PG8_BAR;
            PG8_LDB(B0, 1, 0); PG8_SCHED; PG8_LDA(At, 1, 0); PG8_STAGE(PG8_SA(0, 1), a2 + hstep, voffA);
            PG8_WAIT_L(8); PG8_BAR; PG8_WAIT_L(0); PG8_MMA(0, 0, At, B0); PG8_BAR; PG8_SCHED;
            PG8_LDB(B1, 1, 1); PG8_STAGE(PG8_SB(1, 0), b3, voffB);
            PG8_BAR; PG8_WAIT_L(0); PG8_MMA(0, 1, At, B1); PG8_BAR;
            PG8_LDA(At, 1, 1); PG8_STAGE(PG8_SA(1, 0), a3, voffA);
            PG8_BAR; PG8_WAIT_L(0); PG8_MMA(1, 0, At, B0); PG8_BAR; PG8_SCHED;
            PG8_STAGE(PG8_SB(1, 1), b3 + hstep, voffB);
            PG8_WAIT_V(6); PG8_BAR; PG8_MMA(1, 1, At, B1); PG8_BAR;
            }
        }
        if constexpr (ALIGN_EPI) { if (wr == 0) PG8_BAR; }
        if constexpr (!Epi::AFTER_DRAIN) { if (epi_rep >= 0) E(acc, cur, wr, wc, fr, fq); else {
#pragma unroll
                for (int a_ = 0; a_ < 2; ++a_)
#pragma unroll
                    for (int b_ = 0; b_ < 2; ++b_)
#pragma unroll
                        for (int m_ = 0; m_ < 4; ++m_) asm volatile("" :: "v"(acc[a_][b_][m_][0]), "v"(acc[a_][b_][m_][1])); }
            for (int er_ = 0; er_ < epi_rep; ++er_) E(acc, cur, wr, wc, fr, fq); S.done(cur); }
        if (!has_next) break;
#pragma unroll
        for (int a = 0; a < 2; ++a)
#pragma unroll
            for (int b = 0; b < 2; ++b)
#pragma unroll
                for (int m = 0; m < 4; ++m)
#pragma unroll
                    for (int n = 0; n < 2; ++n) acc[a][b][m][n] = (f32x4){0.f, 0.f, 0.f, 0.f};
        cur = nxt; cA = nA; cB = nB; ++ui;
        if constexpr (ALIGN_EPI) { if (wr == 1) PG8_BAR; }
    }
    PG8_WAIT_V(0);
    if constexpr (!ALIGN_EPI) { if (wr == 0) PG8_BAR; }
    PG8_BAR;
    if constexpr (Epi::AFTER_DRAIN) { E.fused(acc, cur, wr, wc, fr, fq, lds, wid, lane); S.done(cur); }
#undef PG8_SA
#undef PG8_SB
#undef PG8_STAGE
#undef PG8_LDA
#undef PG8_LDB
#undef PG8_MMA
#undef PG8_WAIT_V
#undef PG8_WAIT_L
#undef PG8_BAR
#undef PG8_SCHED
}
}
namespace dattn {
using bf16x8 = __attribute__((ext_vector_type(8))) short;
using s16x4  = __attribute__((ext_vector_type(4))) short;
using f32x16 = __attribute__((ext_vector_type(16))) float;
using u32x4  = __attribute__((ext_vector_type(4))) unsigned;
typedef unsigned short bf16r;
constexpr int NW = 8, QBLK = 32, KVBLK = 64, SEQ = 2048, LDP = 4096;
constexpr float SCALE = 0.125f, THR = 8.f;
constexpr int TILE_B = KVBLK * 128 * 2, NKSLOT = 3, NVSLOT = 5, VRING = NKSLOT * TILE_B; constexpr size_t SHM_WS = 131072;
#define KSWZ(row, colB) ((row) * 256 + ((colB) ^ ((((row) & 7) << 4) | ((((row) >> 3) & 1) << 7))))
#define SBAR() __builtin_amdgcn_sched_barrier(0)
__device__ __forceinline__ int crow(int r, int hi) { return (r & 3) + 8 * (r >> 2) + 4 * hi; }
__device__ __forceinline__ unsigned cvtpk(float lo, float hi) { unsigned r; asm volatile("v_cvt_pk_bf16_f32 %0, %1, %2" : "=v"(r) : "v"(lo), "v"(hi)); return r; }

constexpr float THR2 = THR * 1.4426950408889634f;
template <int VAR = 0, bool FIRST = false> __device__ __forceinline__ void partialSM(f32x16& p0, f32x16& p1, f32x16& negm, float& alpha) {
  if (VAR & 32) { alpha = 1.f; return; }
  float pmax = p0[0];
#pragma unroll
  for (int r = 1; r < 16; ++r) pmax = fmaxf(pmax, p0[r]);
#pragma unroll
  for (int r = 0; r < 16; ++r) pmax = fmaxf(pmax, p1[r]);
  { auto rr = __builtin_amdgcn_permlane32_swap(__float_as_uint(pmax), __float_as_uint(pmax), false, false);
    pmax = fmaxf(__uint_as_float(rr[0]), __uint_as_float(rr[1])); }
  alpha = 1.f;
  if (FIRST || !__builtin_expect(__all(pmax <= THR2), 1)) {
    const float dl = FIRST ? pmax : fmaxf(pmax, 0.f);
#pragma unroll
    for (int r = 0; r < 16; ++r) { p0[r] -= dl; p1[r] -= dl; }
    const float nm = negm[0] - dl;
#pragma unroll
    for (int r = 0; r < 16; ++r) negm[r] = nm;
    alpha = FIRST ? 1.f : __builtin_amdgcn_exp2f(-dl);
  }
#pragma unroll
  for (int r = 0; r < 16; ++r) p0[r] = (VAR & 1) ? p0[r] : __builtin_amdgcn_exp2f(p0[r]);
}
template <int VAR = 0> __device__ __forceinline__ void finishSM(f32x16& p0, f32x16& p1, float alpha, float& l_reg, bf16x8& pa0, bf16x8& pa1, bf16x8& pa2, bf16x8& pa3) {
#pragma unroll
  for (int r = 0; r < 16; ++r) p1[r] = (VAR & (1 | 32)) ? p1[r] : __builtin_amdgcn_exp2f(p1[r]);
  float ps = 0;
  if (!(VAR & 32)) {
#pragma unroll
  for (int r = 0; r < 16; ++r) ps += p0[r];
#pragma unroll
  for (int r = 0; r < 16; ++r) ps += p1[r];
  { auto rr = __builtin_amdgcn_permlane32_swap(__float_as_uint(ps), __float_as_uint(ps), false, false);
    ps = __uint_as_float(rr[0]) + __uint_as_float(rr[1]); }
  l_reg = l_reg * alpha + ps; }
#define PK4(P, BASE, OUT) do { unsigned a0 = cvtpk(P[BASE + 0], P[BASE + 1]), a1 = cvtpk(P[BASE + 2], P[BASE + 3]);   \
    unsigned b0 = cvtpk(P[BASE + 4], P[BASE + 5]), b1 = cvtpk(P[BASE + 6], P[BASE + 7]);                              \
    auto r0 = __builtin_amdgcn_permlane32_swap(a0, b0, false, false); auto r1 = __builtin_amdgcn_permlane32_swap(a1, b1, false, false); \
    u32x4 w = {r0[0], r1[0], r0[1], r1[1]}; OUT = *reinterpret_cast<bf16x8*>(&w); } while (0)
  PK4(p0, 0, pa0); PK4(p0, 8, pa1); PK4(p1, 0, pa2); PK4(p1, 8, pa3);
#undef PK4
}
template <int VAR = 0> __device__ __forceinline__ void qkt(f32x16& p0, f32x16& p1, const char* Ks, const bf16x8* qr, int r32, int hi, int colb0, const f32x16& negm) {
  p0 = negm; p1 = negm;
  if (VAR & 4) { asm volatile("" : "+v"(p0), "+v"(p1)); return; }
  bf16x8 kf[2][2];
  { const int cb = colb0 + (hi * 8) * 2; kf[0][0] = *reinterpret_cast<const bf16x8*>(Ks + KSWZ(r32, cb)); kf[0][1] = *reinterpret_cast<const bf16x8*>(Ks + KSWZ(32 + r32, cb)); }
#pragma unroll
  for (int d0 = 0; d0 < 4; ++d0) {
    if (d0 < 3) { const int cb = colb0 + ((d0 + 1) * 16 + hi * 8) * 2; kf[(d0 + 1) & 1][0] = *reinterpret_cast<const bf16x8*>(Ks + KSWZ(r32, cb)); kf[(d0 + 1) & 1][1] = *reinterpret_cast<const bf16x8*>(Ks + KSWZ(32 + r32, cb)); }
    __builtin_amdgcn_sched_group_barrier(0x100, 2, 0);
    p0 = __builtin_amdgcn_mfma_f32_32x32x16_bf16(kf[d0 & 1][0], qr[d0], p0, 0, 0, 0);
    p1 = __builtin_amdgcn_mfma_f32_32x32x16_bf16(kf[d0 & 1][1], qr[d0], p1, 0, 0, 0);
    __builtin_amdgcn_sched_group_barrier(0x008, 2, 0); }
}
__device__ __forceinline__ int v_st(int k, int c) { const int kk = (k & ~0xC) | ((k & 4) << 1) | ((k & 8) >> 1); return ((kk >> 3) * 4 + (c >> 5)) * 512 + ((kk & 7) * 32 + (c & 31)) * 2; }
__device__ __forceinline__ int v_rd_base(int lane) { return ((lane & 3) << 3) | (((lane >> 2) & 3) << 6) | (((lane >> 4) & 1) << 5) | (((lane >> 5) & 1) << 8); }
constexpr int v_rd_off(int d0, int ks, int half) { return d0 * 512 + ks * 4096 + half * 2048; }
template <int OFF> __device__ __forceinline__ s16x4 tr_read(int vb) {
  s16x4 r; asm volatile("ds_read_b64_tr_b16 %0, %1 offset:%2" : "=&v"(r) : "v"(vb), "i"(OFF) : "memory"); return r;
}
template <int D0> __device__ __forceinline__ void pv_one(f32x16& od, int vb, bf16x8 pa0, bf16x8 pa1, bf16x8 pa2, bf16x8 pa3) {
  const s16x4 l0 = tr_read<v_rd_off(D0, 0, 0)>(vb), h0 = tr_read<v_rd_off(D0, 0, 1)>(vb), l1 = tr_read<v_rd_off(D0, 1, 0)>(vb), h1 = tr_read<v_rd_off(D0, 1, 1)>(vb);
  const s16x4 l2 = tr_read<v_rd_off(D0, 2, 0)>(vb), h2 = tr_read<v_rd_off(D0, 2, 1)>(vb), l3 = tr_read<v_rd_off(D0, 3, 0)>(vb), h3 = tr_read<v_rd_off(D0, 3, 1)>(vb);
  asm volatile("s_waitcnt lgkmcnt(0)" ::: "memory"); SBAR();
#define PK(L, H) (bf16x8){L[0], L[1], L[2], L[3], H[0], H[1], H[2], H[3]}
  od = __builtin_amdgcn_mfma_f32_32x32x16_bf16(pa0, PK(l0, h0), od, 0, 0, 0);
  od = __builtin_amdgcn_mfma_f32_32x32x16_bf16(pa1, PK(l1, h1), od, 0, 0, 0);
  od = __builtin_amdgcn_mfma_f32_32x32x16_bf16(pa2, PK(l2, h2), od, 0, 0, 0);
  od = __builtin_amdgcn_mfma_f32_32x32x16_bf16(pa3, PK(l3, h3), od, 0, 0, 0);
#undef PK
}
template <int VAR = 0> __device__ __forceinline__ void pv_d0(f32x16* o, int vb, bf16x8 pa0, bf16x8 pa1, bf16x8 pa2, bf16x8 pa3) {
  if (VAR & 2) { asm volatile("" :: "v"(pa0), "v"(pa1), "v"(pa2), "v"(pa3)); return; }
  pv_one<0>(o[0], vb, pa0, pa1, pa2, pa3); pv_one<1>(o[1], vb, pa0, pa1, pa2, pa3); pv_one<2>(o[2], vb, pa0, pa1, pa2, pa3); pv_one<3>(o[3], vb, pa0, pa1, pa2, pa3);
}
struct VPre { s16x4 l0, h0, l1, h1; };
__device__ __forceinline__ void pv_load0(VPre& v, int vb) {
  v.l0 = tr_read<v_rd_off(0, 0, 0)>(vb); v.h0 = tr_read<v_rd_off(0, 0, 1)>(vb); v.l1 = tr_read<v_rd_off(0, 1, 0)>(vb); v.h1 = tr_read<v_rd_off(0, 1, 1)>(vb);
}
template <int N> __device__ __forceinline__ void ld_half(s16x4 (&h)[4], int vb) { constexpr int d0 = N >> 1, k0 = 2 * (N & 1);
  h[0] = tr_read<v_rd_off(d0, k0, 0)>(vb); h[1] = tr_read<v_rd_off(d0, k0, 1)>(vb); h[2] = tr_read<v_rd_off(d0, k0 + 1, 0)>(vb); h[3] = tr_read<v_rd_off(d0, k0 + 1, 1)>(vb); }
template <int N> __device__ __forceinline__ void mm_half(f32x16* o, const s16x4 (&h)[4], bf16x8 pa0, bf16x8 pa1, bf16x8 pa2, bf16x8 pa3) { constexpr int d0 = N >> 1;
#define PK(L, H) (bf16x8){L[0], L[1], L[2], L[3], H[0], H[1], H[2], H[3]}
  o[d0] = __builtin_amdgcn_mfma_f32_32x32x16_bf16((N & 1) ? pa2 : pa0, PK(h[0], h[1]), o[d0], 0, 0, 0);
  o[d0] = __builtin_amdgcn_mfma_f32_32x32x16_bf16((N & 1) ? pa3 : pa1, PK(h[2], h[3]), o[d0], 0, 0, 0);
#undef PK
}
#define LW(n, H) asm volatile("s_waitcnt lgkmcnt(" #n ")" : "+v"(H[0]), "+v"(H[1]), "+v"(H[2]), "+v"(H[3]) :: "memory")
template <int VAR = 0> __device__ __forceinline__ void pv_d0p(f32x16* o, int vb, const VPre& v, bf16x8 pa0, bf16x8 pa1, bf16x8 pa2, bf16x8 pa3) {
  if (VAR & 2) { asm volatile("" :: "v"(pa0), "v"(pa1), "v"(pa2), "v"(pa3)); return; }
  s16x4 A[4] = {v.l0, v.h0, v.l1, v.h1}, B[4], C[4];
  ld_half<1>(B, vb); ld_half<2>(C, vb);
  LW(8, A); mm_half<0>(o, A, pa0, pa1, pa2, pa3); ld_half<3>(A, vb);
  LW(8, B); mm_half<1>(o, B, pa0, pa1, pa2, pa3); ld_half<4>(B, vb);
  LW(8, C); mm_half<2>(o, C, pa0, pa1, pa2, pa3); ld_half<5>(C, vb);
  LW(8, A); mm_half<3>(o, A, pa0, pa1, pa2, pa3); ld_half<6>(A, vb);
  LW(8, B); mm_half<4>(o, B, pa0, pa1, pa2, pa3); ld_half<7>(B, vb);
  LW(8, C); mm_half<5>(o, C, pa0, pa1, pa2, pa3);
  LW(4, A); mm_half<6>(o, A, pa0, pa1, pa2, pa3);
  LW(0, B); mm_half<7>(o, B, pa0, pa1, pa2, pa3);
}
#undef LW
__device__ __forceinline__ float bf2f(unsigned short u) { return __uint_as_float((unsigned)u << 16); }
__device__ __forceinline__ unsigned short f2bf(float f) { unsigned u = __float_as_uint(f); return (unsigned short)((u + 0x7fffu + ((u >> 16) & 1u)) >> 16); }

template <int VAR = 0> __device__ __forceinline__ void diff_unit(const bf16r* __restrict__ Qb, const bf16r* __restrict__ Kh, const bf16r* __restrict__ Vh, const bf16r* __restrict__ Gb,
                                          bf16r* __restrict__ Ob, float lam, const float* __restrict__ nw, float nwscale, char* lds, int wave_s,
                                          const bf16r* Qn, const bf16r* Kn, const bf16r* Vn, bool pre, bf16x8 (&qr)[4]) {
  int tid_ = wave_s * 64 + lane_id_opaque(); asm volatile("" : "+v"(tid_));
  const int tid = tid_, wid = tid >> 6, lane = tid & 63, r32 = lane & 31, hi = lane >> 5;
  const int mp = wid >> 2, rg = wid & 3;
  char* K_lds = lds; char* V_lds = lds + VRING;
  float* ws = (float*)(lds + SHM_WS) + wid * 64; float* li_l = ws; float* al_l = ws + 32;
  float l_reg = 0; f32x16 o[4] = {}; f32x16 negm = {};
  const long qoff = (long)(rg * QBLK + r32) * LDP + mp * 64 + hi * 8;
  if (!pre) {
#pragma unroll
    for (int d0 = 0; d0 < 4; ++d0) qr[d0] = *(const __attribute__((address_space(1))) bf16x8*)(Qb + qoff + d0 * 16); }
  const int colb0 = mp * 128;
  const int vb0 = (int)(uintptr_t)V_lds + v_rd_base(lane);
  unsigned ksrc[2], vsrc[2];
#pragma unroll
  for (int i = 0; i < 2; ++i) { const int q = 2 * wave_s + i;
    { const int row = 4 * q + (lane >> 4), slot = lane & 15; const int colB = (slot * 16) ^ (((row & 7) << 4) | (((row >> 3) & 1) << 7)); ksrc[i] = (unsigned)(row * LDP + colB / 2); }
    { const int sub = 2 * q + (lane >> 5), kk = (sub >> 2) * 8 + ((lane & 31) >> 2), key = (kk & ~0xC) | ((kk & 4) << 1) | ((kk & 8) >> 1), col = (sub & 3) * 32 + 8 * (lane & 3); vsrc[i] = (unsigned)(key * LDP + col); } }
  int kslot = 0, vslot = 0;
#define DMA_TILE(t) DMA_TILE_AT(Kh, Vh, t)
#define DMA_TILE_AT(KB_, VB_, t) do { if (VAR & 8) break; const int t_ = (t) < NT ? (t) : NT - 1; const bf16r* kg_ = (KB_) + (long)t_ * KVBLK * LDP; const bf16r* vg_ = (VB_) + (long)t_ * KVBLK * LDP; \
    _Pragma("unroll") for (int i_ = 0; i_ < 2; ++i_) { \
      __builtin_amdgcn_global_load_lds((const unsigned*)(kg_ + ksrc[i_]), (__attribute__((address_space(3))) unsigned*)(K_lds + kslot + (2 * wave_s + i_) * 1024), 16, 0, 0); \
      __builtin_amdgcn_global_load_lds((const unsigned*)(vg_ + vsrc[i_]), (__attribute__((address_space(3))) unsigned*)(V_lds + vslot + (2 * wave_s + i_) * 1024), 16, 0, 0); } \
    kslot = kslot == (NKSLOT - 1) * TILE_B ? 0 : kslot + TILE_B; vslot = vslot == (NVSLOT - 1) * TILE_B ? 0 : vslot + TILE_B; } while (0)
#define LAND_BAR() do { if (VAR & 64) asm volatile("s_waitcnt lgkmcnt(0)" ::: "memory"); else asm volatile("s_waitcnt vmcnt(4) lgkmcnt(0)" ::: "memory"); if (!(VAR & 16)) __builtin_amdgcn_s_barrier(); asm volatile("" ::: "memory"); } while (0)
#define RESC(a) do { if (__any((a) < 1.f)) { if (hi == 0) al_l[r32] = (a); asm volatile("s_waitcnt lgkmcnt(0)" ::: "memory"); \
    _Pragma("unroll") for (int d = 0; d < 4; ++d) _Pragma("unroll") for (int r = 0; r < 16; ++r) o[d][r] *= al_l[crow(r, hi)]; } } while (0)
  f32x16 pA0, pA1, pB0, pB1; float alA, alB; bf16x8 pa0, pa1, pa2, pa3; const int NT = SEQ / KVBLK;
  int kr = 0, vr = 0;
#define ADV_K() do { kr = kr == (NKSLOT - 1) * TILE_B ? 0 : kr + TILE_B; } while (0)
#define ADV_V() do { vr = vr == (NVSLOT - 1) * TILE_B ? 0 : vr + TILE_B; } while (0)
  if (pre) { kslot = TILE_B; vslot = TILE_B; } else DMA_TILE(0);
  DMA_TILE(1); LAND_BAR();
  if (mp == 0) {
  qkt<VAR>(pA0, pA1, K_lds + kr, qr, r32, hi, colb0, negm); partialSM<VAR, true>(pA0, pA1, negm, alA); ADV_K();
  DMA_TILE(2); LAND_BAR();
  VPre vpre;
  for (int j = 1; j + 1 < NT; j += 2) {
    SBAR(); DMA_TILE(j + 2); SBAR();
    qkt<VAR>(pB0, pB1, K_lds + kr, qr, r32, hi, colb0, negm); pv_load0(vpre, vb0 + vr);
    finishSM<VAR>(pA0, pA1, alA, l_reg, pa0, pa1, pa2, pa3); SBAR();
    pv_d0p<VAR>(o, vb0 + vr, vpre, pa0, pa1, pa2, pa3); partialSM<VAR>(pB0, pB1, negm, alB);
    RESC(alB); LAND_BAR(); ADV_K(); ADV_V();
    SBAR(); DMA_TILE(j + 3); SBAR();
    qkt<VAR>(pA0, pA1, K_lds + kr, qr, r32, hi, colb0, negm); pv_load0(vpre, vb0 + vr);
    finishSM<VAR>(pB0, pB1, alB, l_reg, pa0, pa1, pa2, pa3); SBAR();
    pv_d0p<VAR>(o, vb0 + vr, vpre, pa0, pa1, pa2, pa3); partialSM<VAR>(pA0, pA1, negm, alA);
    RESC(alA); LAND_BAR(); ADV_K(); ADV_V();
  }
  SBAR(); qkt<VAR>(pB0, pB1, K_lds + kr, qr, r32, hi, colb0, negm);
  finishSM<VAR>(pA0, pA1, alA, l_reg, pa0, pa1, pa2, pa3); SBAR();
  pv_d0<VAR>(o, vb0 + vr, pa0, pa1, pa2, pa3); partialSM<VAR>(pB0, pB1, negm, alB); ADV_V();
  RESC(alB);
  finishSM<VAR>(pB0, pB1, alB, l_reg, pa0, pa1, pa2, pa3); SBAR();
  pv_d0<VAR>(o, vb0 + vr, pa0, pa1, pa2, pa3);
  } else {
  SBAR(); DMA_TILE(2); SBAR();
  qkt<VAR>(pA0, pA1, K_lds + kr, qr, r32, hi, colb0, negm); ADV_K(); LAND_BAR();
  SBAR(); DMA_TILE(3); SBAR();
  partialSM<VAR, true>(pA0, pA1, negm, alA);
  qkt<VAR>(pB0, pB1, K_lds + kr, qr, r32, hi, colb0, negm);
  finishSM<VAR>(pA0, pA1, alA, l_reg, pa0, pa1, pa2, pa3); ADV_K(); LAND_BAR();
  for (int j = 2; j < NT; j += 2) {
    SBAR(); DMA_TILE(j + 2); SBAR();
    pv_d0<VAR>(o, vb0 + vr, pa0, pa1, pa2, pa3); partialSM<VAR>(pB0, pB1, negm, alB); RESC(alB); ADV_V(); SBAR();
    qkt<VAR>(pA0, pA1, K_lds + kr, qr, r32, hi, colb0, negm);
    finishSM<VAR>(pB0, pB1, alB, l_reg, pa0, pa1, pa2, pa3); ADV_K(); LAND_BAR();
    SBAR(); DMA_TILE(j + 3); SBAR();
    pv_d0<VAR>(o, vb0 + vr, pa0, pa1, pa2, pa3); partialSM<VAR>(pA0, pA1, negm, alA); RESC(alA); ADV_V(); SBAR();
    qkt<VAR>(pB0, pB1, K_lds + kr, qr, r32, hi, colb0, negm);
    finishSM<VAR>(pA0, pA1, alA, l_reg, pa0, pa1, pa2, pa3); ADV_K();
    if (j + 2 < NT) LAND_BAR();
  }
  SBAR(); pv_d0<VAR>(o, vb0 + vr, pa0, pa1, pa2, pa3); partialSM<VAR>(pB0, pB1, negm, alB); RESC(alB); ADV_V();
  finishSM<VAR>(pB0, pB1, alB, l_reg, pa0, pa1, pa2, pa3); SBAR();
  pv_d0<VAR>(o, vb0 + vr, pa0, pa1, pa2, pa3);
  }
  asm volatile("s_waitcnt vmcnt(0)" ::: "memory");
#undef LAND_BAR
#undef ADV_K
#undef ADV_V
  if (hi == 0) li_l[r32] = l_reg; asm volatile("s_waitcnt lgkmcnt(0)" ::: "memory");
  float rli[16];
#pragma unroll
  for (int r = 0; r < 16; ++r) rli[r] = __builtin_amdgcn_rcpf(li_l[crow(r, hi)]);
  u32x4 gpre[4];
#pragma unroll
  for (int it = 0; it < 4; ++it) gpre[it] = *(const __attribute__((address_space(1))) u32x4*)(Gb + (long)(wid * 16 + it * 4 + (lane >> 4)) * LDP + (lane & 15) * 8);
  typedef float f32x4e __attribute__((ext_vector_type(4)));
  const int c0 = (lane & 15) * 8;
  const f32x4e w0 = *(const __attribute__((address_space(1))) f32x4e*)(nw + c0) * nwscale, w1 = *(const __attribute__((address_space(1))) f32x4e*)(nw + c0 + 4) * nwscale;
  __syncthreads();
  float* X = (float*)lds + rg * (16 * 4 * 64);
  float* Y = (float*)(lds + 65536);
  if (mp == 1) {
#pragma unroll
    for (int r = 0; r < 16; ++r)
#pragma unroll
      for (int d0 = 0; d0 < 4; ++d0) X[(r * 4 + d0) * 64 + lane] = o[d0][r] * rli[r];
  }
  __syncthreads();
  if (mp == 0) {
#pragma unroll
    for (int r = 0; r < 16; ++r)
#pragma unroll
      for (int d0 = 0; d0 < 4; ++d0) Y[(rg * QBLK + crow(r, hi)) * 128 + d0 * 32 + r32] = o[d0][r] * rli[r] - lam * X[(r * 4 + d0) * 64 + lane];
  }
  __syncthreads();
  if (Qn) {
#pragma unroll
    for (int d0 = 0; d0 < 4; ++d0) qr[d0] = *(const __attribute__((address_space(1))) bf16x8*)(Qn + qoff + d0 * 16);
    kslot = 0; vslot = 0; DMA_TILE_AT(Kn, Vn, 0); }
  {
#pragma unroll
    for (int it = 0; it < 4; ++it) { const int row = wid * 16 + it * 4 + (lane >> 4);
      const f32x4e a0 = *(const f32x4e*)(Y + row * 128 + c0), a1 = *(const f32x4e*)(Y + row * 128 + c0 + 4);
      float s = (a0[0] * a0[0] + a0[1] * a0[1]) + (a0[2] * a0[2] + a0[3] * a0[3]) + (a1[0] * a1[0] + a1[1] * a1[1]) + (a1[2] * a1[2] + a1[3] * a1[3]);
      s += xor_shfl<1>(s); s += xor_shfl<2>(s); s += xor_shfl<4>(s); s += xor_shfl<8>(s);
      const float rs = 1.f / sqrtf(s * (1.f / 128.f) + 1e-6f);
      const u32x4 gq = gpre[it];
      float gv[8];
#pragma unroll
      for (int e = 0; e < 4; ++e) { gv[2 * e] = __uint_as_float(gq[e] << 16); gv[2 * e + 1] = __uint_as_float(gq[e] & 0xffff0000u); }
      float ov[8];
#pragma unroll
      for (int e = 0; e < 8; ++e) { const float g = gv[e]; const float sg = g / (1.f + __expf(-g)); const float a = e < 4 ? a0[e] : a1[e - 4]; const float w = e < 4 ? w0[e] : w1[e - 4]; ov[e] = a * rs * w * sg; }
      u32x4 ow; ow[0] = cvtpk(ov[0], ov[1]); ow[1] = cvtpk(ov[2], ov[3]); ow[2] = cvtpk(ov[4], ov[5]); ow[3] = cvtpk(ov[6], ov[7]);
      *(__attribute__((address_space(1))) u32x4*)(Ob + (long)row * 1024 + c0) = ow; }
  }
  asm volatile("s_waitcnt lgkmcnt(0)" ::: "memory"); __builtin_amdgcn_s_barrier(); asm volatile("" ::: "memory");
#undef RESC
#undef DMA_TILE
#undef DMA_TILE_AT
}
#undef KSWZ
#undef SBAR
}
#define GAS __attribute__((address_space(1)))
#define LAS __attribute__((address_space(3)))
typedef unsigned short bf16;
typedef unsigned v4u __attribute__((ext_vector_type(4)));
typedef float f32x4 __attribute__((ext_vector_type(4)));
typedef short bf16x8 __attribute__((ext_vector_type(8)));
constexpr int NWAVES = 8;
constexpr int BATCH = 16, SEQ = 2048, DM = 1024, DEPTH = 4, M = BATCH * SEQ;
constexpr int IN_W = 4128, NP = 4096, NPA = 4128;
constexpr float EPS = 1e-6f;
constexpr int PQ_GQ = 0, PQ_GK = 128, PQ_GV = 256, PQ_GG = 512, PQ_DQ = 768, PQ_DK = 1280, PQ_DV = 1792, PQ_DG = 2304, PQ_HQ = 2816;
__host__ __device__ constexpr int col_hzf(int h) { return 3072 + (h >> 1) * 256 + (h & 1) * 64; }
__host__ __device__ constexpr int col_hi(int h) { return col_hzf(h) + 128; }
__host__ __device__ constexpr int col_hzb(int h) { return 3584 + (h >> 1) * 256 + (h & 1) * 64; }
__host__ __device__ constexpr int col_hg(int h) { return col_hzb(h) + 128; }
constexpr size_t MiB = 1u << 20;
constexpr size_t WS_CTL = 0;
constexpr size_t WS_WIN = 1 * MiB;
constexpr size_t WS_WOUT = WS_WIN + (size_t)4 * 4128 * 1024 * 2;
constexpr size_t WS_ROPE = WS_WOUT + 8 * MiB;
constexpr size_t WS_LB = WS_ROPE + 512 * 1024;
constexpr size_t WS_A = WS_LB + 65536;
constexpr size_t WS_RSTD = WS_CTL + 256 * 1024;
constexpr size_t WS_H = 46 * MiB;
constexpr size_t WS_MIX = 110 * MiB;
constexpr size_t WS_PROJ = 174 * MiB;
constexpr size_t WS_Y = WS_PROJ;
constexpr size_t WS_OSC0 = WS_H;
constexpr size_t WS_OSC1 = WS_H + 32 * MiB;
constexpr size_t WS_XB = 430 * MiB;
constexpr size_t WS_END = 494 * MiB;
static_assert(WS_A + (size_t)M * 32 * 4 <= WS_H, "ws map");
constexpr int LDS_BYTES = 147456;

__device__ __forceinline__ float bf2f(unsigned short u) { return __uint_as_float((unsigned)u << 16); }
__device__ __forceinline__ unsigned f2bf(float f) { unsigned u = __float_as_uint(f); return (u + 0x7fffu + ((u >> 16) & 1u)) >> 16; }
__device__ __forceinline__ unsigned pk2(float lo, float hi) { return f2bf(lo) | (f2bf(hi) << 16); }
__device__ __forceinline__ float wave_sum(float v) {
    v += xor_shfl<1>(v); v += xor_shfl<2>(v); v += xor_shfl<4>(v); v += xor_shfl<8>(v); v += xor_shfl<16>(v); v += xor_shfl<32>(v);
    return v;
}
#define LDS_WAIT() asm volatile("s_waitcnt lgkmcnt(0)" ::: "memory")
#define VM_WAIT() asm volatile("s_waitcnt vmcnt(0)" ::: "memory")

struct Args {
    const float* x; const float* norm_pre; const float* norm_post; const float* w_in; const float* w_out;
    const float* gla_wa2_f; const float* gla_ba_f; const float* gla_wa2_b; const float* gla_ba_b; const float* gla_norm;
    const float* lq1; const float* lk1; const float* lq2; const float* lk2; const float* diff_norm; const float* lb_logits; const float* hgrn_norm;
    float* out; unsigned char* ws; int ph_lo, ph_hi, rep, pad;
};
struct Frame { LAS unsigned char* lds; int tid, lane, wave, vcu, G; };

__device__ __forceinline__ int src_col(int p) {
    if (p >= NP) return 768 + (p - NP);
    if (p < 768) return p;
    if (p < 1792) { const int base = p & ~63, e = p & 63, j8 = e >> 3, e8 = e & 7; const int d = (e8 < 4) ? 4 * j8 + e8 : 32 + 4 * j8 + (e8 - 4); return base + d + 32; }
    if (p < 3072) return p + 32;
    { const int t = (p - 3072) >> 8, w = (p - 3072) & 255, half = w >> 7, h = (t & 1) * 2 + ((w & 127) >> 6), k = w & 63;
      const int base = (t < 2) ? (half ? 3616 : 3104) : (half ? 3872 : 3360); return base + h * 64 + k; }
}
__device__ __forceinline__ void transpose_item(const float* W, int srcN, bool remap, bf16* WT, LAS float* scr, int kb, int nb, int lane, const float* kscale = nullptr) {
    const int k0 = 64 * kb, n0 = 32 * nb; const int sc = remap ? src_col(n0 + (lane & 31)) : n0 + (lane & 31);
    float wv[32];
#pragma unroll
    for (int i = 0; i < 32; ++i) { const int kk = 2 * i + (lane >> 5); wv[i] = *(const GAS float*)(W + (size_t)(k0 + kk) * srcN + sc); }
    if (kscale) {
#pragma unroll
        for (int i = 0; i < 32; ++i) { const int kk = 2 * i + (lane >> 5); wv[i] *= *(const GAS float*)(kscale + k0 + kk); } }
#pragma unroll
    for (int i = 0; i < 32; ++i) { const int kk = 2 * i + (lane >> 5); scr[kk * 33 + (lane & 31)] = wv[i]; }
    LDS_WAIT(); asm volatile("" ::: "memory");
    const int c = lane & 7;
#pragma unroll
    for (int j = 0; j < 4; ++j) { const int n = (lane >> 3) + 8 * j; const LAS float* s = scr + (8 * c) * 33 + n;
        v4u o; o.x = pk2(s[0 * 33], s[1 * 33]); o.y = pk2(s[2 * 33], s[3 * 33]); o.z = pk2(s[4 * 33], s[5 * 33]); o.w = pk2(s[6 * 33], s[7 * 33]);
        *(GAS v4u*)(WT + (size_t)(n0 + n) * DM + k0 + 8 * c) = o; }
    LDS_WAIT(); asm volatile("" ::: "memory");
}
__device__ __forceinline__ void row_to_bf16_rstd(const f32x4 (&v)[4], bf16* orow, float* rstd, int lane) {
    float s = 0.f;
#pragma unroll
    for (int j = 0; j < 4; ++j) s += (v[j].x * v[j].x + v[j].y * v[j].y) + (v[j].z * v[j].z + v[j].w * v[j].w);
    const float r = 1.f / sqrtf(wave_sum(s) * (1.f / DM) + EPS);
    GAS unsigned long long* o8 = (GAS unsigned long long*)orow + lane;
#pragma unroll
    for (int j = 0; j < 4; ++j) o8[64 * j] = (unsigned long long)pk2(v[j].x, v[j].y) | ((unsigned long long)pk2(v[j].z, v[j].w) << 32);
    if (lane == 0) *(GAS float*)rstd = r;
}

__device__ __forceinline__ void p0_prologue(const Frame& F, const Args& a, int parts) {
    LAS float* scr = (LAS float*)(F.lds + F.wave * 16384);
    const int gw = F.vcu * NWAVES + F.wave, NGW = F.G * NWAVES;
    bf16* WinT = (bf16*)(a.ws + WS_WIN); bf16* WoutT = (bf16*)(a.ws + WS_WOUT);
    constexpr int I_IN = 16 * (NPA / 32), I_OUT = 16 * 32;
    constexpr int NITEMS = DEPTH * (I_IN + I_OUT);
    if (parts & 1)
    for (int it = gw; it < NITEMS; it += NGW) {
        const int l = it / (I_IN + I_OUT); int r = it % (I_IN + I_OUT);
        if (r < I_IN) transpose_item(a.w_in + (size_t)l * DM * IN_W, IN_W, true, WinT + (size_t)l * NPA * DM, scr, r / (NPA / 32), r % (NPA / 32), F.lane, a.norm_pre + l * DM);
        else { r -= I_IN; transpose_item(a.w_out + (size_t)l * DM * DM, DM, false, WoutT + (size_t)l * DM * DM, scr, r / 32, r % 32, F.lane); }
    }
    if (!(parts & 2)) return;
    float* cosT = (float*)(a.ws + WS_ROPE); float* sinT = cosT + SEQ * 32;
    for (int e = gw * 64 + F.lane; e < SEQ * 32; e += NGW * 64) { const int pos = e >> 5, i = e & 31;
        const float inv = __builtin_amdgcn_exp2f(-(float)i * (13.287712379549449f / 32.f));
        const float ang = (float)pos * inv; float rev = ang * 0.15915494309189535f; rev = rev - floorf(rev);
        cosT[e] = __builtin_amdgcn_cosf(rev); sinT[e] = __builtin_amdgcn_sinf(rev); }
    float* LB = (float*)(a.ws + WS_LB);
    for (int e = gw * 64 + F.lane; e < 256; e += NGW * 64) { float lg[DEPTH], mx = -1e30f;
#pragma unroll
        for (int l = 0; l < DEPTH; ++l) { lg[l] = a.lb_logits[l * 256 + e]; mx = fmaxf(mx, lg[l]); }
        float sum = 0.f;
#pragma unroll
        for (int l = 0; l < DEPTH; ++l) { lg[l] = expf(lg[l] - mx); sum += lg[l]; }
        float cum = 0.f; LB[e] = 0.f;
#pragma unroll
        for (int l = 1; l < DEPTH; ++l) { cum += lg[l] / sum; LB[l * 256 + e] = cum; } }
    bf16* H = (bf16*)(a.ws + WS_XB); float* RS = (float*)(a.ws + WS_RSTD);
    for (int m0 = 4 * gw; m0 < M; m0 += 4 * NGW) { f32x4 v[4][4];
#pragma unroll
        for (int t = 0; t < 4; ++t) { const GAS f32x4* xr = (const GAS f32x4*)(a.x + (size_t)(m0 + t) * DM) + F.lane;
#pragma unroll
            for (int j = 0; j < 4; ++j) v[t][j] = xr[64 * j]; }
#pragma unroll
        for (int t = 0; t < 4; ++t) row_to_bf16_rstd(v[t], H + (size_t)(m0 + t) * DM, RS + m0 + t, F.lane); }
}

__device__ __forceinline__ void lowrank_phase(const Frame& F, const Args& a, int layer) {
    typedef float f32x4v __attribute__((ext_vector_type(4)));
    const bf16* H = (const bf16*)(a.ws + WS_XB); const bf16* Wa = (const bf16*)(a.ws + WS_WIN) + ((size_t)layer * NPA + NP) * DM; float* A = (float*)(a.ws + WS_A); const float* RS = (const float*)(a.ws + WS_RSTD);
    const int gw = F.vcu * NWAVES + F.wave, NGW = F.G * NWAVES, lane = F.lane;
    for (int u = gw; u < M / 16; u += NGW) {
        const bf16* ap = H + (size_t)(u * 16 + (lane & 15)) * DM + 8 * (lane >> 4);
        const bf16* b0 = Wa + (size_t)(lane & 15) * DM + 8 * (lane >> 4); const bf16* b1 = b0 + 16 * DM;
        f32x4v c0 = {0.f, 0.f, 0.f, 0.f}, c1 = {0.f, 0.f, 0.f, 0.f};
#pragma unroll 16
        for (int ks = 0; ks < 32; ++ks) { const bf16x8 av = *(const GAS bf16x8*)(ap + ks * 32), bv0 = *(const GAS bf16x8*)(b0 + ks * 32), bv1 = *(const GAS bf16x8*)(b1 + ks * 32);
            c0 = __builtin_amdgcn_mfma_f32_16x16x32_bf16(av, bv0, c0, 0, 0, 0); c1 = __builtin_amdgcn_mfma_f32_16x16x32_bf16(av, bv1, c1, 0, 0, 0); }
#pragma unroll
        for (int r = 0; r < 4; ++r) { const int row = u * 16 + 4 * (lane >> 4) + r; const float rs = *(const GAS float*)(RS + row); GAS float* o = (GAS float*)(A + (size_t)row * 32 + (lane & 15)); o[0] = c0[r] * rs; o[16] = c1[r] * rs; }
    }
}

__device__ __forceinline__ void postnorm_rows(const Frame& F, const Args& a, int layer, int gw, int NGW, int row_base, int nrows, bool dry = false) {
    const bf16* Y = (const bf16*)(a.ws + WS_Y); float* RS = (float*)(a.ws + (dry ? WS_PROJ + 128 * MiB : WS_RSTD)); const bf16* XBr = (const bf16*)(a.ws + WS_XB); bf16* XB = (bf16*)(a.ws + (dry ? WS_MIX : WS_XB));
    float* outp = dry ? (float*)(a.ws + WS_PROJ + 128 * MiB) : a.out;
    const float* wpost = a.norm_post + layer * DM;
    const int lane = F.lane;
    const bool first = layer == 0, last = layer + 1 == DEPTH;
    f32x4 wp[4];
#pragma unroll
    for (int j = 0; j < 4; ++j) { const int c = (j >> 1) * 512 + 8 * lane + 4 * (j & 1); wp[j] = *(const GAS f32x4*)(wpost + c); }
    constexpr int RPW = 4;
    for (int m0 = row_base + RPW * gw; m0 < row_base + nrows; m0 += RPW * NGW) {
        v4u yr[RPW][2]; f32x4 x[RPW][4];
#pragma unroll
        for (int t = 0; t < RPW; ++t) { const size_t m = (size_t)m0 + t;
#pragma unroll
            for (int hf = 0; hf < 2; ++hf) yr[t][hf] = *(const GAS v4u*)(Y + m * DM + hf * 512 + 8 * lane);
            if (first) {
#pragma unroll
                for (int j = 0; j < 4; ++j) x[t][j] = *(const GAS f32x4*)(a.x + m * DM + (j >> 1) * 512 + 8 * lane + 4 * (j & 1));
            } else {
#pragma unroll
                for (int hf = 0; hf < 2; ++hf) { const v4u xr = *(const GAS v4u*)(XBr + m * DM + hf * 512 + 8 * lane);
                    x[t][2 * hf] = (f32x4){__uint_as_float(xr.x << 16), __uint_as_float(xr.x & 0xffff0000u), __uint_as_float(xr.y << 16), __uint_as_float(xr.y & 0xffff0000u)};
                    x[t][2 * hf + 1] = (f32x4){__uint_as_float(xr.z << 16), __uint_as_float(xr.z & 0xffff0000u), __uint_as_float(xr.w << 16), __uint_as_float(xr.w & 0xffff0000u)}; }
            } }
#pragma unroll
        for (int t = 0; t < RPW; ++t) { const size_t m = (size_t)m0 + t;
            f32x4 y[4]; float s = 0.f;
#pragma unroll
            for (int j = 0; j < 4; ++j) { const unsigned w0 = yr[t][j >> 1][2 * (j & 1)], w1 = yr[t][j >> 1][2 * (j & 1) + 1];
                y[j] = (f32x4){__uint_as_float(w0 << 16), __uint_as_float(w0 & 0xffff0000u), __uint_as_float(w1 << 16), __uint_as_float(w1 & 0xffff0000u)};
                s += (y[j].x * y[j].x + y[j].y * y[j].y) + (y[j].z * y[j].z + y[j].w * y[j].w); }
            const float r = 1.f / sqrtf(wave_sum(s) * (1.f / DM) + EPS);
            float s2 = 0.f;
#pragma unroll
            for (int j = 0; j < 4; ++j) { x[t][j] = x[t][j] + y[j] * r * wp[j];
                if (last) *(GAS f32x4*)(outp + m * DM + (j >> 1) * 512 + 8 * lane + 4 * (j & 1)) = x[t][j];
                s2 += (x[t][j].x * x[t][j].x + x[t][j].y * x[t][j].y) + (x[t][j].z * x[t][j].z + x[t][j].w * x[t][j].w); }
            if (!last) { const float r2 = 1.f / sqrtf(wave_sum(s2) * (1.f / DM) + EPS);
#pragma unroll
                for (int hf = 0; hf < 2; ++hf) { const f32x4 b0 = x[t][2 * hf], b1 = x[t][2 * hf + 1];
                    v4u ox; ox.x = pk2(b0.x, b0.y); ox.y = pk2(b0.z, b0.w); ox.z = pk2(b1.x, b1.y); ox.w = pk2(b1.z, b1.w);
                    *(GAS v4u*)(XB + m * DM + hf * 512 + 8 * lane) = ox; }
                if (lane == 0) *(GAS float*)(RS + m) = r2; }
        }
    }
}
__device__ __forceinline__ void postnorm_phase(const Frame& F, const Args& a, int layer, bool dry = false) { postnorm_rows(F, a, layer, F.vcu * NWAVES + F.wave, F.G * NWAVES, 0, M, dry); }
#define XB_TMO      128
#define XB_XCNT(j)  (256  + 64 * (j))
#define XB_XSUB(j)  (1280 + 64 * (j))
#define XB_XGEN(j)  (2304 + 64 * (j))
#define XB_TOP      3328
#define XB_TOPGEN   3392
#define XCD_BAR_WORDS 3456
#define XB_SPIN_CAP (1u << 18)

__device__ __forceinline__ unsigned xb_ld(unsigned* p)              { return __hip_atomic_load(p, __ATOMIC_RELAXED, __HIP_MEMORY_SCOPE_AGENT); }
__device__ __forceinline__ unsigned xb_add(unsigned* p, unsigned v) { return __hip_atomic_fetch_add(p, v, __ATOMIC_RELAXED, __HIP_MEMORY_SCOPE_AGENT); }
__device__ __forceinline__ unsigned xb_xcc_id() { return (unsigned)__builtin_amdgcn_s_getreg((3 << 11) | 20) & 0xFu; }
#define XB_SPIN(cond, bar) do { unsigned _sp = 0; while (cond) { __builtin_amdgcn_s_sleep(1); \
    if ((++_sp & 255u) == 0u) { if (xb_ld(&(bar)[XB_TMO])) break; if (_sp > XB_SPIN_CAP) { atomicAdd(&(bar)[XB_TMO], 1u); break; } } } } while (0)

struct XcdBarrier {
    unsigned* bar; unsigned x;
    volatile LAS unsigned* st;
};

__device__ __forceinline__ XcdBarrier xcd_barrier_post(unsigned* bar, volatile LAS unsigned* st) {
    XcdBarrier b; b.bar = bar; b.x = xb_xcc_id(); b.st = st;
    if (threadIdx.x == 0) (void)xb_add(&bar[XB_XCNT(b.x)], 1u);
    return b;
}
__device__ __forceinline__ void xcd_barrier_complete(unsigned* bar, unsigned x, unsigned& nloc, unsigned& nx) {
    const unsigned G = gridDim.x * gridDim.y * gridDim.z;
    unsigned sum, cnt, mine, sp = 0u;
    for (;;) {
        sum = 0u; cnt = 0u; mine = 0u;
#pragma unroll
        for (unsigned j = 0; j < 16; ++j) { const unsigned c = xb_ld(&bar[XB_XCNT(j)]); sum += c; cnt += (c > 0u) ? 1u : 0u; mine = (j == x) ? c : mine; }
        if (sum == G) break;
        __builtin_amdgcn_s_sleep(1);
        if ((++sp & 255u) == 0u) { if (xb_ld(&bar[XB_TMO])) break; if (sp > XB_SPIN_CAP) { atomicAdd(&bar[XB_TMO], 1u); break; } }
    }
    nloc = mine > 0u ? mine : 1u; nx = cnt > 0u ? cnt : 1u;
}

__device__ __forceinline__ void xcd_barrier(const XcdBarrier& b) {
    asm volatile("s_waitcnt vmcnt(0)" ::: "memory");
    __syncthreads();
    if (threadIdx.x == 0) {
        unsigned* bar = b.bar;
        __builtin_amdgcn_s_waitcnt(0);
        unsigned nloc = b.st[0], nx = b.st[1];
        if (nloc == 0u) { xcd_barrier_complete(bar, b.x, nloc, nx); b.st[0] = nloc; b.st[1] = nx; }
        const unsigned old = xb_add(&bar[XB_XSUB(b.x)], 1u);
        const unsigned gen = old / nloc;
        if (old + 1u == (gen + 1u) * nloc) {
            __builtin_amdgcn_fence(__ATOMIC_RELEASE, "agent");
            asm volatile("s_waitcnt vmcnt(0)" ::: "memory");
            const unsigned og = xb_add(&bar[XB_TOP], 1u);
            const unsigned tg = og / nx;
            if (og + 1u == (tg + 1u) * nx) xb_add(&bar[XB_TOPGEN], 1u);
            else XB_SPIN(xb_ld(&bar[XB_TOPGEN]) == tg, bar);
            __builtin_amdgcn_fence(__ATOMIC_ACQUIRE, "agent");
            xb_add(&bar[XB_XGEN(b.x)], 1u);
            asm volatile("s_waitcnt vmcnt(0)" ::: "memory");
        } else {
            XB_SPIN(xb_ld(&bar[XB_XGEN(b.x)]) == gen, bar);
            __builtin_amdgcn_fence(__ATOMIC_ACQUIRE, "agent");
            asm volatile("s_waitcnt vmcnt(0)" ::: "memory");
        }
    }
    __syncthreads();
}
namespace scan {
typedef float f32x16 __attribute__((ext_vector_type(16)));
typedef float f32x4s __attribute__((ext_vector_type(4)));
typedef short bf16x8s __attribute__((ext_vector_type(8)));
typedef short s16x4s __attribute__((ext_vector_type(4)));
typedef unsigned u32x4s __attribute__((ext_vector_type(4)));
typedef unsigned u32x2s __attribute__((ext_vector_type(2)));
constexpr int CH = 32, SEGT = 256, NCH = SEGT / CH;
constexpr int WAVE_LDS = 15360;
constexpr int PT = 72, PTB = PT * 2;
constexpr size_t OSC_UNIT = (size_t)64 * 16 * 64 * 4;
__device__ __forceinline__ int crow(int r, int hi) { return (r & 3) + 8 * (r >> 2) + 4 * hi; }
__device__ __forceinline__ unsigned cvtpk(float lo, float hi) { unsigned r; asm volatile("v_cvt_pk_bf16_f32 %0, %1, %2" : "=v"(r) : "v"(lo), "v"(hi)); return r; }
__device__ __forceinline__ float other_half(float x, int hh) { auto rr = __builtin_amdgcn_permlane32_swap(__float_as_uint(x), __float_as_uint(x), false, false); return __uint_as_float(hh ? rr[0] : rr[1]); }
typedef short v4i16_t __attribute__((ext_vector_type(4)));
__device__ __forceinline__ s16x4s trd(LAS const unsigned char* p) { return __builtin_bit_cast(s16x4s, __builtin_amdgcn_ds_read_tr16_b64_v4i16((LAS v4i16_t*)p)); }
#define SC_STEP(N) "v_add_f32_dpp %0, %0, %0 row_shr:" #N " row_mask:0xa bank_mask:0xf bound_ctrl:1\n\tv_add_f32_dpp %1, %1, %1 row_shr:" #N " row_mask:0xa bank_mask:0xf bound_ctrl:1\n\t" \
                   "v_add_f32_dpp %2, %2, %2 row_shr:" #N " row_mask:0xa bank_mask:0xf bound_ctrl:1\n\tv_add_f32_dpp %3, %3, %3 row_shr:" #N " row_mask:0xa bank_mask:0xf bound_ctrl:1\n\t" \
                   "v_add_f32_dpp %0, %0, %0 row_shl:" #N " row_mask:0x5 bank_mask:0xf bound_ctrl:1\n\tv_add_f32_dpp %1, %1, %1 row_shl:" #N " row_mask:0x5 bank_mask:0xf bound_ctrl:1\n\t" \
                   "v_add_f32_dpp %2, %2, %2 row_shl:" #N " row_mask:0x5 bank_mask:0xf bound_ctrl:1\n\tv_add_f32_dpp %3, %3, %3 row_shl:" #N " row_mask:0x5 bank_mask:0xf bound_ctrl:1\n\t"
__device__ __forceinline__ void rowscan4(float& a, float& b, float& c, float& d) {
    asm volatile("s_nop 1\n\t" SC_STEP(1) SC_STEP(2) SC_STEP(4) SC_STEP(8) "s_nop 1" : "+v"(a), "+v"(b), "+v"(c), "+v"(d));
}
#undef SC_STEP
__device__ __forceinline__ void tri_frags(bf16x8s (&T)[2], int r, int hh) {
    const bool row1 = (r & 16) != 0;
#pragma unroll
    for (int ss = 0; ss < 2; ++ss) { u32x4s t;
#pragma unroll
        for (int jj = 0; jj < 4; ++jj) { const int k0 = 16 * ss + 4 * hh + ((2 * jj) & 3) + 8 * ((2 * jj) >> 2), k1 = k0 + 1;
            const bool i0 = row1 ? (k0 >= 16 && k0 <= r) : (k0 >= r && k0 <= 15), i1 = row1 ? (k1 >= 16 && k1 <= r) : (k1 >= r && k1 <= 15);
            t[jj] = (i0 ? 0x3F80u : 0u) | (i1 ? 0x3F800000u : 0u); }
        T[ss] = __builtin_bit_cast(bf16x8s, t); }
}
__device__ __forceinline__ f32x16 tri_cumsum(LAS const unsigned char* TK, int tb, int kb, const bf16x8s (&T)[2]) {
    f32x16 sc = {};
#pragma unroll
    for (int ss = 0; ss < 2; ++ss) { const s16x4s lo = trd(TK + tb + (16 * ss) * PTB + 64 * kb), hi = trd(TK + tb + (16 * ss + 8) * PTB + 64 * kb);
        sc = __builtin_amdgcn_mfma_f32_32x32x16_bf16((bf16x8s){lo[0], lo[1], lo[2], lo[3], hi[0], hi[1], hi[2], hi[3]}, T[ss], sc, 0, 0, 0); }
    return sc;
}

template <int DK, bool HG> struct Ctx {
    const bf16* P; const float* A; int lane; LAS unsigned char* lw;
    int qcol, kcol, vcol, dir;
    bf16x8s wbf; float bav[16];
};
template <int DK> struct Raw { v4u g[DK / 16]; f32x4s a0, a1; };

template <int DK, bool HG, bool FULL, int VAR = 0>
__device__ __forceinline__ void load_raw(const Ctx<DK, HG>& c, size_t row0, Raw<DK>& w, int lane) {
    if (VAR & 8) return;
    const int r = lane & 31, hh = lane >> 5; const bf16* Pr = c.P + row0 * NP;
#pragma unroll
    for (int i = 0; i < DK / 16; ++i) { const int p = lane + 64 * i; w.g[i] = *(const GAS v4u*)(Pr + c.kcol + (unsigned)((p / (DK / 8)) * NP + (p % (DK / 8)) * 8)); }
    if (!HG) { const float* Ar = c.A + row0 * 32; w.a0 = *(const GAS f32x4s*)(Ar + (unsigned)(r * 32 + c.dir * 16 + 8 * hh)); w.a1 = *(const GAS f32x4s*)(Ar + (unsigned)(r * 32 + c.dir * 16 + 8 * hh + 4)); }
}

template <int DK, bool HG, int DIR, bool FULL, int VAR>
__device__ __forceinline__ void chunk_step(const Ctx<DK, HG>& c, size_t row_cur, size_t row_next, Raw<DK>& w, f32x16 (&S)[DK / 32][2], f32x16 (&O)[2]) {
    constexpr int NKB = DK / 32, NKS = DK / 16;
    const int lane_ = lane_id_opaque();
    const int lane = lane_, r = lane & 31, hh = lane >> 5;
    LAS unsigned char* TK = c.lw; LAS unsigned char* TV = c.lw + 32 * PTB; LAS float* VEC = (LAS float*)(c.lw + 64 * PTB);
#pragma unroll
    for (int i = 0; i < NKS; ++i) { const int p = lane + 64 * i; *(LAS v4u*)(TK + (p / (DK / 8)) * PTB + (p % (DK / 8)) * 16) = w.g[i]; }
    v4u vraw[4]; v4u qraw[NKS]; LAS unsigned char* TQ = c.lw + 64 * PTB + 1536;
    { const bf16* Pv = c.P + row_cur * NP;
        if (FULL) {
#pragma unroll
            for (int i = 0; i < NKS; ++i) { const int p = lane + 64 * i; qraw[i] = *(const GAS v4u*)(Pv + c.qcol + (unsigned)((p / (DK / 8)) * NP + (p % (DK / 8)) * 8)); } }
#pragma unroll
        for (int i = 0; i < 4; ++i) { const int p = lane + 64 * i; vraw[i] = *(const GAS v4u*)(Pv + (unsigned)((p >> 3) * NP + c.vcol + (p & 7) * 8)); } }
    f32x16 zg = {};
    if (!HG) { u32x4s t; t[0] = cvtpk(w.a0[0], w.a0[1]); t[1] = cvtpk(w.a0[2], w.a0[3]); t[2] = cvtpk(w.a1[0], w.a1[1]); t[3] = cvtpk(w.a1[2], w.a1[3]);
        zg = __builtin_amdgcn_mfma_f32_32x32x16_bf16(c.wbf, __builtin_bit_cast(bf16x8s, t), zg, 0, 0, 0); }
    bf16x8s QR[NKS], KR[NKS]; float eqv[FULL ? NKS : 1][8];
    const bool row1 = (r & 16) != 0;
    const int tb = (4 * hh + ((r & 15) >> 2)) * PTB + (16 * ((r >> 4) & 1) + 4 * (r & 3)) * 2;
    bf16x8s TRI[2]; f32x16 SCm[HG ? NKB : 1]; if (HG) tri_frags(TRI, r, hh);
    u32x2s G0a[NKS], G1a[NKS];
#pragma unroll
    for (int ks = 0; ks < NKS; ++ks) { G0a[ks] = *(const LAS u32x2s*)(TK + r * PTB + (16 * ks + 4 * hh) * 2); G1a[ks] = *(const LAS u32x2s*)(TK + r * PTB + (16 * ks + 8 + 4 * hh) * 2); }
#pragma unroll
    for (int ks = 0; ks < NKS; ++ks) {
        float x[8], kk[8], sc[8];
        if (HG && (ks & 1) == 0) SCm[HG ? (ks >> 1) : 0] = tri_cumsum(TK, tb, ks >> 1, TRI);
        const u32x2s g0_ = G0a[ks], g1_ = G1a[ks];
#pragma unroll
        for (int j = 0; j < 8; ++j) { const unsigned rawg = (j >> 2) ? g1_[(j >> 1) & 1] : g0_[(j >> 1) & 1]; const float gv = __uint_as_float((j & 1) ? (rawg & 0xffff0000u) : (rawg << 16));
            if (HG) { x[j] = gv; kk[j] = 1.f - __builtin_amdgcn_exp2f(gv); }
            else { const float z = zg[8 * ks + j] + c.bav[8 * ks + j]; x[j] = (fminf(z, 0.f) - __logf(1.f + __expf(-fabsf(z)))) * (1.4426950408889634f / 16.f); kk[j] = gv; }
            sc[j] = HG ? SCm[HG ? (ks >> 1) : 0][8 * (ks & 1) + j] : x[j]; }
        if (!HG && !(VAR & 1)) { rowscan4(sc[0], sc[1], sc[2], sc[3]); rowscan4(sc[4], sc[5], sc[6], sc[7]); }
        if (r == 0) { *(LAS f32x4s*)(VEC + 16 * ks + 4 * hh) = (f32x4s){sc[0], sc[1], sc[2], sc[3]}; *(LAS f32x4s*)(VEC + 16 * ks + 8 + 4 * hh) = (f32x4s){sc[4], sc[5], sc[6], sc[7]}; }
        if (r == 31) { *(LAS f32x4s*)(VEC + 64 + 16 * ks + 4 * hh) = (f32x4s){sc[0], sc[1], sc[2], sc[3]}; *(LAS f32x4s*)(VEC + 64 + 16 * ks + 8 + 4 * hh) = (f32x4s){sc[4], sc[5], sc[6], sc[7]}; }
        float kt[8];
#pragma unroll
        for (int j = 0; j < 8; ++j) { const float d = x[j] - sc[j]; const float e = (DIR == 0) ? (row1 ? sc[j] : d) : (row1 ? d : sc[j]);
            const float eq = __builtin_amdgcn_exp2f(__builtin_amdgcn_fmed3f(e, -115.f, 115.f)), ek = __builtin_amdgcn_rcpf(eq); kt[j] = kk[j] * ek; if (FULL) eqv[ks][j] = eq; }
        u32x4s tk; tk[0] = cvtpk(kt[0], kt[1]); tk[1] = cvtpk(kt[2], kt[3]); tk[2] = cvtpk(kt[4], kt[5]); tk[3] = cvtpk(kt[6], kt[7]); KR[ks] = __builtin_bit_cast(bf16x8s, tk);
        *(LAS u32x2s*)(TK + r * PTB + (16 * ks + 4 * hh) * 2) = (u32x2s){tk[0], tk[1]}; *(LAS u32x2s*)(TK + r * PTB + (16 * ks + 8 + 4 * hh) * 2) = (u32x2s){tk[2], tk[3]};
    }
    if (!FULL) load_raw<DK, HG, FULL, VAR>(c, row_next, w, lane);
#pragma unroll
    for (int i = 0; i < 4; ++i) { const int p = lane + 64 * i; *(LAS v4u*)(TV + (p >> 3) * PTB + (p & 7) * 16) = vraw[i]; }
    if (FULL) {
#pragma unroll
        for (int i = 0; i < NKS; ++i) { const int p = lane + 64 * i; *(LAS v4u*)(TQ + (p / (DK / 8)) * PTB + (p % (DK / 8)) * 16) = qraw[i]; } }
    LDS_WAIT(); asm volatile("" ::: "memory");
    if (FULL) {
#pragma unroll
        for (int ks = 0; ks < NKS; ++ks) { const u32x2s q0_ = *(const LAS u32x2s*)(TQ + r * PTB + (16 * ks + 4 * hh) * 2), q1_ = *(const LAS u32x2s*)(TQ + r * PTB + (16 * ks + 8 + 4 * hh) * 2); float qt[8];
#pragma unroll
            for (int j = 0; j < 8; ++j) { const unsigned rawq = (j >> 2) ? q1_[(j >> 1) & 1] : q0_[(j >> 1) & 1]; float qv = __uint_as_float((j & 1) ? (rawq & 0xffff0000u) : (rawq << 16)); if (!HG) qv *= 0.17677669529663687f; qt[j] = qv * eqv[ks][j]; }
            u32x4s tq; tq[0] = cvtpk(qt[0], qt[1]); tq[1] = cvtpk(qt[2], qt[3]); tq[2] = cvtpk(qt[4], qt[5]); tq[3] = cvtpk(qt[6], qt[7]); QR[ks] = __builtin_bit_cast(bf16x8s, tq); } }
    { const float t0 = VEC[lane], t1 = VEC[64 + lane]; VEC[128 + lane] += t0 + t1;
      const float er_ = __builtin_amdgcn_exp2f(fmaxf(DIR == 0 ? t0 : t1, -115.f)), eu_ = __builtin_amdgcn_exp2f(fmaxf(DIR == 0 ? t1 : t0, -115.f));
      VEC[192 + lane] = er_; VEC[256 + lane] = eu_; VEC[320 + lane] = er_ * eu_; }
    LDS_WAIT(); asm volatile("" ::: "memory");
    bf16x8s Vf[2][2];
#pragma unroll
    for (int vb = 0; vb < 2; ++vb)
#pragma unroll
        for (int ss = 0; ss < 2; ++ss) { const s16x4s lo = trd(TV + tb + (16 * ss) * PTB + 64 * vb), hi = trd(TV + tb + (16 * ss + 8) * PTB + 64 * vb);
            Vf[vb][ss] = (bf16x8s){lo[0], lo[1], lo[2], lo[3], hi[0], hi[1], hi[2], hi[3]}; }
    if (FULL) {
        f32x16 Pm = {};
#pragma unroll
        for (int ks = 0; ks < NKS; ++ks) Pm = __builtin_amdgcn_mfma_f32_32x32x16_bf16(KR[ks], QR[ks], Pm, 0, 0, 0);
        bf16x8s Pf[2];
#pragma unroll
        for (int ss = 0; ss < 2; ++ss) { u32x4s t;
#pragma unroll
            for (int jj = 0; jj < 4; ++jj) { const int g0 = 8 * ss + 2 * jj; const int s0 = crow(g0, hh), s1 = crow(g0 + 1, hh);
                const float p0 = (DIR == 0 ? (s0 <= r) : (s0 >= r)) ? Pm[g0] : 0.f, p1 = (DIR == 0 ? (s1 <= r) : (s1 >= r)) ? Pm[g0 + 1] : 0.f;
                t[jj] = cvtpk(p0, p1); }
            Pf[ss] = __builtin_bit_cast(bf16x8s, t); }
#pragma unroll
        for (int vb = 0; vb < 2; ++vb)
#pragma unroll
            for (int ss = 0; ss < 2; ++ss) O[vb] = __builtin_amdgcn_mfma_f32_32x32x16_bf16(Vf[vb][ss], Pf[ss], ss == 0 ? f32x16{} : O[vb], 0, 0, 0);
        __builtin_amdgcn_sched_barrier(0);
        load_raw<DK, HG, FULL, VAR>(c, row_next, w, lane);
#pragma unroll
        for (int kb = 0; kb < NKB; ++kb) {
            f32x4s er[4];
#pragma unroll
            for (int g = 0; g < 4; ++g) er[g] = *(const LAS f32x4s*)(VEC + 192 + 32 * kb + 8 * g + 4 * hh);
#pragma unroll
            for (int vb = 0; vb < 2; ++vb)
#pragma unroll
                for (int ss = 0; ss < 2; ++ss) { u32x4s t;
#pragma unroll
                    for (int jj = 0; jj < 4; ++jj) { const int g0 = 8 * ss + 2 * jj; t[jj] = cvtpk(S[kb][vb][g0] * er[g0 >> 2][g0 & 3], S[kb][vb][g0 + 1] * er[(g0 + 1) >> 2][(g0 + 1) & 3]); }
                    O[vb] = __builtin_amdgcn_mfma_f32_32x32x16_bf16(__builtin_bit_cast(bf16x8s, t), QR[2 * kb + ss], O[vb], 0, 0, 0); }
        }
    }
#pragma unroll
    for (int kb = 0; kb < NKB; ++kb) {
        bf16x8s KT[2];
#pragma unroll
        for (int ss = 0; ss < 2; ++ss) { const s16x4s lo = trd(TK + tb + (16 * ss) * PTB + 64 * kb), hi = trd(TK + tb + (16 * ss + 8) * PTB + 64 * kb);
            KT[ss] = (bf16x8s){lo[0], lo[1], lo[2], lo[3], hi[0], hi[1], hi[2], hi[3]}; }
        f32x4s gs[4], gu[4];
#pragma unroll
        for (int g = 0; g < 4; ++g) { gs[g] = *(const LAS f32x4s*)(VEC + 320 + 32 * kb + 8 * g + 4 * hh); gu[g] = *(const LAS f32x4s*)(VEC + 256 + 32 * kb + 8 * g + 4 * hh); }
#pragma unroll
        for (int vb = 0; vb < 2; ++vb) { f32x16 U = {};
#pragma unroll
            for (int ss = 0; ss < 2; ++ss) U = __builtin_amdgcn_mfma_f32_32x32x16_bf16(KT[ss], Vf[vb][ss], U, 0, 0, 0);
#pragma unroll
            for (int g = 0; g < 16; ++g) S[kb][vb][g] = S[kb][vb][g] * gs[g >> 2][g & 3] + U[g] * gu[g >> 2][g & 3]; }
    }
    LDS_WAIT(); asm volatile("" ::: "memory");
}

template <int DK, bool HG, int DIR, int VAR>
__device__ __forceinline__ void l1_step(const Ctx<DK, HG>& c, size_t row_cur, size_t row_next, Raw<DK>& w, f32x16 (&S)[DK / 32][2], float (&carry)[DK / 16][8]) {
    constexpr int NKB = DK / 32, NKS = DK / 16;
    const int lane_ = lane_id_opaque();
    const int lane = lane_, r = lane & 31, hh = lane >> 5;
    LAS unsigned char* TK = c.lw; LAS unsigned char* TV = c.lw + 32 * PTB; LAS float* VEC = (LAS float*)(c.lw + 64 * PTB);
    v4u vraw[4];
    { const bf16* Pv = c.P + row_cur * NP;
#pragma unroll
        for (int i = 0; i < 4; ++i) { const int p = lane + 64 * i; vraw[i] = *(const GAS v4u*)(Pv + (unsigned)((p >> 3) * NP + c.vcol + (p & 7) * 8)); } }
#pragma unroll
    for (int i = 0; i < NKS; ++i) { const int p = lane + 64 * i; *(LAS v4u*)(TK + (p / (DK / 8)) * PTB + (p % (DK / 8)) * 16) = w.g[i]; }
    f32x16 zg = {};
    if (!HG) { u32x4s t; t[0] = cvtpk(w.a0[0], w.a0[1]); t[1] = cvtpk(w.a0[2], w.a0[3]); t[2] = cvtpk(w.a1[0], w.a1[1]); t[3] = cvtpk(w.a1[2], w.a1[3]);
        zg = __builtin_amdgcn_mfma_f32_32x32x16_bf16(c.wbf, __builtin_bit_cast(bf16x8s, t), zg, 0, 0, 0); }
    const bool row1 = (r & 16) != 0;
    const int tb = (4 * hh + ((r & 15) >> 2)) * PTB + (16 * ((r >> 4) & 1) + 4 * (r & 3)) * 2;
    float x[NKS][8], kk[NKS][8], sc[NKS][8];
    if (HG) { bf16x8s TRI[2]; tri_frags(TRI, r, hh);
#pragma unroll
        for (int kb = 0; kb < NKB; ++kb) { const f32x16 t = tri_cumsum(TK, tb, kb, TRI);
#pragma unroll
            for (int g = 0; g < 16; ++g) sc[2 * kb + (g >> 3)][g & 7] = t[g]; } }
#pragma unroll
    for (int ks = 0; ks < NKS; ++ks) {
        const u32x2s g0_ = *(const LAS u32x2s*)(TK + r * PTB + (16 * ks + 4 * hh) * 2), g1_ = *(const LAS u32x2s*)(TK + r * PTB + (16 * ks + 8 + 4 * hh) * 2);
#pragma unroll
        for (int j = 0; j < 8; ++j) { const unsigned rawg = (j >> 2) ? g1_[(j >> 1) & 1] : g0_[(j >> 1) & 1]; const float gv = __uint_as_float((j & 1) ? (rawg & 0xffff0000u) : (rawg << 16));
            if (HG) { x[ks][j] = gv; kk[ks][j] = 1.f - __builtin_amdgcn_exp2f(gv); }
            else { const float z = zg[8 * ks + j] + c.bav[8 * ks + j]; x[ks][j] = (fminf(z, 0.f) - __logf(1.f + __expf(-fabsf(z)))) * (1.4426950408889634f / 16.f); kk[ks][j] = gv; }
            if (!HG) sc[ks][j] = x[ks][j]; }
        if (!HG && !(VAR & 1)) { rowscan4(sc[ks][0], sc[ks][1], sc[ks][2], sc[ks][3]); rowscan4(sc[ks][4], sc[ks][5], sc[ks][6], sc[ks][7]); }
        if (r == 0) { *(LAS f32x4s*)(VEC + 16 * ks + 4 * hh) = (f32x4s){sc[ks][0], sc[ks][1], sc[ks][2], sc[ks][3]}; *(LAS f32x4s*)(VEC + 16 * ks + 8 + 4 * hh) = (f32x4s){sc[ks][4], sc[ks][5], sc[ks][6], sc[ks][7]}; }
        if (r == 31) { *(LAS f32x4s*)(VEC + 64 + 16 * ks + 4 * hh) = (f32x4s){sc[ks][0], sc[ks][1], sc[ks][2], sc[ks][3]}; *(LAS f32x4s*)(VEC + 64 + 16 * ks + 8 + 4 * hh) = (f32x4s){sc[ks][4], sc[ks][5], sc[ks][6], sc[ks][7]}; }
    }
    load_raw<DK, HG, false, VAR>(c, row_next, w, lane);
#pragma unroll
    for (int i = 0; i < 4; ++i) { const int p = lane + 64 * i; *(LAS v4u*)(TV + (p >> 3) * PTB + (p & 7) * 16) = vraw[i]; }
    LDS_WAIT(); asm volatile("" ::: "memory");
#pragma unroll
    for (int ks = 0; ks < NKS; ++ks) { float kt[8];
#pragma unroll
        for (int jh = 0; jh < 2; ++jh) { const f32x4s S0 = *(const LAS f32x4s*)(VEC + 16 * ks + 8 * jh + 4 * hh), P1 = *(const LAS f32x4s*)(VEC + 64 + 16 * ks + 8 * jh + 4 * hh);
#pragma unroll
            for (int q = 0; q < 4; ++q) { const int j = 4 * jh + q;
                const float in_chunk = (DIR == 0) ? (row1 ? (P1[q] - sc[ks][j]) : (sc[ks][j] - x[ks][j] + P1[q])) : (row1 ? (S0[q] + sc[ks][j] - x[ks][j]) : (S0[q] - sc[ks][j]));
                kt[j] = kk[ks][j] * __builtin_amdgcn_exp2f(carry[ks][j] + in_chunk); carry[ks][j] += S0[q] + P1[q]; } }
        u32x4s tk; tk[0] = cvtpk(kt[0], kt[1]); tk[1] = cvtpk(kt[2], kt[3]); tk[2] = cvtpk(kt[4], kt[5]); tk[3] = cvtpk(kt[6], kt[7]);
        *(LAS u32x2s*)(TK + r * PTB + (16 * ks + 4 * hh) * 2) = (u32x2s){tk[0], tk[1]}; *(LAS u32x2s*)(TK + r * PTB + (16 * ks + 8 + 4 * hh) * 2) = (u32x2s){tk[2], tk[3]};
    }
    bf16x8s Vf[2][2];
#pragma unroll
    for (int vb = 0; vb < 2; ++vb)
#pragma unroll
        for (int ss = 0; ss < 2; ++ss) { const s16x4s lo = trd(TV + tb + (16 * ss) * PTB + 64 * vb), hi = trd(TV + tb + (16 * ss + 8) * PTB + 64 * vb);
            Vf[vb][ss] = (bf16x8s){lo[0], lo[1], lo[2], lo[3], hi[0], hi[1], hi[2], hi[3]}; }
#pragma unroll
    for (int kb = 0; kb < NKB; ++kb) {
        bf16x8s KT[2];
#pragma unroll
        for (int ss = 0; ss < 2; ++ss) { const s16x4s lo = trd(TK + tb + (16 * ss) * PTB + 64 * kb), hi = trd(TK + tb + (16 * ss + 8) * PTB + 64 * kb);
            KT[ss] = (bf16x8s){lo[0], lo[1], lo[2], lo[3], hi[0], hi[1], hi[2], hi[3]}; }
#pragma unroll
        for (int vb = 0; vb < 2; ++vb)
#pragma unroll
            for (int ss = 0; ss < 2; ++ss) S[kb][vb] = __builtin_amdgcn_mfma_f32_32x32x16_bf16(KT[ss], Vf[vb][ss], S[kb][vb], 0, 0, 0);
    }
    LDS_WAIT(); asm volatile("" ::: "memory");
}

template <int DK, bool HG, int DIR, int VAR>
__device__ __forceinline__ void scan_unit(const Frame& F, const Args& a, int layer, int b, int h, int unit) {
    constexpr int NKB = DK / 32;
    const int lane0 = lane_id_opaque();
    Ctx<DK, HG> c; c.P = (const bf16*)(a.ws + WS_PROJ); c.A = (const float*)(a.ws + WS_A); c.lane = lane0; c.lw = F.lds + F.wave * WAVE_LDS; c.dir = DIR;
    c.qcol = HG ? PQ_HQ + h * 64 : PQ_GQ + h * 32; c.kcol = HG ? (DIR ? col_hzb(h) : col_hzf(h)) : PQ_GK + h * 32; c.vcol = HG ? col_hi(h) : PQ_GV + h * 64;
    const int r = lane0 & 31, hh = lane0 >> 5, w = F.wave, lane = lane0;
    { u32x4s t = {0u, 0u, 0u, 0u};
#pragma unroll
        for (int g = 0; g < 16; ++g) c.bav[g] = 0.f;
        if (!HG) { const float* w2 = (DIR ? a.gla_wa2_b : a.gla_wa2_f) + (size_t)layer * 16 * 128 + (size_t)(8 * hh) * 128 + h * 32 + r;
#pragma unroll
            for (int jj = 0; jj < 4; ++jj) t[jj] = cvtpk(w2[(2 * jj) * 128], w2[(2 * jj + 1) * 128]);
            const float* bp = (DIR ? a.gla_ba_b : a.gla_ba_f) + layer * 128 + h * 32 + 4 * hh;
#pragma unroll
            for (int g = 0; g < 4; ++g) { const f32x4s bv = *(const f32x4s*)(bp + 8 * g); c.bav[4 * g] = bv[0]; c.bav[4 * g + 1] = bv[1]; c.bav[4 * g + 2] = bv[2]; c.bav[4 * g + 3] = bv[3]; } }
        c.wbf = __builtin_bit_cast(bf16x8s, t); }
    GAS float* OSC = (GAS float*)(a.ws + (DIR ? WS_OSC1 : WS_OSC0) + (size_t)(unit >> 1) * OSC_UNIT);
    GAS float* XS = OSC; GAS float* XB = XS + 8 * 4 * 16 * 64;
    const size_t rowseg = (size_t)b * SEQ + w * SEGT;
    LAS float* VEC = (LAS float*)(c.lw + 64 * PTB);
    f32x16 S[NKB][2]; f32x16 O[2]; Raw<DK> raw;
#pragma unroll
    for (int kb = 0; kb < NKB; ++kb) { S[kb][0] = f32x16{}; S[kb][1] = f32x16{}; }
    { float carry[DK / 16][8];
#pragma unroll
        for (int ks = 0; ks < DK / 16; ++ks)
#pragma unroll
            for (int j = 0; j < 8; ++j) carry[ks][j] = 0.f;
        load_raw<DK, HG, false>(c, rowseg + (DIR ? 0 : NCH - 1) * CH, raw, lane_id_opaque());
#pragma unroll 1
        for (int ci = 0; ci < ((VAR & 32) ? 0 : NCH); ++ci) { const int cc = DIR ? ci : NCH - 1 - ci; const int cn = ci + 1 < NCH ? ci + 1 : ci; const int ccn = DIR ? cn : NCH - 1 - cn;
            l1_step<DK, HG, DIR, VAR>(c, rowseg + cc * CH, rowseg + ccn * CH, raw, S, carry); }
        LDS_WAIT(); __syncthreads();
        const int ln = lane_id_opaque();
        LAS float* xs = (LAS float*)F.lds + (w * 4) * 16 * 64;
#pragma unroll
        for (int kb = 0; kb < NKB; ++kb)
#pragma unroll
            for (int vb = 0; vb < 2; ++vb)
#pragma unroll
                for (int g = 0; g < 16; ++g) xs[((kb * 2 + vb) * 16 + g) * 64 + ln] = S[kb][vb][g];
        if ((ln & 31) == 0) {
            LAS float* XT = (LAS float*)(F.lds + 131072);
#pragma unroll
            for (int ks = 0; ks < DK / 16; ++ks)
#pragma unroll
                for (int jh = 0; jh < 2; ++jh) *(LAS f32x4s*)(XT + w * 64 + 16 * ks + 8 * jh + 4 * (ln >> 5)) = (f32x4s){carry[ks][4 * jh], carry[ks][4 * jh + 1], carry[ks][4 * jh + 2], carry[ks][4 * jh + 3]}; } }
    LDS_WAIT(); __syncthreads();
    load_raw<DK, HG, true>(c, rowseg + (DIR ? NCH - 1 : 0) * CH, raw, lane_id_opaque());
    { const int t_ = F.wave * 64 + lane_id_opaque();
        LAS float* XL = (LAS float*)F.lds; LAS float* XT = (LAS float*)(F.lds + 131072);
        constexpr int NVEC = NKB * 2 * 16 * 64 / 4;
        for (int v = t_; v < NVEC; v += NWAVES * 64) {
            const int f = 4 * v, blk = f >> 10, g = (f & 1023) >> 6, l4 = f & 63, k = 32 * (blk >> 1) + crow(g, l4 >> 5);
            f32x4s sl[8]; float bg[8];
#pragma unroll
            for (int ww = 0; ww < 8; ++ww) { sl[ww] = *(const LAS f32x4s*)(XL + (ww * 4) * 16 * 64 + f); bg[ww] = XT[ww * 64 + k]; }
            float z_ = 0.f; asm volatile("" : "+v"(z_)); f32x4s acc = {z_, z_, z_, z_};
#pragma unroll
            for (int i = 0; i < 8; ++i) { const int ww = DIR ? 7 - i : i; const f32x4s nxt = acc * __builtin_amdgcn_exp2f(bg[ww]) + sl[ww];
                *(LAS f32x4s*)(XL + (ww * 4) * 16 * 64 + f) = acc; acc = nxt; }
        } }
    LDS_WAIT(); __syncthreads();
    { const int ln = lane_id_opaque(); const LAS float* xs = (const LAS float*)F.lds + (w * 4) * 16 * 64;
#pragma unroll
        for (int kb = 0; kb < NKB; ++kb)
#pragma unroll
            for (int vb = 0; vb < 2; ++vb)
#pragma unroll
                for (int g = 0; g < 16; ++g) S[kb][vb][g] = xs[((kb * 2 + vb) * 16 + g) * 64 + ln]; }
    LDS_WAIT();
    __syncthreads();
#pragma unroll 1
    for (int ci = 0; ci < ((VAR & 64) ? 0 : NCH); ++ci) { const int cc = DIR ? NCH - 1 - ci : ci; const int cn = ci + 1 < NCH ? ci + 1 : ci; const int ccn = DIR ? NCH - 1 - cn : cn;
        chunk_step<DK, HG, DIR, true, VAR>(c, rowseg + cc * CH, rowseg + ccn * CH, raw, S, O);
        GAS unsigned* osc = (GAS unsigned*)OSC + (size_t)((w * NCH + cc) * 16) * 64; const int ln = lane_id_opaque();
#pragma unroll
        for (int vb = 0; vb < 2; ++vb)
#pragma unroll
            for (int g = 0; g < 8; ++g) { const unsigned ov_ = cvtpk(O[vb][2 * g], O[vb][2 * g + 1]);
                asm volatile("global_store_dword %0, %1, off sc1" :: "v"(osc + (unsigned)((vb * 8 + g) * 64 + ln)), "v"(ov_) : "memory"); }
    }
}

struct FinRaw { v4u g[4]; unsigned a0[16], a1[16]; };
template <bool HG> __device__ __forceinline__ void fin_load(FinRaw& r, const Args& a, int b, int h, int pair, int cc, int ln) {
    const bf16* P = (const bf16*)(a.ws + WS_PROJ);
    const GAS unsigned* o0 = (const GAS unsigned*)(a.ws + WS_OSC0 + (size_t)pair * OSC_UNIT) + (size_t)(cc * 16) * 64; const GAS unsigned* o1 = (const GAS unsigned*)(a.ws + WS_OSC1 + (size_t)pair * OSC_UNIT) + (size_t)(cc * 16) * 64;
    const bf16* gp = P + ((size_t)b * SEQ + cc * CH) * NP + (HG ? col_hg(h) : PQ_GG + h * 64);
#pragma unroll
    for (int i = 0; i < 4; ++i) { const int p = ln + 64 * i; r.g[i] = *(const GAS v4u*)(gp + (unsigned)((p >> 3) * NP + (p & 7) * 8)); }
#pragma unroll
    for (int i = 0; i < 16; ++i) { r.a0[i] = o0[(unsigned)(i * 64 + ln)]; r.a1[i] = o1[(unsigned)(i * 64 + ln)]; }
}
template <bool HG> __device__ __forceinline__ void fin_proc(const FinRaw& r, const Frame& F, const Args& a, int layer, int b, int h, int cc, int ln) {
    LAS unsigned char* TG = F.lds + F.wave * 8192; LAS unsigned char* TO = TG + 4096;
    const int rq = ln & 31, hq = ln >> 5;
    bf16* mp = (bf16*)(a.ws + WS_MIX) + ((size_t)b * SEQ + cc * CH) * DM + (HG ? 768 : 0) + h * 64;
    float ov[32], ss = 0.f;
#pragma unroll
    for (int i = 0; i < 16; ++i) { const unsigned a0 = r.a0[i], a1 = r.a1[i];
        const float v0 = __uint_as_float(a0 << 16) + __uint_as_float(a1 << 16), v1 = __uint_as_float(a0 & 0xffff0000u) + __uint_as_float(a1 & 0xffff0000u);
        ov[2 * i] = v0; ov[2 * i + 1] = v1; ss += v0 * v0 + v1 * v1; }
    ss += other_half(ss, hq);
    const float rs = 1.f / sqrtf(ss * (1.f / 64.f) + EPS);
#pragma unroll
    for (int i = 0; i < 4; ++i) { const int p = ln + 64 * i; *(LAS v4u*)(TG + (p >> 3) * 128 + (p & 7) * 16) = r.g[i]; }
    LDS_WAIT(); asm volatile("" ::: "memory");
    const float* nwp = (HG ? a.hgrn_norm : a.gla_norm) + layer * 64;
#pragma unroll
    for (int vb = 0; vb < 2; ++vb)
#pragma unroll
        for (int g = 0; g < 4; ++g) { const int col = 4 * hq + 32 * vb + 8 * g; const u32x2s gq = *(const LAS u32x2s*)(TG + rq * 128 + col * 2); const f32x4s nw = *(const GAS f32x4s*)(nwp + (unsigned)col);
            float gv[4] = {__uint_as_float(gq[0] << 16), __uint_as_float(gq[0] & 0xffff0000u), __uint_as_float(gq[1] << 16), __uint_as_float(gq[1] & 0xffff0000u)}; float out[4];
#pragma unroll
            for (int q = 0; q < 4; ++q) { const float sg = gv[q] / (1.f + __expf(-gv[q])); out[q] = ov[vb * 16 + 4 * g + q] * rs * nw[q] * sg; }
            u32x2s ow; ow[0] = cvtpk(out[0], out[1]); ow[1] = cvtpk(out[2], out[3]); *(LAS u32x2s*)(TO + rq * 128 + col * 2) = ow; }
    LDS_WAIT(); asm volatile("" ::: "memory");
#pragma unroll
    for (int i = 0; i < 4; ++i) { const int p = ln + 64 * i; const v4u o = *(const LAS v4u*)(TO + (p >> 3) * 128 + (p & 7) * 16); *(GAS v4u*)(mp + (unsigned)((p >> 3) * DM + (p & 7) * 8)) = o; }
    LDS_WAIT(); asm volatile("" ::: "memory");
}
template <bool HG>
__device__ __forceinline__ void finalize_chunks(const Frame& F, const Args& a, int layer, int b, int h, int pair, int c0, int nc) {
    int ln = F.lane; asm volatile("" : "+v"(ln));
    int cc = c0 + F.wave; const int ce = c0 + nc; if (cc >= ce) return;
    FinRaw A, B; fin_load<HG>(A, a, b, h, pair, cc, ln);
    for (;;) {
        const int n1 = cc + NWAVES; const bool h1 = n1 < ce; if (h1) fin_load<HG>(B, a, b, h, pair, n1, ln);
        fin_proc<HG>(A, F, a, layer, b, h, cc, ln); if (!h1) break;
        const int n2 = n1 + NWAVES; const bool h2 = n2 < ce; if (h2) fin_load<HG>(A, a, b, h, pair, n2, ln);
        fin_proc<HG>(B, F, a, layer, b, h, n1, ln); if (!h2) break;
        cc = n2;
    }
}
}

template <int VAR = 0> __device__ __forceinline__ void scan_phase_units(const Frame& F, const Args& a, int layer) {
    unsigned* flags = (unsigned*)(a.ws + WS_CTL) + 8192 + layer * 256;
    for (int u = F.vcu; u < 256; u += F.G) {
        const int pair = u >> 1, dir = u & 1, type = pair >> 6, b = (pair & 63) >> 2, h = pair & 3;
        if (type) { if (dir) scan::scan_unit<64, true, 1, VAR>(F, a, layer, b, h, u); else scan::scan_unit<64, true, 0, VAR>(F, a, layer, b, h, u); }
        else { if (dir) scan::scan_unit<32, false, 1, VAR>(F, a, layer, b, h, u); else scan::scan_unit<32, false, 0, VAR>(F, a, layer, b, h, u); }
        VM_WAIT(); __syncthreads();
        if (F.wave == 0 && lane_id_opaque() == 0) { unsigned ep = (unsigned)(layer + 1); unsigned long long fp = (unsigned long long)(flags + u); asm volatile("" : "+s"(ep), "+s"(fp));
            __builtin_amdgcn_fence(__ATOMIC_RELEASE, "agent"); VM_WAIT(); __hip_atomic_store((unsigned*)fp, ep, __ATOMIC_RELAXED, __HIP_MEMORY_SCOPE_AGENT); }
    }
}
#ifndef FIN_X
#define FIN_X 8
#endif
__device__ __forceinline__ void fin_wait(const Frame& F, unsigned* flag, int layer) {
    if (F.tid == 0) { unsigned spins = 0;
        while (__hip_atomic_load(flag, __ATOMIC_RELAXED, __HIP_MEMORY_SCOPE_AGENT) != (unsigned)(layer + 1)) { __builtin_amdgcn_s_sleep(2); if (++spins > (1u << 24)) break; }
        __builtin_amdgcn_fence(__ATOMIC_ACQUIRE, "agent"); VM_WAIT(); }
    __syncthreads();
}
__device__ __forceinline__ void scan_phase_finalize(const Frame& F, const Args& a, int layer) {
    unsigned* flags = (unsigned*)(a.ws + WS_CTL) + 8192 + layer * 256;
    for (int u = F.vcu; u < 256; u += F.G) {
        const int pair = u >> 1, dir = u & 1, type = pair >> 6, b = (pair & 63) >> 2, h = pair & 3;
        fin_wait(F, flags + (u ^ 1), layer);
        if (type) scan::finalize_chunks<true>(F, a, layer, b, h, pair, dir * 32, 32 - FIN_X);
        else { scan::finalize_chunks<false>(F, a, layer, b, h, pair, dir * 32, 32);
            if (FIN_X) { fin_wait(F, flags + 2 * (pair + 64), layer); fin_wait(F, flags + 2 * (pair + 64) + 1, layer);
                scan::finalize_chunks<true>(F, a, layer, b, h, pair + 64, dir * 32 + 32 - FIN_X, FIN_X); } }
    }
}
#define SCAN_PHASE scan_phase_units<0>
#define SCAN_HAS_FINALIZE 1
template <int VAR = 0> __device__ __forceinline__ void attn_phase(const Frame& F, const Args& a, int layer) {
    const bf16* P = (const bf16*)(a.ws + WS_PROJ); bf16* MX = (bf16*)(a.ws + WS_MIX);
    const float linit = 0.8f - 0.6f * expf(-0.3f * (float)layer);
    const float d1 = wave_sum(a.lq1[layer * 64 + F.lane] * a.lk1[layer * 64 + F.lane]), d2 = wave_sum(a.lq2[layer * 64 + F.lane] * a.lk2[layer * 64 + F.lane]);
    const float lam = expf(d1) - expf(d2) + linit;
    const int NU = BATCH * 4 * (SEQ / 128), per = (NU + F.G - 1) / F.G;
    auto unit_of = [&](int i) { int u = F.vcu * per + i;
        if (F.G == 256) { const int xcd = F.vcu >> 5, w = F.vcu & 31; u = ((xcd * 8 + i * 2 + (w >> 4)) << 4) | (w & 15); }
        return u; };
    dattn::bf16x8 qr[4]; bool pre = false;
    for (int i = 0; i < per; ++i) { if (F.vcu * per + i >= NU) break;
        const int u = unit_of(i); const int bh = u >> 4, qb = u & 15, b = bh >> 2, h = bh & 3; const size_t row0 = (size_t)b * SEQ + qb * 128;
        const bool hn = (i + 1 < per) && (F.vcu * per + i + 1 < NU); const int un = hn ? unit_of(i + 1) : u; const int bhn = un >> 4, bn = bhn >> 2, hh = bhn & 3; const size_t rown = (size_t)bn * SEQ + (un & 15) * 128;
        dattn::diff_unit<VAR>(P + row0 * NP + PQ_DQ + h * 128, P + (size_t)b * SEQ * NP + PQ_DK + h * 128, P + (size_t)b * SEQ * NP + PQ_DV + h * 128,
                         P + row0 * NP + PQ_DG + h * 128, MX + row0 * DM + 256 + h * 128, lam, a.diff_norm + layer * 128, 1.f - linit, (char*)F.lds, F.wave,
                         hn ? P + rown * NP + PQ_DQ + hh * 128 : nullptr, P + (size_t)bn * SEQ * NP + PQ_DK + hh * 128, P + (size_t)bn * SEQ * NP + PQ_DV + hh * 128, pre, qr);
        pre = hn; }
}

__global__ void __launch_bounds__(NWAVES * 64, 2) fwd_mega(Args args) {
    extern __shared__ __attribute__((aligned(16))) unsigned char lds[];
    cg::grid_group grid = cg::this_grid();
    const int wave_s = __builtin_amdgcn_readfirstlane((int)threadIdx.x >> 6);
#define MKFRAME() Frame F; { int t_ = wave_s * 64 + lane_id_opaque(); asm volatile("" : "+v"(t_)); F.lds = (LAS unsigned char*)lds; F.tid = t_; F.lane = t_ & 63; F.wave = wave_s; \
    F.G = gridDim.x; const int bx = blockIdx.x; F.vcu = (F.G % 8 == 0) ? (bx % 8) * (F.G / 8) + bx / 8 : bx; }
    constexpr int ARGTAB = LDS_BYTES - 256, NARGW = (int)(sizeof(Args) / 4);
    { const unsigned* src = (const unsigned*)&args; if (threadIdx.x < NARGW) ((LAS unsigned*)(lds + ARGTAB))[threadIdx.x] = src[threadIdx.x]; }
    { for (int u = threadIdx.x; u < 64; u += NWAVES * 64) ((LAS unsigned*)(lds + LDS_BYTES - 512))[u] = 0u; }
    __syncthreads();
    (void)xcd_barrier_post((unsigned*)(args.ws + WS_CTL) + 4096, (volatile LAS unsigned*)(lds + LDS_BYTES - 512));
    const int lo = args.ph_lo, hi = args.ph_hi, repm = args.rep;
#define LDARGS() Args A_; { unsigned off_ = ARGTAB; asm volatile("" : "+s"(off_)); const LAS unsigned* tab_ = (const LAS unsigned*)((LAS unsigned char*)lds + off_); unsigned* dst_ = (unsigned*)&A_; \
    _Pragma("unroll") for (int i_ = 0; i_ < NARGW; ++i_) dst_[i_] = __builtin_amdgcn_readfirstlane(tab_[i_]); }
#define IN(k) (lo <= (k) && (k) < hi)
#define SEAM(k) do { if (IN(k) && IN((k) + 1)) { for (int rep_ = 0; rep_ < 1 + 2 * ((repm >> 4) & 1); ++rep_) { if (repm == 0x40000000) grid.sync();   { LDARGS(); XcdBarrier b_; b_.bar = (unsigned*)(A_.ws + WS_CTL) + 4096; b_.x = xb_xcc_id(); b_.st = (volatile LAS unsigned*)(lds + LDS_BYTES - 512); xcd_barrier(b_); } } } } while (0)
#ifndef NO_P0
    if (IN(0)) { for (int rep_ = 0; rep_ < 1 + ((repm >> 6) & 1); ++rep_) { MKFRAME(); LDARGS(); p0_prologue(F, A_, 3); } for (int rep_ = 0; rep_ < ((repm >> 10) & 1); ++rep_) { MKFRAME(); LDARGS(); p0_prologue(F, A_, 1); } for (int rep_ = 0; rep_ < ((repm >> 11) & 1); ++rep_) { MKFRAME(); LDARGS(); p0_prologue(F, A_, 2); } }
#endif
    SEAM(0);
    for (int layer = 0; layer < DEPTH; ++layer) {
        const int pb = 1 + 4 * layer;
        if (IN(pb)) {
            MKFRAME(); LDARGS(); const Args& args = A_;
            pg8::Gemm g{(const pg8::bf16_t*)(args.ws + WS_XB), (const pg8::bf16_t*)(args.ws + WS_WIN) + (size_t)layer * NPA * DM, M, NP, DM};
            pg8::StaticOrder S; S.init(M, NP, F.G, (int)blockIdx.x);
            pg8::EpiProj E{(pg8::bf16_t*)(args.ws + WS_PROJ), (const float*)(args.ws + WS_ROPE), (const float*)(args.ws + WS_ROPE) + SEQ * 32, (const float*)(args.ws + WS_LB) + layer * 256, (const float*)(args.ws + WS_RSTD)};
            const bool lr_first = ((blockIdx.x >> 3) & 1) != 0;
#ifndef NO_LR
            if (lr_first) for (int rep_ = 0; rep_ < 1 + ((repm >> 5) & 1); ++rep_) lowrank_phase(F, args, layer);
#endif
#ifndef NO_GA
            for (int rep_ = -((repm >> 14) & 1); rep_ < 1 + (repm & 1); ++rep_)
            pg8::gemm_phase<pg8::EpiProj, pg8::StaticOrder, true, true>(F.lds, g, S, E, wave_s, rep_ < 0 ? -1 : ((repm >> 9) & 1));
#endif
#ifndef NO_LR
            if (!lr_first) for (int rep_ = 0; rep_ < 1 + ((repm >> 5) & 1); ++rep_) lowrank_phase(F, args, layer);
#endif
        }
        SEAM(pb);
        if (IN(pb + 1)) {
            int attn_first = (int)((blockIdx.x >> 4) & 1); asm volatile("" : "+s"(attn_first));
#ifndef NO_SCAN
            if (!attn_first) { for (int rep_ = 0; rep_ < 1 + ((repm >> 1) & 1); ++rep_) { MKFRAME(); LDARGS(); SCAN_PHASE(F, A_, layer); } }
#endif
#ifndef NO_ATTN
            for (int rep_ = 0; rep_ < 1 + ((repm >> 2) & 1); ++rep_) { MKFRAME(); LDARGS(); attn_phase<0>(F, A_, layer); }
#endif
#ifndef NO_SCAN
            if (attn_first) { for (int rep_ = 0; rep_ < 1 + ((repm >> 1) & 1); ++rep_) { MKFRAME(); LDARGS(); SCAN_PHASE(F, A_, layer); } }
#endif
#ifdef SCAN_HAS_FINALIZE
            for (int rep_ = 0; rep_ < 1 + ((repm >> 7) & 1); ++rep_) { MKFRAME(); LDARGS(); scan_phase_finalize(F, A_, layer); }
#endif
        }
        SEAM(pb + 1);
        if (IN(pb + 2)) {
            MKFRAME(); LDARGS(); const Args& args = A_;
            pg8::Gemm g{(const pg8::bf16_t*)(args.ws + WS_MIX), (const pg8::bf16_t*)(args.ws + WS_WOUT) + (size_t)layer * DM * DM, M, DM, DM};
            pg8::StaticOrder S; S.init(M, DM, F.G, (int)blockIdx.x);
            pg8::EpiY E{(pg8::bf16_t*)(args.ws + WS_Y)};
#ifndef NO_GC
            for (int rep_ = 0; rep_ < 1 + ((repm >> 3) & 1); ++rep_)
            pg8::gemm_phase<pg8::EpiY, pg8::StaticOrder, true, true>(F.lds, g, S, E, wave_s);
#endif
        }
        SEAM(pb + 2);
#ifndef NO_PD
        if (IN(pb + 3)) { MKFRAME(); LDARGS(); postnorm_phase(F, A_, layer); for (int rep_ = 0; rep_ < ((repm >> 8) & 1); ++rep_) postnorm_phase(F, A_, layer, true); }
#endif
        if (layer + 1 < DEPTH) SEAM(pb + 3);
    }
#undef IN
#undef SEAM
}
constexpr int N_PHASES = 1 + 4 * DEPTH;

extern "C" void kernel_launch(void* const* d_in, const int* in_sizes, int n_in, void* d_out, int out_size, void* d_ws, size_t ws_size, hipStream_t stream) {
    static int grid = 0;
    if (grid == 0) {
        if (n_in != 17 || in_sizes[0] != M * DM || out_size != M * DM || ws_size < WS_END) {
            fprintf(stderr, "kernel_launch: shape mismatch n_in %d in0 %d out %d ws %zu (need %zu)\n", n_in, n_in > 0 ? in_sizes[0] : -1, out_size, ws_size, (size_t)WS_END); grid = -1; return; }
        int dev = 0, cus = 0, per_cu = 0;
        if (hipGetDevice(&dev) != hipSuccess || hipDeviceGetAttribute(&cus, hipDeviceAttributeMultiprocessorCount, dev) != hipSuccess) { grid = -1; return; }
        if (hipFuncSetAttribute((const void*)fwd_mega, hipFuncAttributeMaxDynamicSharedMemorySize, LDS_BYTES) != hipSuccess) { fprintf(stderr, "kernel_launch: hipFuncSetAttribute failed\n"); grid = -1; return; }
        if (hipOccupancyMaxActiveBlocksPerMultiprocessor(&per_cu, (const void*)fwd_mega, NWAVES * 64, LDS_BYTES) != hipSuccess || per_cu < 1) { fprintf(stderr, "kernel_launch: occupancy query says %d\n", per_cu); (void)hipGetLastError(); grid = -1; return; }
        grid = cus;
        fprintf(stderr, "kernel_launch: cus %d per_cu %d grid %d ws %zu\n", cus, per_cu, grid, ws_size);
    }
    if (grid < 0) return;
    if (hipMemsetAsync((char*)d_ws + WS_CTL, 0, 65536, stream) != hipSuccess) { fprintf(stderr, "kernel_launch: memset failed\n"); return; }
    Args a{};
    a.x = (const float*)d_in[0]; a.norm_pre = (const float*)d_in[1]; a.norm_post = (const float*)d_in[2]; a.w_in = (const float*)d_in[3]; a.w_out = (const float*)d_in[4];
    a.gla_wa2_f = (const float*)d_in[5]; a.gla_ba_f = (const float*)d_in[6]; a.gla_wa2_b = (const float*)d_in[7]; a.gla_ba_b = (const float*)d_in[8]; a.gla_norm = (const float*)d_in[9];
    a.lq1 = (const float*)d_in[10]; a.lk1 = (const float*)d_in[11]; a.lq2 = (const float*)d_in[12]; a.lk2 = (const float*)d_in[13]; a.diff_norm = (const float*)d_in[14];
    a.lb_logits = (const float*)d_in[15]; a.hgrn_norm = (const float*)d_in[16];
    a.out = (float*)d_out; a.ws = (unsigned char*)d_ws; a.ph_lo = 0; a.ph_hi = N_PHASES;
#ifdef REP_MASK
    a.rep = REP_MASK;
#endif
    void* kargs[] = {&a};
    const hipError_t e = hipLaunchCooperativeKernel((const void*)fwd_mega, dim3(grid), dim3(NWAVES * 64), kargs, LDS_BYTES, stream);
    if (e != hipSuccess) fprintf(stderr, "kernel_launch: cooperative launch failed: %s (grid %d)\n", hipGetErrorString(e), grid);
}
```

```cpp
#include <hip/hip_runtime.h>
#include <hip/hip_cooperative_groups.h>
#include <hip/hip_bf16.h>
#include <cstdio>
#include <cstdint>
#include <cmath>
namespace cg = cooperative_groups;
__device__ __forceinline__ int lane_id_opaque() { int x; asm volatile("v_mbcnt_lo_u32_b32 %0, -1, 0\n\tv_mbcnt_hi_u32_b32 %0, -1, %0" : "=v"(x)); return x; }
template <int MASK> __device__ __forceinline__ float xor_shfl(float v) {
    if constexpr (MASK == 32) { auto rr = __builtin_amdgcn_permlane32_swap(__float_as_uint(v), __float_as_uint(v), false, false);
        return __uint_as_float(rr[0] ^ rr[1] ^ __float_as_uint(v)); }
    else return __int_as_float(__builtin_amdgcn_ds_swizzle(__float_as_int(v), (MASK << 10) | 0x1f));
}
namespace pg8 {
#define PG8_LAS __attribute__((address_space(3)))
typedef unsigned short bf16_t;
typedef short bf16x8 __attribute__((ext_vector_type(8)));
typedef float f32x4 __attribute__((ext_vector_type(4)));
typedef unsigned u32x4 __attribute__((ext_vector_type(4)));
constexpr int BM = 256, BK = 64, HALF = 128, HTB = HALF * BK * 2  , STAGE_BYTES = 8 * HTB, NXCD = 8, WGM = 8;

__host__ __device__ __forceinline__ int lds_byte(int r, int c) { const int st = (r >> 4) * 2 + (c >> 5), rr = r & 15, cc = c & 31, ob = rr * 64 + cc * 2; return st * 1024 + (ob ^ (((ob >> 9) & 1) << 5)); }
__host__ __device__ __forceinline__ void stage_rc(int b, int& R, int& C) { const int st = b / 1024, sb = b % 1024, swz = sb ^ (((sb >> 9) & 1) << 5); R = (st >> 1) * 16 + swz / 64; C = (st & 1) * 32 + (swz % 64) / 2; }
__host__ __device__ __forceinline__ int perm32(int rho) { const int n = rho >> 4, i = rho & 15; return 8 * (i >> 2) + 4 * n + (i & 3); }

struct Unit { int pm, pn; };
struct Gemm { const bf16_t* A; const bf16_t* Bt; int M, N, K; };

struct StaticOrder {
    int nM, nN, nwg, G, c;
    __host__ __device__ void init(int M, int N, int G_, int c_) { nM = M / BM; nN = N / BM; nwg = nM * nN; G = G_; c = c_; }
    __host__ __device__ bool next(int i, Unit& u) const {
        const long L = (long)i * G + c; if (L >= nwg) return false;
        int wgid = (int)L; { const int q = nwg / NXCD, r = nwg % NXCD, xcd = wgid % NXCD, off = wgid / NXCD; wgid = (xcd < r ? xcd * (q + 1) : r * (q + 1) + (xcd - r) * q) + off; }
        const int nig = WGM * nN, gid = wgid / nig, fm = gid * WGM, gsz = (nM - fm) < WGM ? (nM - fm) : WGM;
        u.pm = fm + ((wgid % nig) % gsz); u.pn = (wgid % nig) / gsz; return true;
    }
    __device__ __forceinline__ void a_ready(const Unit&) const {}
    __device__ __forceinline__ void done(const Unit&) const {}
};
__device__ __forceinline__ unsigned cvt_pk_bf16(float lo, float hi) { unsigned r; asm volatile("v_cvt_pk_bf16_f32 %0, %1, %2" : "=v"(r) : "v"(lo), "v"(hi)); return r; }
typedef float f32x2 __attribute__((ext_vector_type(2)));
struct EpiF32 {
    static constexpr bool PERM = false, AFTER_DRAIN = false;
    float* C; int ldc; const float* bias;
    __device__ __forceinline__ void operator()(const f32x4 (&acc)[2][2][4][2], const Unit& u, int wr, int wc, int fr, int fq) const {
        const int row0 = u.pm * BM + wr * 64 + fr, col0 = u.pn * BM + wc * 32 + 4 * fq;
        f32x4 bv[2][2];
#pragma unroll
        for (int bj = 0; bj < 2; ++bj)
#pragma unroll
            for (int n = 0; n < 2; ++n) bv[bj][n] = bias ? *(const f32x4*)(bias + col0 + bj * HALF + n * 16) : (f32x4){0.f, 0.f, 0.f, 0.f};
#pragma unroll
        for (int ai = 0; ai < 2; ++ai)
#pragma unroll
            for (int m = 0; m < 4; ++m) { float* rowp = C + (size_t)(row0 + ai * HALF + m * 16) * ldc + col0;
#pragma unroll
                for (int bj = 0; bj < 2; ++bj)
#pragma unroll
                    for (int n = 0; n < 2; ++n) *(f32x4*)(rowp + bj * HALF + n * 16) = acc[ai][bj][m][n] + bv[bj][n]; }
    }
};
#define PG8_GAS __attribute__((address_space(1)))
constexpr float QSCALE = 0.125f * 1.4426950408889634f;
struct EpiProj {
    static constexpr bool PERM = true, AFTER_DRAIN = false; static constexpr int NST = 16;
    bf16_t* O; const float* cosT; const float* sinT; const float* lbrow; const float* rstd;
    __device__ __forceinline__ void operator()(const f32x4 (&acc)[2][2][4][2], const Unit& u, int wr, int wc, int fr, int fq) const {
        const int row0 = u.pm * BM + wr * 64 + fr, col0 = u.pn * BM + wc * 32 + 8 * fq;
        const bool rope = (u.pn >= 3 && u.pn <= 6), hgt = (u.pn >= 12);
        const int j8 = (wc & 1) * 4 + fq;
        float rs[2][4];
#pragma unroll
        for (int ai = 0; ai < 2; ++ai)
#pragma unroll
            for (int m = 0; m < 4; ++m) rs[ai][m] = *(const PG8_GAS float*)(rstd + row0 + ai * HALF + m * 16);
        if (rope) {
            const float qs = (u.pn == 3 || u.pn == 4) ? QSCALE : 1.f;
#pragma unroll
            for (int ai = 0; ai < 2; ++ai) { f32x4 c4[4], s4[4];
#pragma unroll
                for (int m = 0; m < 4; ++m) { const int pos = (row0 + ai * HALF + m * 16) & 2047; c4[m] = *(const PG8_GAS f32x4*)(cosT + pos * 32 + 4 * j8); s4[m] = *(const PG8_GAS f32x4*)(sinT + pos * 32 + 4 * j8); }
#pragma unroll
                for (int m = 0; m < 4; ++m) { bf16_t* rowp = O + (size_t)(row0 + ai * HALF + m * 16) * 4096 + col0; const float r = rs[ai][m] * qs;
#pragma unroll
                    for (int bj = 0; bj < 2; ++bj) { const f32x4 a0 = acc[ai][bj][m][0] * r, a1 = acc[ai][bj][m][1] * r;
                        const f32x4 v0 = a0 * c4[m] - a1 * s4[m], v1 = a1 * c4[m] + a0 * s4[m];
                        u32x4 w; w.x = cvt_pk_bf16(v0[0], v0[1]); w.y = cvt_pk_bf16(v0[2], v0[3]); w.z = cvt_pk_bf16(v1[0], v1[1]); w.w = cvt_pk_bf16(v1[2], v1[3]);
                        *(PG8_GAS u32x4*)(rowp + bj * HALF) = w; } } }
            return;
        }
        f32x4 lb0 = (f32x4){0.f, 0.f, 0.f, 0.f}, lb1 = lb0;
        if (hgt) { lb0 = *(const PG8_GAS f32x4*)(lbrow + (u.pn & 1) * 128 + wc * 32 + 8 * fq); lb1 = *(const PG8_GAS f32x4*)(lbrow + (u.pn & 1) * 128 + wc * 32 + 8 * fq + 4); }
#pragma unroll
        for (int ai = 0; ai < 2; ++ai)
#pragma unroll
            for (int m = 0; m < 4; ++m) { bf16_t* rowp = O + (size_t)(row0 + ai * HALF + m * 16) * 4096 + col0; const float r = rs[ai][m];
#pragma unroll
                for (int bj = 0; bj < 2; ++bj) { f32x4 v0 = acc[ai][bj][m][0] * r, v1 = acc[ai][bj][m][1] * r;
                    if (hgt && bj == 0) {
#pragma unroll
                        for (int e = 0; e < 4; ++e) { const float z0 = v0[e], z1 = v1[e];
                            const float e0 = __expf(-fabsf(z0)), r0 = __builtin_amdgcn_rcpf(1.f + e0), sg0 = z0 >= 0.f ? r0 : e0 * r0;
                            const float e1 = __expf(-fabsf(z1)), r1 = __builtin_amdgcn_rcpf(1.f + e1), sg1 = z1 >= 0.f ? r1 : e1 * r1;
                            v0[e] = __builtin_amdgcn_logf(fmaxf(lb0[e] + (1.f - lb0[e]) * sg0, 1e-30f)); v1[e] = __builtin_amdgcn_logf(fmaxf(lb1[e] + (1.f - lb1[e]) * sg1, 1e-30f)); } }
                    u32x4 w; w.x = cvt_pk_bf16(v0[0], v0[1]); w.y = cvt_pk_bf16(v0[2], v0[3]); w.z = cvt_pk_bf16(v1[0], v1[1]); w.w = cvt_pk_bf16(v1[2], v1[3]);
                    *(PG8_GAS u32x4*)(rowp + bj * HALF) = w; } }
    }
};
struct EpiY {
    static constexpr bool PERM = true, AFTER_DRAIN = false; static constexpr int NST = 16;
    bf16_t* O;
    __device__ __forceinline__ void operator()(const f32x4 (&acc)[2][2][4][2], const Unit& u, int wr, int wc, int fr, int fq) const {
        const int row0 = u.pm * BM + wr * 64 + fr, col0 = u.pn * BM + wc * 32 + 8 * fq;
#pragma unroll
        for (int ai = 0; ai < 2; ++ai)
#pragma unroll
            for (int m = 0; m < 4; ++m) { bf16_t* rowp = O + (size_t)(row0 + ai * HALF + m * 16) * 1024 + col0;
#pragma unroll
                for (int bj = 0; bj < 2; ++bj) { const f32x4 v0 = acc[ai][bj][m][0], v1 = acc[ai][bj][m][1];
                    u32x4 w; w.x = cvt_pk_bf16(v0[0], v0[1]); w.y = cvt_pk_bf16(v0[2], v0[3]); w.z = cvt_pk_bf16(v1[0], v1[1]); w.w = cvt_pk_bf16(v1[2], v1[3]);
                    *(PG8_GAS u32x4*)(rowp + bj * HALF) = w; } }
    }
};
template <class Epi, class Sched, bool ALIGN_EPI = false, bool SP2 = false>
__device__ __forceinline__ void gemm_phase(PG8_LAS unsigned char* lds, const Gemm g, const Sched& S, const Epi& E, int wave_s, int epi_rep = 0) {
    int tid_ = wave_s * 64 + lane_id_opaque(); asm volatile("" : "+v"(tid_));
    const int tid = tid_, wid = __builtin_amdgcn_readfirstlane(tid >> 6), lane = tid & 63, wr = wid >> 2, wc = wid & 3, fr = lane & 15, fq = lane >> 4;
    const int K = g.K, nt = K / BK;
    unsigned voffA[2], voffB[2];
#pragma unroll
    for (int i = 0; i < 2; ++i) { int R, C; stage_rc(tid * 16 + i * 8192, R, C); const int Rb = Epi::PERM ? ((R & ~31) + perm32(R & 31)) : R;
        voffA[i] = (unsigned)(R * K + C) * 2u; voffB[i] = (unsigned)(Rb * K + C) * 2u; }
    const size_t kstep = (size_t)(BK * 2);
    const size_t hstep = (size_t)HALF * K * 2;
    const size_t tstep = 2 * hstep;
    const unsigned ldsw = (unsigned)wid * 1024u;
    const int aoff = lds_byte(wr * 64 + fr, fq * 8), boff = lds_byte(wc * 32 + fr, fq * 8);
#define PG8_SA(b, h) (((b) * 2 + (h)) * HTB)
#define PG8_SB(b, h) ((4 + (b) * 2 + (h)) * HTB)
#define PG8_STAGE(bufoff, gbase, voff) do { _Pragma("unroll") for (int _i = 0; _i < 2; ++_i) \
        __builtin_amdgcn_global_load_lds((const unsigned*)((const char*)(gbase) + (voff)[_i]), (PG8_LAS unsigned*)(lds + (bufoff) + ldsw + _i * 8192), 16, 0, 0); } while (0)
#define PG8_LDA(dst, b, h) do { _Pragma("unroll") for (int m = 0; m < 4; ++m) _Pragma("unroll") for (int k = 0; k < 2; ++k) dst[m][k] = *(const PG8_LAS bf16x8*)(lds + PG8_SA(b, h) + aoff + m * 2048 + k * 1024); } while (0)
#define PG8_LDB(dst, b, h) do { _Pragma("unroll") for (int n = 0; n < 2; ++n) _Pragma("unroll") for (int k = 0; k < 2; ++k) dst[n][k] = *(const PG8_LAS bf16x8*)(lds + PG8_SB(b, h) + boff + n * 2048 + k * 1024); } while (0)
#define PG8_MMA(ai, bj, At, Bt) do { __builtin_amdgcn_s_setprio(1); _Pragma("unroll") for (int m = 0; m < 4; ++m) _Pragma("unroll") for (int n = 0; n < 2; ++n) _Pragma("unroll") for (int k = 0; k < 2; ++k) \
        acc[ai][bj][m][n] = __builtin_amdgcn_mfma_f32_16x16x32_bf16(Bt[n][k], At[m][k], acc[ai][bj][m][n], 0, 0, 0); __builtin_amdgcn_s_setprio(0); } while (0)
#define PG8_WAIT_V(n) asm volatile("s_waitcnt vmcnt(" #n ")" ::: "memory")
#define PG8_WAIT_L(n) asm volatile("s_waitcnt lgkmcnt(" #n ")" ::: "memory")
#define PG8_BAR __builtin_amdgcn_s_barrier()
#define PG8_SCHED __builtin_amdgcn_sched_barrier(0)
    Unit cur, nxt; int ui = 0;
    if (!S.next(0, cur)) return;
    f32x4 acc[2][2][4][2];
#pragma unroll
    for (int a = 0; a < 2; ++a)
#pragma unroll
        for (int b = 0; b < 2; ++b)
#pragma unroll
            for (int m = 0; m < 4; ++m)
#pragma unroll
                for (int n = 0; n < 2; ++n) acc[a][b][m][n] = (f32x4){0.f, 0.f, 0.f, 0.f};
    bf16x8 At[4][2], B0[2][2], B1[2][2];
    const char* cA = (const char*)g.A + (size_t)cur.pm * tstep; const char* cB = (const char*)g.Bt + (size_t)cur.pn * tstep;
    S.a_ready(cur);
    if constexpr (SP2) {
        PG8_STAGE(PG8_SB(0, 0), cB, voffB); PG8_STAGE(PG8_SB(0, 1), cB + hstep, voffB); PG8_STAGE(PG8_SA(0, 0), cA, voffA); PG8_STAGE(PG8_SA(0, 1), cA + hstep, voffA);
        if (wr == 1) PG8_BAR;
        PG8_WAIT_V(2); PG8_BAR;
        PG8_STAGE(PG8_SB(1, 0), cB + kstep, voffB); PG8_STAGE(PG8_SA(1, 0), cA + kstep, voffA); PG8_STAGE(PG8_SB(1, 1), cB + hstep + kstep, voffB);
        PG8_WAIT_V(6); PG8_BAR;
    } else {
        PG8_STAGE(PG8_SB(0, 0), cB, voffB); PG8_STAGE(PG8_SA(0, 0), cA, voffA); PG8_STAGE(PG8_SB(0, 1), cB + hstep, voffB); PG8_STAGE(PG8_SA(0, 1), cA + hstep, voffA);
        if (wr == 1) PG8_BAR;
        PG8_WAIT_V(4); PG8_BAR;
        PG8_STAGE(PG8_SB(1, 0), cB + kstep, voffB); PG8_STAGE(PG8_SA(1, 0), cA + kstep, voffA); PG8_STAGE(PG8_SB(1, 1), cB + hstep + kstep, voffB);
        PG8_WAIT_V(6); PG8_BAR;
    }
    for (;;) {
        const bool has_next = S.next(ui + 1, nxt);
        const char* nA = has_next ? (const char*)g.A + (size_t)nxt.pm * tstep : cA; const char* nB = has_next ? (const char*)g.Bt + (size_t)nxt.pn * tstep : cB;
        for (int t = 0; t < nt; t += 2) {
            const bool last = (t == nt - 2);
            const char* a1 = cA + (size_t)(t + 1) * kstep;
            const char* a2 = last ? nA : cA + (size_t)(t + 2) * kstep; const char* b2 = last ? nB : cB + (size_t)(t + 2) * kstep;
            const char* a3 = a2 + kstep; const char* b3 = b2 + kstep;
            if (last && has_next) S.a_ready(nxt);
            if constexpr (SP2) {
            PG8_LDB(B0, 0, 0); PG8_LDB(B1, 0, 1); PG8_SCHED; PG8_LDA(At, 0, 0); PG8_STAGE(PG8_SA(1, 1), a1 + hstep, voffA);
            PG8_WAIT_V(8); PG8_WAIT_L(0); PG8_BAR; PG8_MMA(0, 0, At, B0); PG8_MMA(0, 1, At, B1); PG8_BAR; PG8_SCHED;
            PG8_LDA(At, 0, 1); PG8_STAGE(PG8_SB(0, 0), b2, voffB); PG8_STAGE(PG8_SB(0, 1), b2 + hstep, voffB); PG8_STAGE(PG8_SA(0, 0), a2, voffA);
            PG8_WAIT_V(8); PG8_WAIT_L(0); PG8_BAR; PG8_MMA(1, 0, At, B0); PG8_MMA(1, 1, At, B1); PG8_BAR; PG8_SCHED;
            PG8_LDB(B0, 1, 0); PG8_LDB(B1, 1, 1); PG8_SCHED; PG8_LDA(At, 1, 0); PG8_STAGE(PG8_SA(0, 1), a2 + hstep, voffA);
            PG8_WAIT_V(8); PG8_WAIT_L(0); PG8_BAR; PG8_MMA(0, 0, At, B0); PG8_MMA(0, 1, At, B1); PG8_BAR; PG8_SCHED;
            PG8_LDA(At, 1, 1); PG8_STAGE(PG8_SB(1, 0), b3, voffB); PG8_STAGE(PG8_SB(1, 1), b3 + hstep, voffB); PG8_STAGE(PG8_SA(1, 0), a3, voffA);
            PG8_WAIT_V(8); PG8_WAIT_L(0); PG8_BAR; PG8_MMA(1, 0, At, B0); PG8_MMA(1, 1, At, B1); PG8_BAR; PG8_SCHED;
            } else {
            PG8_LDB(B0, 0, 0); PG8_SCHED; PG8_LDA(At, 0, 0); PG8_STAGE(PG8_SA(1, 1), a1 + hstep, voffA);
            PG8_WAIT_L(8); PG8_BAR; PG8_WAIT_L(0); PG8_MMA(0, 0, At, B0); PG8_BAR; PG8_SCHED;
            PG8_LDB(B1, 0, 1); PG8_STAGE(PG8_SB(0, 0), b2, voffB);
            PG8_BAR; PG8_WAIT_L(0); PG8_MMA(0, 1, At, B1); PG8_BAR;
            PG8_LDA(At, 0, 1); PG8_STAGE(PG8_SA(0, 0), a2, voffA);
            PG8_BAR; PG8_WAIT_L(0); PG8_MMA(1, 0, At, B0); PG8_BAR; PG8_SCHED;
            PG8_STAGE(PG8_SB(0, 1), b2 + hstep, voffB);
            PG8_WAIT_V(6); PG8_BAR; PG8_MMA(1, 1, At, B1); PG8_BAR;
            PG8_LDB(B0, 1, 0); PG8_SCHED; PG8_LDA(At, 1, 0); PG8_STAGE(PG8_SA(0, 1), a2 + hstep, voffA);
            PG8_WAIT_L(8); PG8_BAR; PG8_WAIT_L(0); PG8_MMA(0, 0, At, B0); PG8_BAR; PG8_SCHED;
            PG8_LDB(B1, 1, 1); PG8_STAGE(PG8_SB(1, 0), b3, voffB);
            PG8_BAR; PG8_WAIT_L(0); PG8_MMA(0, 1, At, B1); PG8_BAR;
            PG8_LDA(At, 1, 1); PG8_STAGE(PG8_SA(1, 0), a3, voffA);
            PG8_BAR; PG8_WAIT_L(0); PG8_MMA(1, 0, At, B0); PG8_BAR; PG8_SCHED;
            PG8_STAGE(PG8_SB(1, 1), b3 + hstep, voffB);
            PG8_WAIT_V(6); PG8_BAR; PG8_MMA(1, 1, At, B1); PG8_BAR;
            }
        }
        if constexpr (ALIGN_EPI) { if (wr == 0) PG8_BAR; }
        if constexpr (!Epi::AFTER_DRAIN) { if (epi_rep >= 0) E(acc, cur, wr, wc, fr, fq); else {
#pragma unroll
                for (int a_ = 0; a_ < 2; ++a_)
#pragma unroll
                    for (int b_ = 0; b_ < 2; ++b_)
#pragma unroll
                        for (int m_ = 0; m_ < 4; ++m_) asm volatile("" :: "v"(acc[a_][b_][m_][0]), "v"(acc[a_][b_][m_][1])); }
            for (int er_ = 0; er_ < epi_rep; ++er_) E(acc, cur, wr, wc, fr, fq); S.done(cur); }
        if (!has_next) break;
#pragma unroll
        for (int a = 0; a < 2; ++a)
#pragma unroll
            for (int b = 0; b < 2; ++b)
#pragma unroll
                for (int m = 0; m < 4; ++m)
#pragma unroll
                    for (int n = 0; n < 2; ++n) acc[a][b][m][n] = (f32x4){0.f, 0.f, 0.f, 0.f};
        cur = nxt; cA = nA; cB = nB; ++ui;
        if constexpr (ALIGN_EPI) { if (wr == 1) PG8_BAR; }
    }
    PG8_WAIT_V(0);
    if constexpr (!ALIGN_EPI) { if (wr == 0) PG8_BAR; }
    PG8_BAR;
    if constexpr (Epi::AFTER_DRAIN) { E.fused(acc, cur, wr, wc, fr, fq, lds, wid, lane); S.done(cur); }
#undef PG8_SA
#undef PG8_SB
#undef PG8_STAGE
#undef PG8_LDA
#undef PG8_LDB
#undef PG8_MMA
#undef PG8_WAIT_V
#undef PG8_WAIT_L
#undef PG8_BAR
#undef PG8_SCHED
}
}
#ifndef PP_OFF
#define PP_OFF 1
#endif
namespace dattn {
using bf16x8 = __attribute__((ext_vector_type(8))) short;
using s16x4  = __attribute__((ext_vector_type(4))) short;
using f32x16 = __attribute__((ext_vector_type(16))) float;
using u32x4  = __attribute__((ext_vector_type(4))) unsigned;
typedef unsigned short bf16r;
constexpr int NW = 8, QBLK = 32, KVBLK = 64, SEQ = 2048, LDP = 4096;
constexpr float SCALE = 0.125f, THR = 8.f;
constexpr int TILE_B = KVBLK * 128 * 2, NKSLOT = 3, NVSLOT = 5, VRING = NKSLOT * TILE_B; constexpr size_t SHM_WS = 131072;
#define KSWZ(row, colB) ((row) * 256 + ((colB) ^ ((((row) & 7) << 4) | ((((row) >> 3) & 1) << 7))))
#define SBAR() __builtin_amdgcn_sched_barrier(0)
__device__ __forceinline__ int crow(int r, int hi) { return (r & 3) + 8 * (r >> 2) + 4 * hi; }
__device__ __forceinline__ unsigned cvtpk(float lo, float hi) { unsigned r; asm volatile("v_cvt_pk_bf16_f32 %0, %1, %2" : "=v"(r) : "v"(lo), "v"(hi)); return r; }

constexpr float THR2 = THR * 1.4426950408889634f;
template <int VAR = 0, bool FIRST = false> __device__ __forceinline__ void partialSM(f32x16& p0, f32x16& p1, f32x16& negm, float& alpha) {
  if (VAR & 32) { alpha = 1.f; return; }
  float pmax = p0[0];
#pragma unroll
  for (int r = 1; r < 16; ++r) pmax = fmaxf(pmax, p0[r]);
#pragma unroll
  for (int r = 0; r < 16; ++r) pmax = fmaxf(pmax, p1[r]);
  { auto rr = __builtin_amdgcn_permlane32_swap(__float_as_uint(pmax), __float_as_uint(pmax), false, false);
    pmax = fmaxf(__uint_as_float(rr[0]), __uint_as_float(rr[1])); }
  alpha = 1.f;
  if (FIRST || !__builtin_expect(__all(pmax <= THR2), 1)) {
    const float dl = FIRST ? pmax : fmaxf(pmax, 0.f);
#pragma unroll
    for (int r = 0; r < 16; ++r) { p0[r] -= dl; p1[r] -= dl; }
    const float nm = negm[0] - dl;
#pragma unroll
    for (int r = 0; r < 16; ++r) negm[r] = nm;
    alpha = FIRST ? 1.f : __builtin_amdgcn_exp2f(-dl);
  }
#pragma unroll
  for (int r = 0; r < 16; ++r) p0[r] = (VAR & 1) ? p0[r] : __builtin_amdgcn_exp2f(p0[r]);
}
template <int VAR = 0> __device__ __forceinline__ void finishSM(f32x16& p0, f32x16& p1, float alpha, float& l_reg, bf16x8& pa0, bf16x8& pa1, bf16x8& pa2, bf16x8& pa3) {
#pragma unroll
  for (int r = 0; r < 16; ++r) p1[r] = (VAR & (1 | 32)) ? p1[r] : __builtin_amdgcn_exp2f(p1[r]);
  float ps = 0;
  if (!(VAR & 32)) {
#pragma unroll
  for (int r = 0; r < 16; ++r) ps += p0[r];
#pragma unroll
  for (int r = 0; r < 16; ++r) ps += p1[r];
  { auto rr = __builtin_amdgcn_permlane32_swap(__float_as_uint(ps), __float_as_uint(ps), false, false);
    ps = __uint_as_float(rr[0]) + __uint_as_float(rr[1]); }
  l_reg = l_reg * alpha + ps; }
#define PK4(P, BASE, OUT) do { u32x4 w = {cvtpk(P[BASE + 0], P[BASE + 1]), cvtpk(P[BASE + 2], P[BASE + 3]), cvtpk(P[BASE + 4], P[BASE + 5]), cvtpk(P[BASE + 6], P[BASE + 7])}; OUT = *reinterpret_cast<bf16x8*>(&w); } while (0)
  PK4(p0, 0, pa0); PK4(p0, 8, pa1); PK4(p1, 0, pa2); PK4(p1, 8, pa3);
#undef PK4
}
template <int VAR = 0> __device__ __forceinline__ void qkt(f32x16& p0, f32x16& p1, const char* Ks, const bf16x8* qr, int r32, int hi, int colb0, const f32x16& negm) {
  p0 = negm; p1 = negm;
  if (VAR & 4) { asm volatile("" : "+v"(p0), "+v"(p1)); return; }
  bf16x8 kf[2][2];
  { const int cb = colb0 + (hi * 8) * 2; kf[0][0] = *reinterpret_cast<const bf16x8*>(Ks + KSWZ(r32, cb)); kf[0][1] = *reinterpret_cast<const bf16x8*>(Ks + KSWZ(32 + r32, cb)); }
#pragma unroll
  for (int d0 = 0; d0 < 4; ++d0) {
    if (d0 < 3) { const int cb = colb0 + ((d0 + 1) * 16 + hi * 8) * 2; kf[(d0 + 1) & 1][0] = *reinterpret_cast<const bf16x8*>(Ks + KSWZ(r32, cb)); kf[(d0 + 1) & 1][1] = *reinterpret_cast<const bf16x8*>(Ks + KSWZ(32 + r32, cb)); }
    __builtin_amdgcn_sched_group_barrier(0x100, 2, 0);
    p0 = __builtin_amdgcn_mfma_f32_32x32x16_bf16(kf[d0 & 1][0], qr[d0], p0, 0, 0, 0);
    p1 = __builtin_amdgcn_mfma_f32_32x32x16_bf16(kf[d0 & 1][1], qr[d0], p1, 0, 0, 0);
    __builtin_amdgcn_sched_group_barrier(0x008, 2, 0); }
}
__device__ __forceinline__ int v_st(int k, int c) { const int kk = (k & ~0xC) | ((k & 4) << 1) | ((k & 8) >> 1); return ((kk >> 3) * 4 + (c >> 5)) * 512 + ((kk & 7) * 32 + (c & 31)) * 2; }
__device__ __forceinline__ int v_rd_base(int lane) { return ((lane & 3) << 3) | (((lane >> 2) & 3) << 6) | (((lane >> 4) & 1) << 5) | (((lane >> 5) & 1) << 8); }
constexpr int v_rd_off(int d0, int ks, int half) { return d0 * 512 + ks * 4096 + half * 2048; }
template <int OFF> __device__ __forceinline__ s16x4 tr_read(int vb) {
  s16x4 r; asm volatile("ds_read_b64_tr_b16 %0, %1 offset:%2" : "=&v"(r) : "v"(vb), "i"(OFF) : "memory"); return r;
}
template <int D0> __device__ __forceinline__ void pv_one(f32x16& od, int vb, bf16x8 pa0, bf16x8 pa1, bf16x8 pa2, bf16x8 pa3) {
  const s16x4 l0 = tr_read<v_rd_off(D0, 0, 0)>(vb), h0 = tr_read<v_rd_off(D0, 0, 1)>(vb), l1 = tr_read<v_rd_off(D0, 1, 0)>(vb), h1 = tr_read<v_rd_off(D0, 1, 1)>(vb);
  const s16x4 l2 = tr_read<v_rd_off(D0, 2, 0)>(vb), h2 = tr_read<v_rd_off(D0, 2, 1)>(vb), l3 = tr_read<v_rd_off(D0, 3, 0)>(vb), h3 = tr_read<v_rd_off(D0, 3, 1)>(vb);
  asm volatile("s_waitcnt lgkmcnt(0)" ::: "memory"); SBAR();
#define PK(L, H) (bf16x8){L[0], L[1], L[2], L[3], H[0], H[1], H[2], H[3]}
  od = __builtin_amdgcn_mfma_f32_32x32x16_bf16(pa0, PK(l0, h0), od, 0, 0, 0);
  od = __builtin_amdgcn_mfma_f32_32x32x16_bf16(pa1, PK(l1, h1), od, 0, 0, 0);
  od = __builtin_amdgcn_mfma_f32_32x32x16_bf16(pa2, PK(l2, h2), od, 0, 0, 0);
  od = __builtin_amdgcn_mfma_f32_32x32x16_bf16(pa3, PK(l3, h3), od, 0, 0, 0);
#undef PK
}
template <int VAR = 0> __device__ __forceinline__ void pv_d0(f32x16* o, int vb, bf16x8 pa0, bf16x8 pa1, bf16x8 pa2, bf16x8 pa3) {
  if (VAR & 2) { asm volatile("" :: "v"(pa0), "v"(pa1), "v"(pa2), "v"(pa3)); return; }
  pv_one<0>(o[0], vb, pa0, pa1, pa2, pa3); pv_one<1>(o[1], vb, pa0, pa1, pa2, pa3); pv_one<2>(o[2], vb, pa0, pa1, pa2, pa3); pv_one<3>(o[3], vb, pa0, pa1, pa2, pa3);
}
struct VPre { s16x4 l0, h0, l1, h1; };
__device__ __forceinline__ void pv_load0(VPre& v, int vb) {
  v.l0 = tr_read<v_rd_off(0, 0, 0)>(vb); v.h0 = tr_read<v_rd_off(0, 0, 1)>(vb); v.l1 = tr_read<v_rd_off(0, 1, 0)>(vb); v.h1 = tr_read<v_rd_off(0, 1, 1)>(vb);
}
template <int VAR = 0> __device__ __forceinline__ void pv_d0p(f32x16* o, int vb, const VPre& v, bf16x8 pa0, bf16x8 pa1, bf16x8 pa2, bf16x8 pa3) {
  if (VAR & 2) { asm volatile("" :: "v"(pa0), "v"(pa1), "v"(pa2), "v"(pa3)); return; }
  const s16x4 l2 = tr_read<v_rd_off(0, 2, 0)>(vb), h2 = tr_read<v_rd_off(0, 2, 1)>(vb), l3 = tr_read<v_rd_off(0, 3, 0)>(vb), h3 = tr_read<v_rd_off(0, 3, 1)>(vb);
  asm volatile("s_waitcnt lgkmcnt(4)" ::: "memory"); SBAR();
#define PK(L, H) (bf16x8){L[0], L[1], L[2], L[3], H[0], H[1], H[2], H[3]}
  o[0] = __builtin_amdgcn_mfma_f32_32x32x16_bf16(pa0, PK(v.l0, v.h0), o[0], 0, 0, 0);
  o[0] = __builtin_amdgcn_mfma_f32_32x32x16_bf16(pa1, PK(v.l1, v.h1), o[0], 0, 0, 0);
  asm volatile("s_waitcnt lgkmcnt(0)" ::: "memory"); SBAR();
  o[0] = __builtin_amdgcn_mfma_f32_32x32x16_bf16(pa2, PK(l2, h2), o[0], 0, 0, 0);
  o[0] = __builtin_amdgcn_mfma_f32_32x32x16_bf16(pa3, PK(l3, h3), o[0], 0, 0, 0);
#undef PK
  pv_one<1>(o[1], vb, pa0, pa1, pa2, pa3); pv_one<2>(o[2], vb, pa0, pa1, pa2, pa3); pv_one<3>(o[3], vb, pa0, pa1, pa2, pa3);
}
__device__ __forceinline__ float bf2f(unsigned short u) { return __uint_as_float((unsigned)u << 16); }
__device__ __forceinline__ unsigned short f2bf(float f) { unsigned u = __float_as_uint(f); return (unsigned short)((u + 0x7fffu + ((u >> 16) & 1u)) >> 16); }

template <int VAR = 0> __device__ __forceinline__ void diff_unit(const bf16r* __restrict__ Qb, const bf16r* __restrict__ Kh, const bf16r* __restrict__ Vh, const bf16r* __restrict__ Gb,
                                          bf16r* __restrict__ Ob, float lam, const float* __restrict__ nw, float nwscale, char* lds, int wave_s,
                                          const bf16r* Qn, const bf16r* Kn, const bf16r* Vn, bool pre, bf16x8 (&qr)[4]) {
  int tid_ = wave_s * 64 + lane_id_opaque(); asm volatile("" : "+v"(tid_));
  const int tid = tid_, wid = tid >> 6, lane = tid & 63, r32 = lane & 31, hi = lane >> 5;
  const int mp = wid >> 2, rg = wid & 3;
  char* K_lds = lds; char* V_lds = lds + VRING;
  float* ws = (float*)(lds + SHM_WS) + wid * 64; float* li_l = ws; float* al_l = ws + 32;
  float l_reg = 0; f32x16 o[4] = {}; f32x16 negm = {};
  const long qoff = (long)(rg * QBLK + r32) * LDP + mp * 64 + hi * 8;
  if (!pre) {
#pragma unroll
    for (int d0 = 0; d0 < 4; ++d0) qr[d0] = *(const __attribute__((address_space(1))) bf16x8*)(Qb + qoff + d0 * 16); }
  const int colb0 = mp * 128;
  const int vb0 = (int)(uintptr_t)V_lds + v_rd_base(lane);
  unsigned ksrc[2], vsrc[2];
#pragma unroll
  for (int i = 0; i < 2; ++i) { const int q = 2 * wave_s + i;
    { const int row = 4 * q + (lane >> 4), slot = lane & 15; const int colB = (slot * 16) ^ (((row & 7) << 4) | (((row >> 3) & 1) << 7)); ksrc[i] = (unsigned)(row * LDP + colB / 2) * 2u; }
    { const int sub = 2 * q + (lane >> 5), kk = (sub >> 2) * 8 + ((lane & 31) >> 2), key = kk, col = (sub & 3) * 32 + 8 * (lane & 3); vsrc[i] = (unsigned)(key * LDP + col) * 2u; } }
  int kslot = 0, vslot = 0;
#define DMA16(ldsaddr, voff, gbase) do { unsigned m0v_ = (ldsaddr); unsigned long long gb_ = (unsigned long long)(gbase); asm volatile("s_mov_b32 m0, %0\n\ts_nop 0\n\tglobal_load_lds_dwordx4 %1, %2" :: "s"(m0v_), "v"(voff), "s"(gb_) : "m0", "memory"); } while (0)
#define DMA_TILE(t) DMA_TILE_AT(Kh, Vh, t)
#define DMA_TILE_AT(KB_, VB_, t) do { if (VAR & 8) break; const int t_ = (t) < NT ? (t) : NT - 1; const bf16r* kg_ = (KB_) + (long)t_ * KVBLK * LDP; const bf16r* vg_ = (VB_) + (long)t_ * KVBLK * LDP; \
    _Pragma("unroll") for (int i_ = 0; i_ < 2; ++i_) { \
      DMA16((unsigned)(uintptr_t)K_lds + (unsigned)(kslot + (2 * wave_s + i_) * 1024), ksrc[i_], kg_); \
      DMA16((unsigned)(uintptr_t)V_lds + (unsigned)(vslot + (2 * wave_s + i_) * 1024), vsrc[i_], vg_); } \
    kslot = kslot == (NKSLOT - 1) * TILE_B ? 0 : kslot + TILE_B; vslot = vslot == (NVSLOT - 1) * TILE_B ? 0 : vslot + TILE_B; } while (0)
#define LAND_BAR() do { if (VAR & 64) asm volatile("s_waitcnt lgkmcnt(0)" ::: "memory"); else asm volatile("s_waitcnt vmcnt(4) lgkmcnt(0)" ::: "memory"); if (!(VAR & 16)) __builtin_amdgcn_s_barrier(); asm volatile("" ::: "memory"); } while (0)
#define RESC(a) do { if (__any((a) < 1.f)) { if (hi == 0) al_l[r32] = (a); asm volatile("s_waitcnt lgkmcnt(0)" ::: "memory"); \
    _Pragma("unroll") for (int d = 0; d < 4; ++d) _Pragma("unroll") for (int r = 0; r < 16; ++r) o[d][r] *= al_l[crow(r, hi)]; } } while (0)
  f32x16 pA0, pA1, pB0, pB1; float alA, alB; bf16x8 pa0, pa1, pa2, pa3; const int NT = SEQ / KVBLK;
  int kr = 0, vr = 0;
#define ADV_K() do { kr = kr == (NKSLOT - 1) * TILE_B ? 0 : kr + TILE_B; } while (0)
#define ADV_V() do { vr = vr == (NVSLOT - 1) * TILE_B ? 0 : vr + TILE_B; } while (0)
  if (pre) { kslot = TILE_B; vslot = TILE_B; } else DMA_TILE(0);
  DMA_TILE(1); LAND_BAR();
  if (mp == 0 || PP_OFF) {
  qkt<VAR>(pA0, pA1, K_lds + kr, qr, r32, hi, colb0, negm); partialSM<VAR, true>(pA0, pA1, negm, alA); ADV_K();
  DMA_TILE(2); LAND_BAR();
  VPre vpre;
  for (int j = 1; j + 1 < NT; j += 2) {
    SBAR(); DMA_TILE(j + 2); SBAR();
    qkt<VAR>(pB0, pB1, K_lds + kr, qr, r32, hi, colb0, negm); pv_load0(vpre, vb0 + vr);
    finishSM<VAR>(pA0, pA1, alA, l_reg, pa0, pa1, pa2, pa3); SBAR();
    pv_d0p<VAR>(o, vb0 + vr, vpre, pa0, pa1, pa2, pa3); partialSM<VAR>(pB0, pB1, negm, alB);
    RESC(alB); LAND_BAR(); ADV_K(); ADV_V();
    SBAR(); DMA_TILE(j + 3); SBAR();
    qkt<VAR>(pA0, pA1, K_lds + kr, qr, r32, hi, colb0, negm); pv_load0(vpre, vb0 + vr);
    finishSM<VAR>(pB0, pB1, alB, l_reg, pa0, pa1, pa2, pa3); SBAR();
    pv_d0p<VAR>(o, vb0 + vr, vpre, pa0, pa1, pa2, pa3); partialSM<VAR>(pA0, pA1, negm, alA);
    RESC(alA); LAND_BAR(); ADV_K(); ADV_V();
  }
  SBAR(); qkt<VAR>(pB0, pB1, K_lds + kr, qr, r32, hi, colb0, negm);
  finishSM<VAR>(pA0, pA1, alA, l_reg, pa0, pa1, pa2, pa3); SBAR();
  pv_d0<VAR>(o, vb0 + vr, pa0, pa1, pa2, pa3); partialSM<VAR>(pB0, pB1, negm, alB); ADV_V();
  RESC(alB);
  finishSM<VAR>(pB0, pB1, alB, l_reg, pa0, pa1, pa2, pa3); SBAR();
  pv_d0<VAR>(o, vb0 + vr, pa0, pa1, pa2, pa3);
  } else {
  SBAR(); DMA_TILE(2); SBAR();
  qkt<VAR>(pA0, pA1, K_lds + kr, qr, r32, hi, colb0, negm); ADV_K(); LAND_BAR();
  SBAR(); DMA_TILE(3); SBAR();
  partialSM<VAR, true>(pA0, pA1, negm, alA);
  qkt<VAR>(pB0, pB1, K_lds + kr, qr, r32, hi, colb0, negm);
  finishSM<VAR>(pA0, pA1, alA, l_reg, pa0, pa1, pa2, pa3); ADV_K(); LAND_BAR();
  for (int j = 2; j < NT; j += 2) {
    SBAR(); DMA_TILE(j + 2); SBAR();
    pv_d0<VAR>(o, vb0 + vr, pa0, pa1, pa2, pa3); partialSM<VAR>(pB0, pB1, negm, alB); RESC(alB); ADV_V(); SBAR();
    qkt<VAR>(pA0, pA1, K_lds + kr, qr, r32, hi, colb0, negm);
    finishSM<VAR>(pB0, pB1, alB, l_reg, pa0, pa1, pa2, pa3); ADV_K(); LAND_BAR();
    SBAR(); DMA_TILE(j + 3); SBAR();
    pv_d0<VAR>(o, vb0 + vr, pa0, pa1, pa2, pa3); partialSM<VAR>(pA0, pA1, negm, alA); RESC(alA); ADV_V(); SBAR();
    qkt<VAR>(pB0, pB1, K_lds + kr, qr, r32, hi, colb0, negm);
    finishSM<VAR>(pA0, pA1, alA, l_reg, pa0, pa1, pa2, pa3); ADV_K();
    if (j + 2 < NT) LAND_BAR();
  }
  SBAR(); pv_d0<VAR>(o, vb0 + vr, pa0, pa1, pa2, pa3); partialSM<VAR>(pB0, pB1, negm, alB); RESC(alB); ADV_V();
  finishSM<VAR>(pB0, pB1, alB, l_reg, pa0, pa1, pa2, pa3); SBAR();
  pv_d0<VAR>(o, vb0 + vr, pa0, pa1, pa2, pa3);
  }
  asm volatile("s_waitcnt vmcnt(0)" ::: "memory");
#undef LAND_BAR
#undef ADV_K
#undef ADV_V
  if (hi == 0) li_l[r32] = l_reg; asm volatile("s_waitcnt lgkmcnt(0)" ::: "memory");
  float rli[16];
#pragma unroll
  for (int r = 0; r < 16; ++r) rli[r] = __builtin_amdgcn_rcpf(li_l[crow(r, hi)]);
  u32x4 gpre[4];
#pragma unroll
  for (int it = 0; it < 4; ++it) gpre[it] = *(const __attribute__((address_space(1))) u32x4*)(Gb + (long)(wid * 16 + it * 4 + (lane >> 4)) * LDP + (lane & 15) * 8);
  typedef float f32x4e __attribute__((ext_vector_type(4)));
  const int c0 = (lane & 15) * 8;
  const f32x4e w0 = *(const __attribute__((address_space(1))) f32x4e*)(nw + c0) * nwscale, w1 = *(const __attribute__((address_space(1))) f32x4e*)(nw + c0 + 4) * nwscale;
  __syncthreads();
  float* X = (float*)lds + rg * (16 * 4 * 64);
  float* Y = (float*)(lds + 65536);
  if (mp == 1) {
#pragma unroll
    for (int r = 0; r < 16; ++r)
#pragma unroll
      for (int d0 = 0; d0 < 4; ++d0) X[(r * 4 + d0) * 64 + lane] = o[d0][r] * rli[r];
  }
  __syncthreads();
  if (mp == 0) {
#pragma unroll
    for (int r = 0; r < 16; ++r)
#pragma unroll
      for (int d0 = 0; d0 < 4; ++d0) Y[(rg * QBLK + crow(r, hi)) * 128 + d0 * 32 + r32] = o[d0][r] * rli[r] - lam * X[(r * 4 + d0) * 64 + lane];
  }
  __syncthreads();
  if (Qn) {
#pragma unroll
    for (int d0 = 0; d0 < 4; ++d0) qr[d0] = *(const __attribute__((address_space(1))) bf16x8*)(Qn + qoff + d0 * 16);
    kslot = 0; vslot = 0; DMA_TILE_AT(Kn, Vn, 0); }
  {
#pragma unroll
    for (int it = 0; it < 4; ++it) { const int row = wid * 16 + it * 4 + (lane >> 4);
      const f32x4e a0 = *(const f32x4e*)(Y + row * 128 + c0), a1 = *(const f32x4e*)(Y + row * 128 + c0 + 4);
      float s = (a0[0] * a0[0] + a0[1] * a0[1]) + (a0[2] * a0[2] + a0[3] * a0[3]) + (a1[0] * a1[0] + a1[1] * a1[1]) + (a1[2] * a1[2] + a1[3] * a1[3]);
      s += xor_shfl<1>(s); s += xor_shfl<2>(s); s += xor_shfl<4>(s); s += xor_shfl<8>(s);
      const float rs = 1.f / sqrtf(s * (1.f / 128.f) + 1e-6f);
      const u32x4 gq = gpre[it];
      float gv[8];
#pragma unroll
      for (int e = 0; e < 4; ++e) { gv[2 * e] = __uint_as_float(gq[e] << 16); gv[2 * e + 1] = __uint_as_float(gq[e] & 0xffff0000u); }
      float ov[8];
#pragma unroll
      for (int e = 0; e < 8; ++e) { const float g = gv[e]; const float sg = g / (1.f + __expf(-g)); const float a = e < 4 ? a0[e] : a1[e - 4]; const float w = e < 4 ? w0[e] : w1[e - 4]; ov[e] = a * rs * w * sg; }
      u32x4 ow; ow[0] = cvtpk(ov[0], ov[1]); ow[1] = cvtpk(ov[2], ov[3]); ow[2] = cvtpk(ov[4], ov[5]); ow[3] = cvtpk(ov[6], ov[7]);
      *(__attribute__((address_space(1))) u32x4*)(Ob + (long)row * 1024 + c0) = ow; }
  }
  asm volatile("s_waitcnt lgkmcnt(0)" ::: "memory"); __builtin_amdgcn_s_barrier(); asm volatile("" ::: "memory");
#undef RESC
#undef DMA_TILE
#undef DMA_TILE_AT
#undef DMA16
}
#undef KSWZ
#undef SBAR
}
#define GAS __attribute__((address_space(1)))
#define LAS __attribute__((address_space(3)))
typedef unsigned short bf16;
typedef unsigned v4u __attribute__((ext_vector_type(4)));
typedef float f32x4 __attribute__((ext_vector_type(4)));
typedef short bf16x8 __attribute__((ext_vector_type(8)));
constexpr int NWAVES = 8;
constexpr int BATCH = 16, SEQ = 2048, DM = 1024, DEPTH = 4, M = BATCH * SEQ;
constexpr int IN_W = 4128, NP = 4096, NPA = 4128;
constexpr float EPS = 1e-6f;
constexpr int PQ_GQ = 0, PQ_GK = 128, PQ_GV = 256, PQ_GG = 512, PQ_DQ = 768, PQ_DK = 1280, PQ_DV = 1792, PQ_DG = 2304, PQ_HQ = 2816;
__host__ __device__ constexpr int col_hzf(int h) { return 3072 + (h >> 1) * 256 + (h & 1) * 64; }
__host__ __device__ constexpr int col_hi(int h) { return col_hzf(h) + 128; }
__host__ __device__ constexpr int col_hzb(int h) { return 3584 + (h >> 1) * 256 + (h & 1) * 64; }
__host__ __device__ constexpr int col_hg(int h) { return col_hzb(h) + 128; }
constexpr size_t MiB = 1u << 20;
constexpr size_t WS_CTL = 0;
constexpr size_t WS_WIN = 1 * MiB;
constexpr size_t WS_WOUT = WS_WIN + (size_t)4 * 4128 * 1024 * 2;
constexpr size_t WS_ROPE = WS_WOUT + 8 * MiB;
constexpr size_t WS_LB = WS_ROPE + 512 * 1024;
constexpr size_t WS_A = WS_LB + 65536;
constexpr size_t WS_RSTD = WS_CTL + 256 * 1024;
constexpr size_t WS_H = 46 * MiB;
constexpr size_t WS_MIX = 110 * MiB;
constexpr size_t WS_PROJ = 174 * MiB;
constexpr size_t WS_Y = WS_PROJ;
constexpr size_t WS_OSC0 = WS_H;
constexpr size_t WS_OSC1 = WS_H + 32 * MiB;
constexpr size_t WS_XB = 430 * MiB;
constexpr size_t WS_END = 494 * MiB;
static_assert(WS_A + (size_t)M * 32 * 4 <= WS_H, "ws map");
constexpr int LDS_BYTES = 147456;

__device__ __forceinline__ float bf2f(unsigned short u) { return __uint_as_float((unsigned)u << 16); }
__device__ __forceinline__ unsigned f2bf(float f) { unsigned u = __float_as_uint(f); return (u + 0x7fffu + ((u >> 16) & 1u)) >> 16; }
__device__ __forceinline__ unsigned pk2(float lo, float hi) { return f2bf(lo) | (f2bf(hi) << 16); }
__device__ __forceinline__ float wave_sum(float v) {
    v += xor_shfl<1>(v); v += xor_shfl<2>(v); v += xor_shfl<4>(v); v += xor_shfl<8>(v); v += xor_shfl<16>(v); v += xor_shfl<32>(v);
    return v;
}
#define LDS_WAIT() asm volatile("s_waitcnt lgkmcnt(0)" ::: "memory")
#define VM_WAIT() asm volatile("s_waitcnt vmcnt(0)" ::: "memory")

struct Args {
    const float* x; const float* norm_pre; const float* norm_post; const float* w_in; const float* w_out;
    const float* gla_wa2_f; const float* gla_ba_f; const float* gla_wa2_b; const float* gla_ba_b; const float* gla_norm;
    const float* lq1; const float* lk1; const float* lq2; const float* lk2; const float* diff_norm; const float* lb_logits; const float* hgrn_norm;
    float* out; unsigned char* ws; int ph_lo, ph_hi, rep, pad;
};
struct Frame { LAS unsigned char* lds; int tid, lane, wave, vcu, G; };

__device__ __forceinline__ int src_col(int p) {
    if (p >= NP) return 768 + (p - NP);
    if (p < 768) return p;
    if (p < 1792) { const int base = p & ~63, e = p & 63, j8 = e >> 3, e8 = e & 7; const int d = (e8 < 4) ? 4 * j8 + e8 : 32 + 4 * j8 + (e8 - 4); return base + d + 32; }
    if (p < 3072) return p + 32;
    { const int t = (p - 3072) >> 8, w = (p - 3072) & 255, half = w >> 7, h = (t & 1) * 2 + ((w & 127) >> 6), k = w & 63;
      const int base = (t < 2) ? (half ? 3616 : 3104) : (half ? 3872 : 3360); return base + h * 64 + k; }
}
__device__ __forceinline__ void transpose_load(float (&wv)[32], const float* W, int srcN, bool remap, int kb, int nb, int lane) {
    const int k0 = 64 * kb, n0 = 32 * nb; const int sc = remap ? src_col(n0 + (lane & 31)) : n0 + (lane & 31);
#pragma unroll
    for (int i = 0; i < 32; ++i) { const int kk = 2 * i + (lane >> 5); wv[i] = __builtin_nontemporal_load((const GAS float*)(W + (size_t)(k0 + kk) * srcN + sc)); }
}
__device__ __forceinline__ void transpose_store(float (&wv)[32], bf16* WT, LAS float* scr, int kb, int nb, int lane, const float* kscale) {
    const int k0 = 64 * kb, n0 = 32 * nb;
    if (kscale) {
#pragma unroll
        for (int i = 0; i < 32; ++i) { const int kk = 2 * i + (lane >> 5); wv[i] *= *(const GAS float*)(kscale + k0 + kk); } }
#pragma unroll
    for (int i = 0; i < 32; ++i) { const int kk = 2 * i + (lane >> 5); scr[kk * 33 + (lane & 31)] = wv[i]; }
    LDS_WAIT(); asm volatile("" ::: "memory");
    const int c = lane & 7;
#pragma unroll
    for (int j = 0; j < 4; ++j) { const int n = (lane >> 3) + 8 * j; const LAS float* s = scr + (8 * c) * 33 + n;
        v4u o; o.x = pk2(s[0 * 33], s[1 * 33]); o.y = pk2(s[2 * 33], s[3 * 33]); o.z = pk2(s[4 * 33], s[5 * 33]); o.w = pk2(s[6 * 33], s[7 * 33]);
        *(GAS v4u*)(WT + (size_t)(n0 + n) * DM + k0 + 8 * c) = o; }
    LDS_WAIT(); asm volatile("" ::: "memory");
}
__device__ __forceinline__ void row_to_bf16_rstd(const f32x4 (&v)[4], bf16* orow, float* rstd, int lane) {
    float s = 0.f;
#pragma unroll
    for (int j = 0; j < 4; ++j) s += (v[j].x * v[j].x + v[j].y * v[j].y) + (v[j].z * v[j].z + v[j].w * v[j].w);
    const float r = 1.f / sqrtf(wave_sum(s) * (1.f / DM) + EPS);
    GAS unsigned long long* o8 = (GAS unsigned long long*)orow + lane;
#pragma unroll
    for (int j = 0; j < 4; ++j) o8[64 * j] = (unsigned long long)pk2(v[j].x, v[j].y) | ((unsigned long long)pk2(v[j].z, v[j].w) << 32);
    if (lane == 0) *(GAS float*)rstd = r;
}

__device__ __forceinline__ void p0_prologue(const Frame& F, const Args& a, int parts) {
    LAS float* scr = (LAS float*)(F.lds + F.wave * 16384);
    const int gw = F.vcu * NWAVES + F.wave, NGW = F.G * NWAVES;
    bf16* WinT = (bf16*)(a.ws + WS_WIN); bf16* WoutT = (bf16*)(a.ws + WS_WOUT);
    constexpr int I_IN = 16 * (NPA / 32), I_OUT = 16 * 32;
    constexpr int NITEMS = DEPTH * (I_IN + I_OUT);
    if (parts & 1) {
        auto item_load = [&](int it, float (&wv)[32]) { const int l = it / (I_IN + I_OUT); int r = it % (I_IN + I_OUT);
            if (r < I_IN) transpose_load(wv, a.w_in + (size_t)l * DM * IN_W, IN_W, true, r / (NPA / 32), r % (NPA / 32), F.lane);
            else { r -= I_IN; transpose_load(wv, a.w_out + (size_t)l * DM * DM, DM, false, r / 32, r % 32, F.lane); } };
        auto item_store = [&](int it, float (&wv)[32]) { const int l = it / (I_IN + I_OUT); int r = it % (I_IN + I_OUT);
            if (r < I_IN) transpose_store(wv, WinT + (size_t)l * NPA * DM, scr, r / (NPA / 32), r % (NPA / 32), F.lane, a.norm_pre + l * DM);
            else { r -= I_IN; transpose_store(wv, WoutT + (size_t)l * DM * DM, scr, r / 32, r % 32, F.lane, nullptr); } };
        float wa[32], wb[32]; int it = gw;
        if (it < NITEMS) item_load(it, wa);
        while (it < NITEMS) {
            const int i1 = it + NGW; if (i1 < NITEMS) item_load(i1, wb);
            item_store(it, wa); if (i1 >= NITEMS) break;
            const int i2 = i1 + NGW; if (i2 < NITEMS) item_load(i2, wa);
            item_store(i1, wb); it = i2;
        }
    }
    if (!(parts & 2)) return;
    float* cosT = (float*)(a.ws + WS_ROPE); float* sinT = cosT + SEQ * 32;
    for (int e = gw * 64 + F.lane; e < SEQ * 32; e += NGW * 64) { const int pos = e >> 5, i = e & 31;
        const float inv = __builtin_amdgcn_exp2f(-(float)i * (13.287712379549449f / 32.f));
        const float ang = (float)pos * inv; float rev = ang * 0.15915494309189535f; rev = rev - floorf(rev);
        cosT[e] = __builtin_amdgcn_cosf(rev); sinT[e] = __builtin_amdgcn_sinf(rev); }
    float* LB = (float*)(a.ws + WS_LB);
    for (int e = gw * 64 + F.lane; e < 256; e += NGW * 64) { float lg[DEPTH], mx = -1e30f;
#pragma unroll
        for (int l = 0; l < DEPTH; ++l) { lg[l] = a.lb_logits[l * 256 + e]; mx = fmaxf(mx, lg[l]); }
        float sum = 0.f;
#pragma unroll
        for (int l = 0; l < DEPTH; ++l) { lg[l] = expf(lg[l] - mx); sum += lg[l]; }
        float cum = 0.f; LB[e] = 0.f;
#pragma unroll
        for (int l = 1; l < DEPTH; ++l) { cum += lg[l] / sum; LB[l * 256 + e] = cum; } }
    bf16* H = (bf16*)(a.ws + WS_XB); float* RS = (float*)(a.ws + WS_RSTD);
    for (int m0 = 4 * gw; m0 < M; m0 += 4 * NGW) { f32x4 v[4][4];
#pragma unroll
        for (int t = 0; t < 4; ++t) { const GAS f32x4* xr = (const GAS f32x4*)(a.x + (size_t)(m0 + t) * DM) + F.lane;
#pragma unroll
            for (int j = 0; j < 4; ++j) v[t][j] = __builtin_nontemporal_load(xr + 64 * j); }
#pragma unroll
        for (int t = 0; t < 4; ++t) row_to_bf16_rstd(v[t], H + (size_t)(m0 + t) * DM, RS + m0 + t, F.lane); }
}

__device__ __forceinline__ void lowrank_phase(const Frame& F, const Args& a, int layer) {
    typedef float f32x4v __attribute__((ext_vector_type(4)));
    const bf16* H = (const bf16*)(a.ws + WS_XB); const bf16* Wa = (const bf16*)(a.ws + WS_WIN) + ((size_t)layer * NPA + NP) * DM; float* A = (float*)(a.ws + WS_A); const float* RS = (const float*)(a.ws + WS_RSTD);
    const int gw = F.vcu * NWAVES + F.wave, NGW = F.G * NWAVES, lane = F.lane;
    for (int u = gw; u < M / 16; u += NGW) {
        const bf16* ap = H + (size_t)(u * 16 + (lane & 15)) * DM + 8 * (lane >> 4);
        const bf16* b0 = Wa + (size_t)(lane & 15) * DM + 8 * (lane >> 4); const bf16* b1 = b0 + 16 * DM;
        f32x4v c0 = {0.f, 0.f, 0.f, 0.f}, c1 = {0.f, 0.f, 0.f, 0.f};
#pragma unroll 16
        for (int ks = 0; ks < 32; ++ks) { const bf16x8 av = *(const GAS bf16x8*)(ap + ks * 32), bv0 = *(const GAS bf16x8*)(b0 + ks * 32), bv1 = *(const GAS bf16x8*)(b1 + ks * 32);
            c0 = __builtin_amdgcn_mfma_f32_16x16x32_bf16(av, bv0, c0, 0, 0, 0); c1 = __builtin_amdgcn_mfma_f32_16x16x32_bf16(av, bv1, c1, 0, 0, 0); }
#pragma unroll
        for (int r = 0; r < 4; ++r) { const int row = u * 16 + 4 * (lane >> 4) + r; const float rs = *(const GAS float*)(RS + row); GAS float* o = (GAS float*)(A + (size_t)row * 32 + (lane & 15)); o[0] = c0[r] * rs; o[16] = c1[r] * rs; }
    }
}

__device__ __forceinline__ void postnorm_rows(const Frame& F, const Args& a, int layer, int gw, int NGW, int row_base, int nrows, bool dry = false) {
    const bf16* Y = (const bf16*)(a.ws + WS_Y); float* RS = (float*)(a.ws + (dry ? WS_PROJ + 128 * MiB : WS_RSTD)); const bf16* XBr = (const bf16*)(a.ws + WS_XB); bf16* XB = (bf16*)(a.ws + (dry ? WS_MIX : WS_XB));
    float* outp = dry ? (float*)(a.ws + WS_PROJ + 128 * MiB) : a.out;
    const float* wpost = a.norm_post + layer * DM;
    const int lane = F.lane;
    const bool first = layer == 0, last = layer + 1 == DEPTH;
    f32x4 wp[4];
#pragma unroll
    for (int j = 0; j < 4; ++j) { const int c = (j >> 1) * 512 + 8 * lane + 4 * (j & 1); wp[j] = *(const GAS f32x4*)(wpost + c); }
    constexpr int RPW = 4;
    for (int m0 = row_base + RPW * gw; m0 < row_base + nrows; m0 += RPW * NGW) {
        v4u yr[RPW][2]; f32x4 x[RPW][4];
#pragma unroll
        for (int t = 0; t < RPW; ++t) { const size_t m = (size_t)m0 + t;
#pragma unroll
            for (int hf = 0; hf < 2; ++hf) yr[t][hf] = __builtin_nontemporal_load((const GAS v4u*)(Y + m * DM + hf * 512 + 8 * lane));
            if (first) {
#pragma unroll
                for (int j = 0; j < 4; ++j) x[t][j] = __builtin_nontemporal_load((const GAS f32x4*)(a.x + m * DM + (j >> 1) * 512 + 8 * lane + 4 * (j & 1)));
            } else {
#pragma unroll
                for (int hf = 0; hf < 2; ++hf) { const v4u xr = __builtin_nontemporal_load((const GAS v4u*)(XBr + m * DM + hf * 512 + 8 * lane));
                    x[t][2 * hf] = (f32x4){__uint_as_float(xr.x << 16), __uint_as_float(xr.x & 0xffff0000u), __uint_as_float(xr.y << 16), __uint_as_float(xr.y & 0xffff0000u)};
                    x[t][2 * hf + 1] = (f32x4){__uint_as_float(xr.z << 16), __uint_as_float(xr.z & 0xffff0000u), __uint_as_float(xr.w << 16), __uint_as_float(xr.w & 0xffff0000u)}; }
            } }
#pragma unroll
        for (int t = 0; t < RPW; ++t) { const size_t m = (size_t)m0 + t;
            f32x4 y[4]; float s = 0.f;
#pragma unroll
            for (int j = 0; j < 4; ++j) { const unsigned w0 = yr[t][j >> 1][2 * (j & 1)], w1 = yr[t][j >> 1][2 * (j & 1) + 1];
                y[j] = (f32x4){__uint_as_float(w0 << 16), __uint_as_float(w0 & 0xffff0000u), __uint_as_float(w1 << 16), __uint_as_float(w1 & 0xffff0000u)};
                s += (y[j].x * y[j].x + y[j].y * y[j].y) + (y[j].z * y[j].z + y[j].w * y[j].w); }
            const float r = 1.f / sqrtf(wave_sum(s) * (1.f / DM) + EPS);
            float s2 = 0.f;
#pragma unroll
            for (int j = 0; j < 4; ++j) { x[t][j] = x[t][j] + y[j] * r * wp[j];
                if (last) __builtin_nontemporal_store(x[t][j], (GAS f32x4*)(outp + m * DM + (j >> 1) * 512 + 8 * lane + 4 * (j & 1)));
                s2 += (x[t][j].x * x[t][j].x + x[t][j].y * x[t][j].y) + (x[t][j].z * x[t][j].z + x[t][j].w * x[t][j].w); }
            if (!last) { const float r2 = 1.f / sqrtf(wave_sum(s2) * (1.f / DM) + EPS);
#pragma unroll
                for (int hf = 0; hf < 2; ++hf) { const f32x4 b0 = x[t][2 * hf], b1 = x[t][2 * hf + 1];
                    v4u ox; ox.x = pk2(b0.x, b0.y); ox.y = pk2(b0.z, b0.w); ox.z = pk2(b1.x, b1.y); ox.w = pk2(b1.z, b1.w);
                    *(GAS v4u*)(XB + m * DM + hf * 512 + 8 * lane) = ox; }
                if (lane == 0) *(GAS float*)(RS + m) = r2; }
        }
    }
}
__device__ __forceinline__ void postnorm_phase(const Frame& F, const Args& a, int layer, bool dry = false) { postnorm_rows(F, a, layer, F.vcu * NWAVES + F.wave, F.G * NWAVES, 0, M, dry); }
#define XB_TMO      128
#define XB_XCNT(j)  (256  + 64 * (j))
#define XB_XSUB(j)  (1280 + 64 * (j))
#define XB_XGEN(j)  (2304 + 64 * (j))
#define XB_TOP      3328
#define XB_TOPGEN   3392
#define XCD_BAR_WORDS 3456
#define XB_SPIN_CAP (1u << 18)

__device__ __forceinline__ unsigned xb_ld(unsigned* p)              { return __hip_atomic_load(p, __ATOMIC_RELAXED, __HIP_MEMORY_SCOPE_AGENT); }
__device__ __forceinline__ unsigned xb_add(unsigned* p, unsigned v) { return __hip_atomic_fetch_add(p, v, __ATOMIC_RELAXED, __HIP_MEMORY_SCOPE_AGENT); }
__device__ __forceinline__ unsigned xb_xcc_id() { return (unsigned)__builtin_amdgcn_s_getreg((3 << 11) | 20) & 0xFu; }
#define XB_SPIN(cond, bar) do { unsigned _sp = 0; while (cond) { __builtin_amdgcn_s_sleep(1); \
    if ((++_sp & 255u) == 0u) { if (xb_ld(&(bar)[XB_TMO])) break; if (_sp > XB_SPIN_CAP) { atomicAdd(&(bar)[XB_TMO], 1u); break; } } } } while (0)

struct XcdBarrier {
    unsigned* bar; unsigned x;
    volatile LAS unsigned* st;
};

__device__ __forceinline__ XcdBarrier xcd_barrier_post(unsigned* bar, volatile LAS unsigned* st) {
    XcdBarrier b; b.bar = bar; b.x = xb_xcc_id(); b.st = st;
    if (threadIdx.x == 0) (void)xb_add(&bar[XB_XCNT(b.x)], 1u);
    return b;
}
__device__ __forceinline__ void xcd_barrier_complete(unsigned* bar, unsigned x, unsigned& nloc, unsigned& nx) {
    const unsigned G = gridDim.x * gridDim.y * gridDim.z;
    unsigned sum, cnt, mine, sp = 0u;
    for (;;) {
        sum = 0u; cnt = 0u; mine = 0u;
#pragma unroll
        for (unsigned j = 0; j < 16; ++j) { const unsigned c = xb_ld(&bar[XB_XCNT(j)]); sum += c; cnt += (c > 0u) ? 1u : 0u; mine = (j == x) ? c : mine; }
        if (sum == G) break;
        __builtin_amdgcn_s_sleep(1);
        if ((++sp & 255u) == 0u) { if (xb_ld(&bar[XB_TMO])) break; if (sp > XB_SPIN_CAP) { atomicAdd(&bar[XB_TMO], 1u); break; } }
    }
    nloc = mine > 0u ? mine : 1u; nx = cnt > 0u ? cnt : 1u;
}

__device__ __forceinline__ void xcd_barrier(const XcdBarrier& b) {
    asm volatile("s_waitcnt vmcnt(0)" ::: "memory");
    __syncthreads();
    if (threadIdx.x == 0) {
        unsigned* bar = b.bar;
        __builtin_amdgcn_s_waitcnt(0);
        unsigned nloc = b.st[0], nx = b.st[1];
        if (nloc == 0u) { xcd_barrier_complete(bar, b.x, nloc, nx); b.st[0] = nloc; b.st[1] = nx; }
        const unsigned old = xb_add(&bar[XB_XSUB(b.x)], 1u);
        const unsigned gen = old / nloc;
        if (old + 1u == (gen + 1u) * nloc) {
            __builtin_amdgcn_fence(__ATOMIC_RELEASE, "agent");
            asm volatile("s_waitcnt vmcnt(0)" ::: "memory");
            const unsigned og = xb_add(&bar[XB_TOP], 1u);
            const unsigned tg = og / nx;
            if (og + 1u == (tg + 1u) * nx) xb_add(&bar[XB_TOPGEN], 1u);
            else XB_SPIN(xb_ld(&bar[XB_TOPGEN]) == tg, bar);
            __builtin_amdgcn_fence(__ATOMIC_ACQUIRE, "agent");
            xb_add(&bar[XB_XGEN(b.x)], 1u);
            asm volatile("s_waitcnt vmcnt(0)" ::: "memory");
        } else {
            XB_SPIN(xb_ld(&bar[XB_XGEN(b.x)]) == gen, bar);
            __builtin_amdgcn_fence(__ATOMIC_ACQUIRE, "agent");
            asm volatile("s_waitcnt vmcnt(0)" ::: "memory");
        }
    }
    __syncthreads();
}
namespace scan {
typedef float f32x16 __attribute__((ext_vector_type(16)));
typedef float f32x4s __attribute__((ext_vector_type(4)));
typedef short bf16x8s __attribute__((ext_vector_type(8)));
typedef short s16x4s __attribute__((ext_vector_type(4)));
typedef unsigned u32x4s __attribute__((ext_vector_type(4)));
typedef unsigned u32x2s __attribute__((ext_vector_type(2)));
constexpr int CH = 32, SEGT = 256, NCH = SEGT / CH;
constexpr int WAVE_LDS = 15360;
constexpr int PT = 72, PTB = PT * 2;
constexpr size_t OSC_UNIT = (size_t)64 * 16 * 64 * 4;
__device__ __forceinline__ int crow(int r, int hi) { return (r & 3) + 8 * (r >> 2) + 4 * hi; }
__device__ __forceinline__ unsigned cvtpk(float lo, float hi) { unsigned r; asm volatile("v_cvt_pk_bf16_f32 %0, %1, %2" : "=v"(r) : "v"(lo), "v"(hi)); return r; }
__device__ __forceinline__ float other_half(float x, int hh) { auto rr = __builtin_amdgcn_permlane32_swap(__float_as_uint(x), __float_as_uint(x), false, false); return __uint_as_float(hh ? rr[0] : rr[1]); }
typedef short v4i16_t __attribute__((ext_vector_type(4)));
__device__ __forceinline__ s16x4s trd(LAS const unsigned char* p) { return __builtin_bit_cast(s16x4s, __builtin_amdgcn_ds_read_tr16_b64_v4i16((LAS v4i16_t*)p)); }
#define SC_STEP(N) "v_add_f32_dpp %0, %0, %0 row_shr:" #N " row_mask:0xa bank_mask:0xf bound_ctrl:1\n\tv_add_f32_dpp %1, %1, %1 row_shr:" #N " row_mask:0xa bank_mask:0xf bound_ctrl:1\n\t" \
                   "v_add_f32_dpp %2, %2, %2 row_shr:" #N " row_mask:0xa bank_mask:0xf bound_ctrl:1\n\tv_add_f32_dpp %3, %3, %3 row_shr:" #N " row_mask:0xa bank_mask:0xf bound_ctrl:1\n\t" \
                   "v_add_f32_dpp %0, %0, %0 row_shl:" #N " row_mask:0x5 bank_mask:0xf bound_ctrl:1\n\tv_add_f32_dpp %1, %1, %1 row_shl:" #N " row_mask:0x5 bank_mask:0xf bound_ctrl:1\n\t" \
                   "v_add_f32_dpp %2, %2, %2 row_shl:" #N " row_mask:0x5 bank_mask:0xf bound_ctrl:1\n\tv_add_f32_dpp %3, %3, %3 row_shl:" #N " row_mask:0x5 bank_mask:0xf bound_ctrl:1\n\t"
__device__ __forceinline__ void rowscan4(float& a, float& b, float& c, float& d) {
    asm volatile("s_nop 1\n\t" SC_STEP(1) SC_STEP(2) SC_STEP(4) SC_STEP(8) "s_nop 1" : "+v"(a), "+v"(b), "+v"(c), "+v"(d));
}
#undef SC_STEP
__device__ __forceinline__ void tri_frags(bf16x8s (&T)[2], int r, int hh) {
    const bool row1 = (r & 16) != 0;
#pragma unroll
    for (int ss = 0; ss < 2; ++ss) { u32x4s t;
#pragma unroll
        for (int jj = 0; jj < 4; ++jj) { const int k0 = 16 * ss + 4 * hh + ((2 * jj) & 3) + 8 * ((2 * jj) >> 2), k1 = k0 + 1;
            const bool i0 = row1 ? (k0 >= 16 && k0 <= r) : (k0 >= r && k0 <= 15), i1 = row1 ? (k1 >= 16 && k1 <= r) : (k1 >= r && k1 <= 15);
            t[jj] = (i0 ? 0x3F80u : 0u) | (i1 ? 0x3F800000u : 0u); }
        T[ss] = __builtin_bit_cast(bf16x8s, t); }
}
template <int DIR> __device__ __forceinline__ void te_frags(bf16x8s (&TE)[2], bf16x8s (&TI)[2], int r, int hh) {
    const bool row1 = (r & 16) != 0;
#pragma unroll
    for (int ss = 0; ss < 2; ++ss) { u32x4s te, ti;
#pragma unroll
        for (int jj = 0; jj < 4; ++jj) { unsigned we = 0u, wi = 0u;
#pragma unroll
            for (int q = 0; q < 2; ++q) { const int k = 16 * ss + 4 * hh + ((2 * jj) & 3) + 8 * ((2 * jj) >> 2) + q;
                unsigned ce;
                if (DIR == 0) ce = row1 ? ((k >= 16 && k <= r) ? 0x3F80u : 0u) : ((k > r && k <= 15) ? 0xBF80u : 0u);
                else          ce = row1 ? ((k >= 16 && k < r) ? 0xBF80u : 0u) : ((k >= r && k <= 15) ? 0x3F80u : 0u);
                we |= ce << (16 * q); wi |= ((k == r) ? 0x3F80u : 0u) << (16 * q); }
            te[jj] = we; ti[jj] = wi; }
        TE[ss] = __builtin_bit_cast(bf16x8s, te); TI[ss] = __builtin_bit_cast(bf16x8s, ti); }
}
__device__ __forceinline__ void tri_ex(LAS const unsigned char* TK, int tb, int kb, const bf16x8s (&TE)[2], const bf16x8s (&TI)[2], f32x16& E, f32x16& X) {
    E = f32x16{}; X = f32x16{};
#pragma unroll
    for (int ss = 0; ss < 2; ++ss) { const s16x4s lo = trd(TK + tb + (16 * ss) * PTB + 64 * kb), hi = trd(TK + tb + (16 * ss + 8) * PTB + 64 * kb);
        const bf16x8s g = (bf16x8s){lo[0], lo[1], lo[2], lo[3], hi[0], hi[1], hi[2], hi[3]};
        E = __builtin_amdgcn_mfma_f32_32x32x16_bf16(g, TE[ss], E, 0, 0, 0); X = __builtin_amdgcn_mfma_f32_32x32x16_bf16(g, TI[ss], X, 0, 0, 0); }
}
template <int DIR> __device__ __forceinline__ void l1_frags(bf16x8s (&TF)[2], bf16x8s (&TI)[2], int r, int hh) {
#pragma unroll
    for (int ss = 0; ss < 2; ++ss) { u32x4s tf, ti;
#pragma unroll
        for (int jj = 0; jj < 4; ++jj) { unsigned wf = 0u, wi = 0u;
#pragma unroll
            for (int q = 0; q < 2; ++q) { const int k = 16 * ss + 4 * hh + ((2 * jj) & 3) + 8 * ((2 * jj) >> 2) + q;
                wf |= (((DIR == 0) ? (k > r) : (k < r)) ? 0x3F80u : 0u) << (16 * q); wi |= ((k == r) ? 0x3F80u : 0u) << (16 * q); }
            tf[jj] = wf; ti[jj] = wi; }
        TF[ss] = __builtin_bit_cast(bf16x8s, tf); TI[ss] = __builtin_bit_cast(bf16x8s, ti); }
}
__device__ __forceinline__ void tri_l1(LAS const unsigned char* TK, int tb, int kb, const bf16x8s (&TF)[2], const bf16x8s (&TI)[2], f32x16& IC, f32x16& TT, f32x16& X) {
    IC = f32x16{}; TT = f32x16{}; X = f32x16{};
    const u32x4s o4 = {0x3F803F80u, 0x3F803F80u, 0x3F803F80u, 0x3F803F80u}; const bf16x8s ones = __builtin_bit_cast(bf16x8s, o4);
#pragma unroll
    for (int ss = 0; ss < 2; ++ss) { const s16x4s lo = trd(TK + tb + (16 * ss) * PTB + 64 * kb), hi = trd(TK + tb + (16 * ss + 8) * PTB + 64 * kb);
        const bf16x8s g = (bf16x8s){lo[0], lo[1], lo[2], lo[3], hi[0], hi[1], hi[2], hi[3]};
        IC = __builtin_amdgcn_mfma_f32_32x32x16_bf16(g, TF[ss], IC, 0, 0, 0); TT = __builtin_amdgcn_mfma_f32_32x32x16_bf16(g, ones, TT, 0, 0, 0); X = __builtin_amdgcn_mfma_f32_32x32x16_bf16(g, TI[ss], X, 0, 0, 0); }
}
__device__ __forceinline__ f32x16 tri_cumsum(LAS const unsigned char* TK, int tb, int kb, const bf16x8s (&T)[2]) {
    f32x16 sc = {};
#pragma unroll
    for (int ss = 0; ss < 2; ++ss) { const s16x4s lo = trd(TK + tb + (16 * ss) * PTB + 64 * kb), hi = trd(TK + tb + (16 * ss + 8) * PTB + 64 * kb);
        sc = __builtin_amdgcn_mfma_f32_32x32x16_bf16((bf16x8s){lo[0], lo[1], lo[2], lo[3], hi[0], hi[1], hi[2], hi[3]}, T[ss], sc, 0, 0, 0); }
    return sc;
}

template <int DK, bool HG> struct Ctx {
    const bf16* P; const float* A; int lane; LAS unsigned char* lw;
    int qcol, kcol, vcol, dir;
    bf16x8s wbf; float bav[16];
};
template <int DK> struct Raw { v4u g[DK / 16]; f32x4s a0, a1; };

template <int DK, bool HG, bool FULL, int VAR = 0>
__device__ __forceinline__ void load_raw(const Ctx<DK, HG>& c, size_t row0, Raw<DK>& w, int lane) {
    if (VAR & 8) return;
    const int r = lane & 31, hh = lane >> 5; const bf16* Pr = c.P + row0 * NP;
#pragma unroll
    for (int i = 0; i < DK / 16; ++i) { const int p = lane + 64 * i; w.g[i] = *(const GAS v4u*)(Pr + c.kcol + (unsigned)((p / (DK / 8)) * NP + (p % (DK / 8)) * 8)); }
    if (!HG) { const float* Ar = c.A + row0 * 32; w.a0 = *(const GAS f32x4s*)(Ar + (unsigned)(r * 32 + c.dir * 16 + 8 * hh)); w.a1 = *(const GAS f32x4s*)(Ar + (unsigned)(r * 32 + c.dir * 16 + 8 * hh + 4)); }
}

template <int DK, bool HG, int DIR, bool FULL, int VAR>
__device__ __forceinline__ void chunk_step(const Ctx<DK, HG>& c, size_t row_cur, size_t row_next, Raw<DK>& w, f32x16 (&S)[DK / 32][2], f32x16 (&O)[2]) {
    constexpr int NKB = DK / 32, NKS = DK / 16;
    const int lane_ = lane_id_opaque();
    const int lane = lane_, r = lane & 31, hh = lane >> 5;
    LAS unsigned char* TK = c.lw; LAS unsigned char* TV = c.lw + 32 * PTB; LAS float* VEC = (LAS float*)(c.lw + 64 * PTB);
#pragma unroll
    for (int i = 0; i < NKS; ++i) { const int p = lane + 64 * i; *(LAS v4u*)(TK + (p / (DK / 8)) * PTB + (p % (DK / 8)) * 16) = w.g[i]; }
    v4u vraw[4]; v4u qraw[NKS]; LAS unsigned char* TQ = c.lw + 64 * PTB + 1536;
    { const bf16* Pv = c.P + row_cur * NP;
        if (FULL) {
#pragma unroll
            for (int i = 0; i < NKS; ++i) { const int p = lane + 64 * i; qraw[i] = *(const GAS v4u*)(Pv + c.qcol + (unsigned)((p / (DK / 8)) * NP + (p % (DK / 8)) * 8)); } }
#pragma unroll
        for (int i = 0; i < 4; ++i) { const int p = lane + 64 * i; vraw[i] = *(const GAS v4u*)(Pv + (unsigned)((p >> 3) * NP + c.vcol + (p & 7) * 8)); } }
    f32x16 zg = {};
    if (!HG) { u32x4s t; t[0] = cvtpk(w.a0[0], w.a0[1]); t[1] = cvtpk(w.a0[2], w.a0[3]); t[2] = cvtpk(w.a1[0], w.a1[1]); t[3] = cvtpk(w.a1[2], w.a1[3]);
        zg = __builtin_amdgcn_mfma_f32_32x32x16_bf16(c.wbf, __builtin_bit_cast(bf16x8s, t), zg, 0, 0, 0); }
    bf16x8s QR[NKS], KR[NKS]; float eqv[FULL ? NKS : 1][8];
    const bool row1 = (r & 16) != 0;
    const int tb = (4 * hh + ((r & 15) >> 2)) * PTB + (16 * ((r >> 4) & 1) + 4 * (r & 3)) * 2;
    bf16x8s TE[2], TI[2]; f32x16 Em, Xm; te_frags<DIR>(TE, TI, r, hh);
    u32x2s G0a[NKS], G1a[NKS];
#pragma unroll
    for (int ks = 0; ks < NKS; ++ks) { if (!HG) { G0a[ks] = *(const LAS u32x2s*)(TK + r * PTB + (16 * ks + 4 * hh) * 2); G1a[ks] = *(const LAS u32x2s*)(TK + r * PTB + (16 * ks + 8 + 4 * hh) * 2); } }
    if (!HG) {
        LAS unsigned char* TX = c.lw + 64 * PTB + 1536;
#pragma unroll
        for (int ks = 0; ks < NKS; ++ks) { float xf[8];
#pragma unroll
            for (int j = 0; j < 8; ++j) { const float z = zg[8 * ks + j] + c.bav[8 * ks + j]; xf[j] = (fminf(z, 0.f) - __logf(1.f + __expf(-fabsf(z)))) * (1.4426950408889634f / 16.f); }
            *(LAS u32x2s*)(TX + r * PTB + (16 * ks + 4 * hh) * 2) = (u32x2s){cvtpk(xf[0], xf[1]), cvtpk(xf[2], xf[3])}; *(LAS u32x2s*)(TX + r * PTB + (16 * ks + 8 + 4 * hh) * 2) = (u32x2s){cvtpk(xf[4], xf[5]), cvtpk(xf[6], xf[7])}; }
        tri_ex(TX, tb, 0, TE, TI, Em, Xm);
    }
#pragma unroll
    for (int ks = 0; ks < NKS; ++ks) {
        if (HG && (ks & 1) == 0) tri_ex(TK, tb, ks >> 1, TE, TI, Em, Xm);
        float kt[8];
        {
            float xv[8], ev[8], kv[8];
            const int gi = HG ? 8 * (ks & 1) : 8 * ks;
#pragma unroll
            for (int j = 0; j < 8; ++j) { xv[j] = Xm[gi + j]; ev[j] = Em[gi + j]; }
            if (HG) {
#pragma unroll
                for (int j = 0; j < 8; ++j) kv[j] = 1.f - __builtin_amdgcn_exp2f(xv[j]);
            } else { const u32x2s g0_ = G0a[ks], g1_ = G1a[ks];
#pragma unroll
                for (int j = 0; j < 8; ++j) { const unsigned rawg = (j >> 2) ? g1_[(j >> 1) & 1] : g0_[(j >> 1) & 1]; kv[j] = __uint_as_float((j & 1) ? (rawg & 0xffff0000u) : (rawg << 16)); } }
            if (r == 0) { float t[8];
#pragma unroll
                for (int j = 0; j < 8; ++j) t[j] = (DIR == 0) ? xv[j] - ev[j] : ev[j];
                *(LAS f32x4s*)(VEC + 16 * ks + 4 * hh) = (f32x4s){t[0], t[1], t[2], t[3]}; *(LAS f32x4s*)(VEC + 16 * ks + 8 + 4 * hh) = (f32x4s){t[4], t[5], t[6], t[7]}; }
            if (r == 31) { float t[8];
#pragma unroll
                for (int j = 0; j < 8; ++j) t[j] = (DIR == 0) ? ev[j] : xv[j] - ev[j];
                *(LAS f32x4s*)(VEC + 64 + 16 * ks + 4 * hh) = (f32x4s){t[0], t[1], t[2], t[3]}; *(LAS f32x4s*)(VEC + 64 + 16 * ks + 8 + 4 * hh) = (f32x4s){t[4], t[5], t[6], t[7]}; }
#pragma unroll
            for (int j = 0; j < 8; ++j) { const float eq = __builtin_amdgcn_exp2f(__builtin_amdgcn_fmed3f(ev[j], -115.f, 115.f)), ek = __builtin_amdgcn_rcpf(eq); kt[j] = kv[j] * ek; if (FULL) eqv[ks][j] = eq; }
        }
        u32x4s tk; tk[0] = cvtpk(kt[0], kt[1]); tk[1] = cvtpk(kt[2], kt[3]); tk[2] = cvtpk(kt[4], kt[5]); tk[3] = cvtpk(kt[6], kt[7]); KR[ks] = __builtin_bit_cast(bf16x8s, tk);
        *(LAS u32x2s*)(TK + r * PTB + (16 * ks + 4 * hh) * 2) = (u32x2s){tk[0], tk[1]}; *(LAS u32x2s*)(TK + r * PTB + (16 * ks + 8 + 4 * hh) * 2) = (u32x2s){tk[2], tk[3]};
    }
    if (!FULL) load_raw<DK, HG, FULL, VAR>(c, row_next, w, lane);
#pragma unroll
    for (int i = 0; i < 4; ++i) { const int p = lane + 64 * i; *(LAS v4u*)(TV + (p >> 3) * PTB + (p & 7) * 16) = vraw[i]; }
    if (FULL) {
#pragma unroll
        for (int i = 0; i < NKS; ++i) { const int p = lane + 64 * i; *(LAS v4u*)(TQ + (p / (DK / 8)) * PTB + (p % (DK / 8)) * 16) = qraw[i]; } }
    LDS_WAIT(); asm volatile("" ::: "memory");
    if (FULL) {
#pragma unroll
        for (int ks = 0; ks < NKS; ++ks) { const u32x2s q0_ = *(const LAS u32x2s*)(TQ + r * PTB + (16 * ks + 4 * hh) * 2), q1_ = *(const LAS u32x2s*)(TQ + r * PTB + (16 * ks + 8 + 4 * hh) * 2); float qt[8];
#pragma unroll
            for (int j = 0; j < 8; ++j) { const unsigned rawq = (j >> 2) ? q1_[(j >> 1) & 1] : q0_[(j >> 1) & 1]; float qv = __uint_as_float((j & 1) ? (rawq & 0xffff0000u) : (rawq << 16)); if (!HG) qv *= 0.17677669529663687f; qt[j] = qv * eqv[ks][j]; }
            u32x4s tq; tq[0] = cvtpk(qt[0], qt[1]); tq[1] = cvtpk(qt[2], qt[3]); tq[2] = cvtpk(qt[4], qt[5]); tq[3] = cvtpk(qt[6], qt[7]); QR[ks] = __builtin_bit_cast(bf16x8s, tq); } }
    { const float t0 = VEC[lane], t1 = VEC[64 + lane]; VEC[128 + lane] += t0 + t1;
      const float er_ = __builtin_amdgcn_exp2f(fmaxf(DIR == 0 ? t0 : t1, -115.f)), eu_ = __builtin_amdgcn_exp2f(fmaxf(DIR == 0 ? t1 : t0, -115.f));
      VEC[192 + lane] = er_; VEC[256 + lane] = eu_; VEC[320 + lane] = er_ * eu_; }
    LDS_WAIT(); asm volatile("" ::: "memory");
    bf16x8s Vf[2][2];
#pragma unroll
    for (int vb = 0; vb < 2; ++vb)
#pragma unroll
        for (int ss = 0; ss < 2; ++ss) { const s16x4s lo = trd(TV + tb + (16 * ss) * PTB + 64 * vb), hi = trd(TV + tb + (16 * ss + 8) * PTB + 64 * vb);
            Vf[vb][ss] = (bf16x8s){lo[0], lo[1], lo[2], lo[3], hi[0], hi[1], hi[2], hi[3]}; }
    if (FULL) {
        f32x16 Pm = {};
#pragma unroll
        for (int ks = 0; ks < NKS; ++ks) Pm = __builtin_amdgcn_mfma_f32_32x32x16_bf16(KR[ks], QR[ks], Pm, 0, 0, 0);
        bf16x8s Pf[2];
#pragma unroll
        for (int ss = 0; ss < 2; ++ss) { u32x4s t;
#pragma unroll
            for (int jj = 0; jj < 4; ++jj) { const int g0 = 8 * ss + 2 * jj; const int s0 = crow(g0, hh), s1 = crow(g0 + 1, hh);
                const float p0 = (DIR == 0 ? (s0 <= r) : (s0 >= r)) ? Pm[g0] : 0.f, p1 = (DIR == 0 ? (s1 <= r) : (s1 >= r)) ? Pm[g0 + 1] : 0.f;
                t[jj] = cvtpk(p0, p1); }
            Pf[ss] = __builtin_bit_cast(bf16x8s, t); }
#pragma unroll
        for (int vb = 0; vb < 2; ++vb)
#pragma unroll
            for (int ss = 0; ss < 2; ++ss) O[vb] = __builtin_amdgcn_mfma_f32_32x32x16_bf16(Vf[vb][ss], Pf[ss], ss == 0 ? f32x16{} : O[vb], 0, 0, 0);
        __builtin_amdgcn_sched_barrier(0);
        load_raw<DK, HG, FULL, VAR>(c, row_next, w, lane);
#pragma unroll
        for (int kb = 0; kb < NKB; ++kb) {
            f32x4s er[4];
#pragma unroll
            for (int g = 0; g < 4; ++g) er[g] = *(const LAS f32x4s*)(VEC + 192 + 32 * kb + 8 * g + 4 * hh);
#pragma unroll
            for (int vb = 0; vb < 2; ++vb)
#pragma unroll
                for (int ss = 0; ss < 2; ++ss) { u32x4s t;
#pragma unroll
                    for (int jj = 0; jj < 4; ++jj) { const int g0 = 8 * ss + 2 * jj; t[jj] = cvtpk(S[kb][vb][g0] * er[g0 >> 2][g0 & 3], S[kb][vb][g0 + 1] * er[(g0 + 1) >> 2][(g0 + 1) & 3]); }
                    O[vb] = __builtin_amdgcn_mfma_f32_32x32x16_bf16(__builtin_bit_cast(bf16x8s, t), QR[2 * kb + ss], O[vb], 0, 0, 0); }
        }
    }
#pragma unroll
    for (int kb = 0; kb < NKB; ++kb) {
        bf16x8s KT[2];
#pragma unroll
        for (int ss = 0; ss < 2; ++ss) { const s16x4s lo = trd(TK + tb + (16 * ss) * PTB + 64 * kb), hi = trd(TK + tb + (16 * ss + 8) * PTB + 64 * kb);
            KT[ss] = (bf16x8s){lo[0], lo[1], lo[2], lo[3], hi[0], hi[1], hi[2], hi[3]}; }
        f32x4s gs[4], gu[4];
#pragma unroll
        for (int g = 0; g < 4; ++g) { gs[g] = *(const LAS f32x4s*)(VEC + 320 + 32 * kb + 8 * g + 4 * hh); gu[g] = *(const LAS f32x4s*)(VEC + 256 + 32 * kb + 8 * g + 4 * hh); }
#pragma unroll
        for (int vb = 0; vb < 2; ++vb) { f32x16 U = {};
#pragma unroll
            for (int ss = 0; ss < 2; ++ss) U = __builtin_amdgcn_mfma_f32_32x32x16_bf16(KT[ss], Vf[vb][ss], U, 0, 0, 0);
#pragma unroll
            for (int g = 0; g < 16; ++g) S[kb][vb][g] = S[kb][vb][g] * gs[g >> 2][g & 3] + U[g] * gu[g >> 2][g & 3]; }
    }
    LDS_WAIT(); asm volatile("" ::: "memory");
}

template <int DK, bool HG, int DIR, int VAR>
__device__ __forceinline__ void l1_step(const Ctx<DK, HG>& c, size_t row_cur, size_t row_next, Raw<DK>& w, f32x16 (&S)[DK / 32][2], float (&carry)[DK / 16][8]) {
    constexpr int NKB = DK / 32, NKS = DK / 16;
    const int lane_ = lane_id_opaque();
    const int lane = lane_, r = lane & 31, hh = lane >> 5;
    LAS unsigned char* TK = c.lw; LAS unsigned char* TV = c.lw + 32 * PTB; LAS float* VEC = (LAS float*)(c.lw + 64 * PTB);
    v4u vraw[4];
    { const bf16* Pv = c.P + row_cur * NP;
#pragma unroll
        for (int i = 0; i < 4; ++i) { const int p = lane + 64 * i; vraw[i] = *(const GAS v4u*)(Pv + (unsigned)((p >> 3) * NP + c.vcol + (p & 7) * 8)); } }
#pragma unroll
    for (int i = 0; i < NKS; ++i) { const int p = lane + 64 * i; *(LAS v4u*)(TK + (p / (DK / 8)) * PTB + (p % (DK / 8)) * 16) = w.g[i]; }
    f32x16 zg = {};
    if (!HG) { u32x4s t; t[0] = cvtpk(w.a0[0], w.a0[1]); t[1] = cvtpk(w.a0[2], w.a0[3]); t[2] = cvtpk(w.a1[0], w.a1[1]); t[3] = cvtpk(w.a1[2], w.a1[3]);
        zg = __builtin_amdgcn_mfma_f32_32x32x16_bf16(c.wbf, __builtin_bit_cast(bf16x8s, t), zg, 0, 0, 0); }
    const bool row1 = (r & 16) != 0;
    const int tb = (4 * hh + ((r & 15) >> 2)) * PTB + (16 * ((r >> 4) & 1) + 4 * (r & 3)) * 2;
    if constexpr (HG) {
        bf16x8s TF[2], TI[2]; l1_frags<DIR>(TF, TI, r, hh);
#pragma unroll
        for (int kb = 0; kb < NKB; ++kb) { f32x16 IC, TT, XX; tri_l1(TK, tb, kb, TF, TI, IC, TT, XX);
#pragma unroll
            for (int h2 = 0; h2 < 2; ++h2) { const int ks = 2 * kb + h2; float kt[8];
#pragma unroll
                for (int j = 0; j < 8; ++j) { const int g = 8 * h2 + j;
                    kt[j] = (1.f - __builtin_amdgcn_exp2f(XX[g])) * __builtin_amdgcn_exp2f(carry[ks][j] + IC[g]); carry[ks][j] += TT[g]; }
                u32x4s tk; tk[0] = cvtpk(kt[0], kt[1]); tk[1] = cvtpk(kt[2], kt[3]); tk[2] = cvtpk(kt[4], kt[5]); tk[3] = cvtpk(kt[6], kt[7]);
                *(LAS u32x2s*)(TK + r * PTB + (16 * ks + 4 * hh) * 2) = (u32x2s){tk[0], tk[1]}; *(LAS u32x2s*)(TK + r * PTB + (16 * ks + 8 + 4 * hh) * 2) = (u32x2s){tk[2], tk[3]}; } }
        load_raw<DK, HG, false, VAR>(c, row_next, w, lane);
#pragma unroll
        for (int i = 0; i < 4; ++i) { const int p = lane + 64 * i; *(LAS v4u*)(TV + (p >> 3) * PTB + (p & 7) * 16) = vraw[i]; }
        LDS_WAIT(); asm volatile("" ::: "memory");
    } else {
        LAS unsigned char* TX = c.lw + 64 * PTB + 1536;
        float kv[NKS][8];
#pragma unroll
        for (int ks = 0; ks < NKS; ++ks) {
            const u32x2s g0_ = *(const LAS u32x2s*)(TK + r * PTB + (16 * ks + 4 * hh) * 2), g1_ = *(const LAS u32x2s*)(TK + r * PTB + (16 * ks + 8 + 4 * hh) * 2);
            float xf[8];
#pragma unroll
            for (int j = 0; j < 8; ++j) { const unsigned rawg = (j >> 2) ? g1_[(j >> 1) & 1] : g0_[(j >> 1) & 1]; kv[ks][j] = __uint_as_float((j & 1) ? (rawg & 0xffff0000u) : (rawg << 16));
                const float z = zg[8 * ks + j] + c.bav[8 * ks + j]; xf[j] = (fminf(z, 0.f) - __logf(1.f + __expf(-fabsf(z)))) * (1.4426950408889634f / 16.f); }
            *(LAS u32x2s*)(TX + r * PTB + (16 * ks + 4 * hh) * 2) = (u32x2s){cvtpk(xf[0], xf[1]), cvtpk(xf[2], xf[3])}; *(LAS u32x2s*)(TX + r * PTB + (16 * ks + 8 + 4 * hh) * 2) = (u32x2s){cvtpk(xf[4], xf[5]), cvtpk(xf[6], xf[7])}; }
        bf16x8s TF[2], TI[2]; l1_frags<DIR>(TF, TI, r, hh);
        f32x16 IC, TT, XX; tri_l1(TX, tb, 0, TF, TI, IC, TT, XX);
#pragma unroll
        for (int ks = 0; ks < NKS; ++ks) { float kt[8];
#pragma unroll
            for (int j = 0; j < 8; ++j) { const int g = 8 * ks + j; kt[j] = kv[ks][j] * __builtin_amdgcn_exp2f(carry[ks][j] + IC[g]); carry[ks][j] += TT[g]; }
            u32x4s tk; tk[0] = cvtpk(kt[0], kt[1]); tk[1] = cvtpk(kt[2], kt[3]); tk[2] = cvtpk(kt[4], kt[5]); tk[3] = cvtpk(kt[6], kt[7]);
            *(LAS u32x2s*)(TK + r * PTB + (16 * ks + 4 * hh) * 2) = (u32x2s){tk[0], tk[1]}; *(LAS u32x2s*)(TK + r * PTB + (16 * ks + 8 + 4 * hh) * 2) = (u32x2s){tk[2], tk[3]}; }
        load_raw<DK, HG, false, VAR>(c, row_next, w, lane);
#pragma unroll
        for (int i = 0; i < 4; ++i) { const int p = lane + 64 * i; *(LAS v4u*)(TV + (p >> 3) * PTB + (p & 7) * 16) = vraw[i]; }
        LDS_WAIT(); asm volatile("" ::: "memory");
    }
    bf16x8s Vf[2][2];
#pragma unroll
    for (int vb = 0; vb < 2; ++vb)
#pragma unroll
        for (int ss = 0; ss < 2; ++ss) { const s16x4s lo = trd(TV + tb + (16 * ss) * PTB + 64 * vb), hi = trd(TV + tb + (16 * ss + 8) * PTB + 64 * vb);
            Vf[vb][ss] = (bf16x8s){lo[0], lo[1], lo[2], lo[3], hi[0], hi[1], hi[2], hi[3]}; }
#pragma unroll
    for (int kb = 0; kb < NKB; ++kb) {
        bf16x8s KT[2];
#pragma unroll
        for (int ss = 0; ss < 2; ++ss) { const s16x4s lo = trd(TK + tb + (16 * ss) * PTB + 64 * kb), hi = trd(TK + tb + (16 * ss + 8) * PTB + 64 * kb);
            KT[ss] = (bf16x8s){lo[0], lo[1], lo[2], lo[3], hi[0], hi[1], hi[2], hi[3]}; }
#pragma unroll
        for (int vb = 0; vb < 2; ++vb)
#pragma unroll
            for (int ss = 0; ss < 2; ++ss) S[kb][vb] = __builtin_amdgcn_mfma_f32_32x32x16_bf16(KT[ss], Vf[vb][ss], S[kb][vb], 0, 0, 0);
    }
    LDS_WAIT(); asm volatile("" ::: "memory");
}

template <int DK, bool HG, int DIR, int VAR>
__device__ __forceinline__ void scan_unit(const Frame& F, const Args& a, int layer, int b, int h, int unit) {
    constexpr int NKB = DK / 32;
    const int lane0 = lane_id_opaque();
    Ctx<DK, HG> c; c.P = (const bf16*)(a.ws + WS_PROJ); c.A = (const float*)(a.ws + WS_A); c.lane = lane0; c.lw = F.lds + F.wave * WAVE_LDS; c.dir = DIR;
    c.qcol = HG ? PQ_HQ + h * 64 : PQ_GQ + h * 32; c.kcol = HG ? (DIR ? col_hzb(h) : col_hzf(h)) : PQ_GK + h * 32; c.vcol = HG ? col_hi(h) : PQ_GV + h * 64;
    const int r = lane0 & 31, hh = lane0 >> 5, w = F.wave, lane = lane0;
    { u32x4s t = {0u, 0u, 0u, 0u};
#pragma unroll
        for (int g = 0; g < 16; ++g) c.bav[g] = 0.f;
        if (!HG) { const float* w2 = (DIR ? a.gla_wa2_b : a.gla_wa2_f) + (size_t)layer * 16 * 128 + (size_t)(8 * hh) * 128 + h * 32 + r;
#pragma unroll
            for (int jj = 0; jj < 4; ++jj) t[jj] = cvtpk(w2[(2 * jj) * 128], w2[(2 * jj + 1) * 128]);
            const float* bp = (DIR ? a.gla_ba_b : a.gla_ba_f) + layer * 128 + h * 32 + 4 * hh;
#pragma unroll
            for (int g = 0; g < 4; ++g) { const f32x4s bv = *(const f32x4s*)(bp + 8 * g); c.bav[4 * g] = bv[0]; c.bav[4 * g + 1] = bv[1]; c.bav[4 * g + 2] = bv[2]; c.bav[4 * g + 3] = bv[3]; } }
        c.wbf = __builtin_bit_cast(bf16x8s, t); }
    GAS float* OSC = (GAS float*)(a.ws + (DIR ? WS_OSC1 : WS_OSC0) + (size_t)(unit >> 1) * OSC_UNIT);
    GAS float* XS = OSC; GAS float* XB = XS + 8 * 4 * 16 * 64;
    const size_t rowseg = (size_t)b * SEQ + w * SEGT;
    LAS float* VEC = (LAS float*)(c.lw + 64 * PTB);
    f32x16 S[NKB][2]; f32x16 O[2]; Raw<DK> raw;
#pragma unroll
    for (int kb = 0; kb < NKB; ++kb) { S[kb][0] = f32x16{}; S[kb][1] = f32x16{}; }
    { float carry[DK / 16][8];
#pragma unroll
        for (int ks = 0; ks < DK / 16; ++ks)
#pragma unroll
            for (int j = 0; j < 8; ++j) carry[ks][j] = 0.f;
        load_raw<DK, HG, false>(c, rowseg + (DIR ? 0 : NCH - 1) * CH, raw, lane_id_opaque());
#pragma unroll 1
        for (int ci = 0; ci < ((VAR & 32) ? 0 : NCH); ++ci) { const int cc = DIR ? ci : NCH - 1 - ci; const int cn = ci + 1 < NCH ? ci + 1 : ci; const int ccn = DIR ? cn : NCH - 1 - cn;
            l1_step<DK, HG, DIR, VAR>(c, rowseg + cc * CH, rowseg + ccn * CH, raw, S, carry); }
        LDS_WAIT(); __syncthreads();
        const int ln = lane_id_opaque();
        LAS float* xs = (LAS float*)F.lds + (w * 4) * 16 * 64;
#pragma unroll
        for (int kb = 0; kb < NKB; ++kb)
#pragma unroll
            for (int vb = 0; vb < 2; ++vb)
#pragma unroll
                for (int g = 0; g < 16; ++g) xs[((kb * 2 + vb) * 16 + g) * 64 + ln] = S[kb][vb][g];
        if ((ln & 31) == 0) {
            LAS float* XT = (LAS float*)(F.lds + 131072);
#pragma unroll
            for (int ks = 0; ks < DK / 16; ++ks)
#pragma unroll
                for (int jh = 0; jh < 2; ++jh) *(LAS f32x4s*)(XT + w * 64 + 16 * ks + 8 * jh + 4 * (ln >> 5)) = (f32x4s){carry[ks][4 * jh], carry[ks][4 * jh + 1], carry[ks][4 * jh + 2], carry[ks][4 * jh + 3]}; } }
    LDS_WAIT(); __syncthreads();
    load_raw<DK, HG, true>(c, rowseg + (DIR ? NCH - 1 : 0) * CH, raw, lane_id_opaque());
    { const int t_ = F.wave * 64 + lane_id_opaque();
        LAS float* XL = (LAS float*)F.lds; LAS float* XT = (LAS float*)(F.lds + 131072);
        constexpr int NVEC = NKB * 2 * 16 * 64 / 4;
        for (int v = t_; v < NVEC; v += NWAVES * 64) {
            const int f = 4 * v, blk = f >> 10, g = (f & 1023) >> 6, l4 = f & 63, k = 32 * (blk >> 1) + crow(g, l4 >> 5);
            f32x4s sl[8]; float bg[8];
#pragma unroll
            for (int ww = 0; ww < 8; ++ww) { sl[ww] = *(const LAS f32x4s*)(XL + (ww * 4) * 16 * 64 + f); bg[ww] = XT[ww * 64 + k]; }
            float z_ = 0.f; asm volatile("" : "+v"(z_)); f32x4s acc = {z_, z_, z_, z_};
#pragma unroll
            for (int i = 0; i < 8; ++i) { const int ww = DIR ? 7 - i : i; const f32x4s nxt = acc * __builtin_amdgcn_exp2f(bg[ww]) + sl[ww];
                *(LAS f32x4s*)(XL + (ww * 4) * 16 * 64 + f) = acc; acc = nxt; }
        } }
    LDS_WAIT(); __syncthreads();
    { const int ln = lane_id_opaque(); const LAS float* xs = (const LAS float*)F.lds + (w * 4) * 16 * 64;
#pragma unroll
        for (int kb = 0; kb < NKB; ++kb)
#pragma unroll
            for (int vb = 0; vb < 2; ++vb)
#pragma unroll
                for (int g = 0; g < 16; ++g) S[kb][vb][g] = xs[((kb * 2 + vb) * 16 + g) * 64 + ln]; }
    LDS_WAIT();
    __syncthreads();
#pragma unroll 1
    for (int ci = 0; ci < ((VAR & 64) ? 0 : NCH); ++ci) { const int cc = DIR ? NCH - 1 - ci : ci; const int cn = ci + 1 < NCH ? ci + 1 : ci; const int ccn = DIR ? NCH - 1 - cn : cn;
        chunk_step<DK, HG, DIR, true, VAR>(c, rowseg + cc * CH, rowseg + ccn * CH, raw, S, O);
        GAS unsigned* osc = (GAS unsigned*)OSC + (size_t)((w * NCH + cc) * 16) * 64; const int ln = lane_id_opaque();
#pragma unroll
        for (int vb = 0; vb < 2; ++vb)
#pragma unroll
            for (int g = 0; g < 8; ++g) { const unsigned ov_ = cvtpk(O[vb][2 * g], O[vb][2 * g + 1]);
                asm volatile("global_store_dword %0, %1, off sc1" :: "v"(osc + (unsigned)((vb * 8 + g) * 64 + ln)), "v"(ov_) : "memory"); }
    }
}

struct FinRaw { v4u g[4]; unsigned a0[16], a1[16]; };
template <bool HG> __device__ __forceinline__ void fin_load(FinRaw& r, const Args& a, int b, int h, int pair, int cc, int ln) {
    const bf16* P = (const bf16*)(a.ws + WS_PROJ);
    const GAS unsigned* o0 = (const GAS unsigned*)(a.ws + WS_OSC0 + (size_t)pair * OSC_UNIT) + (size_t)(cc * 16) * 64; const GAS unsigned* o1 = (const GAS unsigned*)(a.ws + WS_OSC1 + (size_t)pair * OSC_UNIT) + (size_t)(cc * 16) * 64;
    const bf16* gp = P + ((size_t)b * SEQ + cc * CH) * NP + (HG ? col_hg(h) : PQ_GG + h * 64);
#pragma unroll
    for (int i = 0; i < 4; ++i) { const int p = ln + 64 * i; r.g[i] = __builtin_nontemporal_load((const GAS v4u*)(gp + (unsigned)((p >> 3) * NP + (p & 7) * 8))); }
#pragma unroll
    for (int i = 0; i < 16; ++i) { r.a0[i] = __builtin_nontemporal_load(o0 + (unsigned)(i * 64 + ln)); r.a1[i] = __builtin_nontemporal_load(o1 + (unsigned)(i * 64 + ln)); }
}
template <bool HG> __device__ __forceinline__ void fin_proc(const FinRaw& r, const Frame& F, const Args& a, int layer, int b, int h, int cc, int ln) {
    LAS unsigned char* TG = F.lds + F.wave * 8192; LAS unsigned char* TO = TG + 4096;
    const int rq = ln & 31, hq = ln >> 5;
    bf16* mp = (bf16*)(a.ws + WS_MIX) + ((size_t)b * SEQ + cc * CH) * DM + (HG ? 768 : 0) + h * 64;
    float ov[32], ss = 0.f;
#pragma unroll
    for (int i = 0; i < 16; ++i) { const unsigned a0 = r.a0[i], a1 = r.a1[i];
        const float v0 = __uint_as_float(a0 << 16) + __uint_as_float(a1 << 16), v1 = __uint_as_float(a0 & 0xffff0000u) + __uint_as_float(a1 & 0xffff0000u);
        ov[2 * i] = v0; ov[2 * i + 1] = v1; ss += v0 * v0 + v1 * v1; }
    ss += other_half(ss, hq);
    const float rs = 1.f / sqrtf(ss * (1.f / 64.f) + EPS);
#pragma unroll
    for (int i = 0; i < 4; ++i) { const int p = ln + 64 * i; *(LAS v4u*)(TG + (p >> 3) * 128 + (p & 7) * 16) = r.g[i]; }
    LDS_WAIT(); asm volatile("" ::: "memory");
    const float* nwp = (HG ? a.hgrn_norm : a.gla_norm) + layer * 64;
#pragma unroll
    for (int vb = 0; vb < 2; ++vb)
#pragma unroll
        for (int g = 0; g < 4; ++g) { const int col = 4 * hq + 32 * vb + 8 * g; const u32x2s gq = *(const LAS u32x2s*)(TG + rq * 128 + col * 2); const f32x4s nw = *(const GAS f32x4s*)(nwp + (unsigned)col);
            float gv[4] = {__uint_as_float(gq[0] << 16), __uint_as_float(gq[0] & 0xffff0000u), __uint_as_float(gq[1] << 16), __uint_as_float(gq[1] & 0xffff0000u)}; float out[4];
#pragma unroll
            for (int q = 0; q < 4; ++q) { const float sg = gv[q] / (1.f + __expf(-gv[q])); out[q] = ov[vb * 16 + 4 * g + q] * rs * nw[q] * sg; }
            u32x2s ow; ow[0] = cvtpk(out[0], out[1]); ow[1] = cvtpk(out[2], out[3]); *(LAS u32x2s*)(TO + rq * 128 + col * 2) = ow; }
    LDS_WAIT(); asm volatile("" ::: "memory");
#pragma unroll
    for (int i = 0; i < 4; ++i) { const int p = ln + 64 * i; const v4u o = *(const LAS v4u*)(TO + (p >> 3) * 128 + (p & 7) * 16); *(GAS v4u*)(mp + (unsigned)((p >> 3) * DM + (p & 7) * 8)) = o; }
    LDS_WAIT(); asm volatile("" ::: "memory");
}
template <bool HG>
__device__ __forceinline__ void finalize_chunks(const Frame& F, const Args& a, int layer, int b, int h, int pair, int c0, int nc) {
    int ln = F.lane; asm volatile("" : "+v"(ln));
    int cc = c0 + F.wave; const int ce = c0 + nc; if (cc >= ce) return;
    FinRaw A, B; fin_load<HG>(A, a, b, h, pair, cc, ln);
    for (;;) {
        const int n1 = cc + NWAVES; const bool h1 = n1 < ce; if (h1) fin_load<HG>(B, a, b, h, pair, n1, ln);
        fin_proc<HG>(A, F, a, layer, b, h, cc, ln); if (!h1) break;
        const int n2 = n1 + NWAVES; const bool h2 = n2 < ce; if (h2) fin_load<HG>(A, a, b, h, pair, n2, ln);
        fin_proc<HG>(B, F, a, layer, b, h, n1, ln); if (!h2) break;
        cc = n2;
    }
}
}

template <int VAR = 0> __device__ __forceinline__ void scan_phase_units(const Frame& F, const Args& a, int layer) {
    unsigned* flags = (unsigned*)(a.ws + WS_CTL) + 8192 + layer * 256;
    for (int u = F.vcu; u < 256; u += F.G) {
        const int pair = u >> 1, dir = u & 1, type = pair >> 6, b = (pair & 63) >> 2, h = pair & 3;
        if (type) { if (dir) scan::scan_unit<64, true, 1, VAR>(F, a, layer, b, h, u); else scan::scan_unit<64, true, 0, VAR>(F, a, layer, b, h, u); }
        else { if (dir) scan::scan_unit<32, false, 1, VAR>(F, a, layer, b, h, u); else scan::scan_unit<32, false, 0, VAR>(F, a, layer, b, h, u); }
        VM_WAIT(); __syncthreads();
        if (F.wave == 0 && lane_id_opaque() == 0) { unsigned ep = (unsigned)(layer + 1); unsigned long long fp = (unsigned long long)(flags + u); asm volatile("" : "+s"(ep), "+s"(fp));
              __hip_atomic_store((unsigned*)fp, ep, __ATOMIC_RELAXED, __HIP_MEMORY_SCOPE_AGENT); }
    }
}
#ifndef FIN_X
#define FIN_X 8
#endif
__device__ __forceinline__ void fin_wait(const Frame& F, unsigned* flag, int layer) {
    if (F.tid == 0) { unsigned spins = 0;
        while (__hip_atomic_load(flag, __ATOMIC_RELAXED, __HIP_MEMORY_SCOPE_AGENT) != (unsigned)(layer + 1)) { __builtin_amdgcn_s_sleep(2); if (++spins > (1u << 24)) break; }
        __builtin_amdgcn_fence(__ATOMIC_ACQUIRE, "agent"); VM_WAIT(); }
    __syncthreads();
}
__device__ __forceinline__ void scan_phase_finalize(const Frame& F, const Args& a, int layer) {
    unsigned* flags = (unsigned*)(a.ws + WS_CTL) + 8192 + layer * 256;
    for (int u = F.vcu; u < 256; u += F.G) {
        const int pair = u >> 1, dir = u & 1, type = pair >> 6, b = (pair & 63) >> 2, h = pair & 3;
        fin_wait(F, flags + (u ^ 1), layer);
        if (type) scan::finalize_chunks<true>(F, a, layer, b, h, pair, dir * 32, 32 - FIN_X);
        else { scan::finalize_chunks<false>(F, a, layer, b, h, pair, dir * 32, 32);
            if (FIN_X) { fin_wait(F, flags + 2 * (pair + 64), layer); fin_wait(F, flags + 2 * (pair + 64) + 1, layer);
                scan::finalize_chunks<true>(F, a, layer, b, h, pair + 64, dir * 32 + 32 - FIN_X, FIN_X); } }
    }
}
#define SCAN_PHASE scan_phase_units<0>
#define SCAN_HAS_FINALIZE 1
template <int VAR = 0> __device__ __forceinline__ void attn_phase(const Frame& F, const Args& a, int layer) {
    const bf16* P = (const bf16*)(a.ws + WS_PROJ); bf16* MX = (bf16*)(a.ws + WS_MIX);
    const float linit = 0.8f - 0.6f * expf(-0.3f * (float)layer);
    const float d1 = wave_sum(a.lq1[layer * 64 + F.lane] * a.lk1[layer * 64 + F.lane]), d2 = wave_sum(a.lq2[layer * 64 + F.lane] * a.lk2[layer * 64 + F.lane]);
    const float lam = expf(d1) - expf(d2) + linit;
    const int NU = BATCH * 4 * (SEQ / 128), per = (NU + F.G - 1) / F.G;
    auto unit_of = [&](int i) { int u = F.vcu * per + i;
        if (F.G == 256) { const int xcd = F.vcu >> 5, w = F.vcu & 31; u = ((xcd * 8 + i * 2 + (w >> 4)) << 4) | (w & 15); }
        return u; };
    dattn::bf16x8 qr[4]; bool pre = false;
    for (int i = 0; i < per; ++i) { if (F.vcu * per + i >= NU) break;
        const int u = unit_of(i); const int bh = u >> 4, qb = u & 15, b = bh >> 2, h = bh & 3; const size_t row0 = (size_t)b * SEQ + qb * 128;
        const bool hn = (i + 1 < per) && (F.vcu * per + i + 1 < NU); const int un = hn ? unit_of(i + 1) : u; const int bhn = un >> 4, bn = bhn >> 2, hh = bhn & 3; const size_t rown = (size_t)bn * SEQ + (un & 15) * 128;
        dattn::diff_unit<VAR>(P + row0 * NP + PQ_DQ + h * 128, P + (size_t)b * SEQ * NP + PQ_DK + h * 128, P + (size_t)b * SEQ * NP + PQ_DV + h * 128,
                         P + row0 * NP + PQ_DG + h * 128, MX + row0 * DM + 256 + h * 128, lam, a.diff_norm + layer * 128, 1.f - linit, (char*)F.lds, F.wave,
                         hn ? P + rown * NP + PQ_DQ + hh * 128 : nullptr, P + (size_t)bn * SEQ * NP + PQ_DK + hh * 128, P + (size_t)bn * SEQ * NP + PQ_DV + hh * 128, pre, qr);
        pre = hn; }
}

__global__ void __launch_bounds__(NWAVES * 64, 2) fwd_mega(Args args) {
    extern __shared__ __attribute__((aligned(16))) unsigned char lds[];
    cg::grid_group grid = cg::this_grid();
    const int wave_s = __builtin_amdgcn_readfirstlane((int)threadIdx.x >> 6);
#define MKFRAME() Frame F; { int t_ = wave_s * 64 + lane_id_opaque(); asm volatile("" : "+v"(t_)); F.lds = (LAS unsigned char*)lds; F.tid = t_; F.lane = t_ & 63; F.wave = wave_s; \
    F.G = gridDim.x; const int bx = blockIdx.x; F.vcu = (F.G % 8 == 0) ? (bx % 8) * (F.G / 8) + bx / 8 : bx; }
    constexpr int ARGTAB = LDS_BYTES - 256, NARGW = (int)(sizeof(Args) / 4);
    { const unsigned* src = (const unsigned*)&args; if (threadIdx.x < NARGW) ((LAS unsigned*)(lds + ARGTAB))[threadIdx.x] = src[threadIdx.x]; }
    { for (int u = threadIdx.x; u < 64; u += NWAVES * 64) ((LAS unsigned*)(lds + LDS_BYTES - 512))[u] = 0u; }
    __syncthreads();
    (void)xcd_barrier_post((unsigned*)(args.ws + WS_CTL) + 4096, (volatile LAS unsigned*)(lds + LDS_BYTES - 512));
    const int lo = args.ph_lo, hi = args.ph_hi, repm = args.rep;
#define LDARGS() Args A_; { unsigned off_ = ARGTAB; asm volatile("" : "+s"(off_)); const LAS unsigned* tab_ = (const LAS unsigned*)((LAS unsigned char*)lds + off_); unsigned* dst_ = (unsigned*)&A_; \
    _Pragma("unroll") for (int i_ = 0; i_ < NARGW; ++i_) dst_[i_] = __builtin_amdgcn_readfirstlane(tab_[i_]); }
#define IN(k) (lo <= (k) && (k) < hi)
#define SEAM(k) do { if (IN(k) && IN((k) + 1)) { for (int rep_ = 0; rep_ < 1 + 2 * ((repm >> 4) & 1); ++rep_) { if (repm == 0x40000000) grid.sync();   { LDARGS(); XcdBarrier b_; b_.bar = (unsigned*)(A_.ws + WS_CTL) + 4096; b_.x = xb_xcc_id(); b_.st = (volatile LAS unsigned*)(lds + LDS_BYTES - 512); xcd_barrier(b_); } } } } while (0)
#ifndef NO_P0
    if (IN(0)) { for (int rep_ = 0; rep_ < 1 + ((repm >> 6) & 1); ++rep_) { MKFRAME(); LDARGS(); p0_prologue(F, A_, 3); } for (int rep_ = 0; rep_ < ((repm >> 10) & 1); ++rep_) { MKFRAME(); LDARGS(); p0_prologue(F, A_, 1); } for (int rep_ = 0; rep_ < ((repm >> 11) & 1); ++rep_) { MKFRAME(); LDARGS(); p0_prologue(F, A_, 2); } }
#endif
    SEAM(0);
    for (int layer = 0; layer < DEPTH; ++layer) {
        const int pb = 1 + 4 * layer;
        if (IN(pb)) {
            MKFRAME(); LDARGS(); const Args& args = A_;
            pg8::Gemm g{(const pg8::bf16_t*)(args.ws + WS_XB), (const pg8::bf16_t*)(args.ws + WS_WIN) + (size_t)layer * NPA * DM, M, NP, DM};
            pg8::StaticOrder S; S.init(M, NP, F.G, (int)blockIdx.x);
            pg8::EpiProj E{(pg8::bf16_t*)(args.ws + WS_PROJ), (const float*)(args.ws + WS_ROPE), (const float*)(args.ws + WS_ROPE) + SEQ * 32, (const float*)(args.ws + WS_LB) + layer * 256, (const float*)(args.ws + WS_RSTD)};
            const bool lr_first = ((blockIdx.x >> 3) & 1) != 0;
#ifndef NO_LR
            if (lr_first) for (int rep_ = 0; rep_ < 1 + ((repm >> 5) & 1); ++rep_) lowrank_phase(F, args, layer);
#endif
#ifndef NO_GA
            for (int rep_ = -((repm >> 14) & 1); rep_ < 1 + (repm & 1); ++rep_)
            pg8::gemm_phase<pg8::EpiProj, pg8::StaticOrder, true, true>(F.lds, g, S, E, wave_s, rep_ < 0 ? -1 : ((repm >> 9) & 1));
#endif
#ifndef NO_LR
            if (!lr_first) for (int rep_ = 0; rep_ < 1 + ((repm >> 5) & 1); ++rep_) lowrank_phase(F, args, layer);
#endif
        }
        SEAM(pb);
        if (IN(pb + 1)) {
            int attn_first = (int)((blockIdx.x >> 4) & 1); asm volatile("" : "+s"(attn_first));
#ifndef NO_SCAN
            if (!attn_first) { for (int rep_ = 0; rep_ < 1 + ((repm >> 1) & 1); ++rep_) { MKFRAME(); LDARGS(); SCAN_PHASE(F, A_, layer); } }
#endif
#ifndef NO_ATTN
            for (int rep_ = 0; rep_ < 1 + ((repm >> 2) & 1); ++rep_) { MKFRAME(); LDARGS(); attn_phase<0>(F, A_, layer); }
#endif
#ifndef NO_SCAN
            if (attn_first) { for (int rep_ = 0; rep_ < 1 + ((repm >> 1) & 1); ++rep_) { MKFRAME(); LDARGS(); SCAN_PHASE(F, A_, layer); } }
#endif
#ifdef SCAN_HAS_FINALIZE
            for (int rep_ = 0; rep_ < 1 + ((repm >> 7) & 1); ++rep_) { MKFRAME(); LDARGS(); scan_phase_finalize(F, A_, layer); }
#endif
        }
        SEAM(pb + 1);
        if (IN(pb + 2)) {
            MKFRAME(); LDARGS(); const Args& args = A_;
            pg8::Gemm g{(const pg8::bf16_t*)(args.ws + WS_MIX), (const pg8::bf16_t*)(args.ws + WS_WOUT) + (size_t)layer * DM * DM, M, DM, DM};
            pg8::StaticOrder S; S.init(M, DM, F.G, (int)blockIdx.x);
            pg8::EpiY E{(pg8::bf16_t*)(args.ws + WS_Y)};
#ifndef NO_GC
            for (int rep_ = 0; rep_ < 1 + ((repm >> 3) & 1); ++rep_)
            pg8::gemm_phase<pg8::EpiY, pg8::StaticOrder, true, true>(F.lds, g, S, E, wave_s);
#endif
        }
        SEAM(pb + 2);
#ifndef NO_PD
        if (IN(pb + 3)) { MKFRAME(); LDARGS(); postnorm_phase(F, A_, layer); for (int rep_ = 0; rep_ < ((repm >> 8) & 1); ++rep_) postnorm_phase(F, A_, layer, true); }
#endif
        if (layer + 1 < DEPTH) SEAM(pb + 3);
    }
#undef IN
#undef SEAM
}
constexpr int N_PHASES = 1 + 4 * DEPTH;

extern "C" void kernel_launch(void* const* d_in, const int* in_sizes, int n_in, void* d_out, int out_size, void* d_ws, size_t ws_size, hipStream_t stream) {
    static int grid = 0;
    if (grid == 0) {
        if (n_in != 17 || in_sizes[0] != M * DM || out_size != M * DM || ws_size < WS_END) {
            fprintf(stderr, "kernel_launch: shape mismatch n_in %d in0 %d out %d ws %zu (need %zu)\n", n_in, n_in > 0 ? in_sizes[0] : -1, out_size, ws_size, (size_t)WS_END); grid = -1; return; }
        int dev = 0, cus = 0, per_cu = 0;
        if (hipGetDevice(&dev) != hipSuccess || hipDeviceGetAttribute(&cus, hipDeviceAttributeMultiprocessorCount, dev) != hipSuccess) { grid = -1; return; }
        if (hipFuncSetAttribute((const void*)fwd_mega, hipFuncAttributeMaxDynamicSharedMemorySize, LDS_BYTES) != hipSuccess) { fprintf(stderr, "kernel_launch: hipFuncSetAttribute failed\n"); grid = -1; return; }
        if (hipOccupancyMaxActiveBlocksPerMultiprocessor(&per_cu, (const void*)fwd_mega, NWAVES * 64, LDS_BYTES) != hipSuccess || per_cu < 1) { fprintf(stderr, "kernel_launch: occupancy query says %d\n", per_cu); (void)hipGetLastError(); grid = -1; return; }
        grid = cus;
        fprintf(stderr, "kernel_launch: cus %d per_cu %d grid %d ws %zu\n", cus, per_cu, grid, ws_size);
    }
    if (grid < 0) return;
    if (hipMemsetAsync((char*)d_ws + WS_CTL, 0, 65536, stream) != hipSuccess) { fprintf(stderr, "kernel_launch: memset failed\n"); return; }
    Args a{};
    a.x = (const float*)d_in[0]; a.norm_pre = (const float*)d_in[1]; a.norm_post = (const float*)d_in[2]; a.w_in = (const float*)d_in[3]; a.w_out = (const float*)d_in[4];
    a.gla_wa2_f = (const float*)d_in[5]; a.gla_ba_f = (const float*)d_in[6]; a.gla_wa2_b = (const float*)d_in[7]; a.gla_ba_b = (const float*)d_in[8]; a.gla_norm = (const float*)d_in[9];
    a.lq1 = (const float*)d_in[10]; a.lk1 = (const float*)d_in[11]; a.lq2 = (const float*)d_in[12]; a.lk2 = (const float*)d_in[13]; a.diff_norm = (const float*)d_in[14];
    a.lb_logits = (const float*)d_in[15]; a.hgrn_norm = (const float*)d_in[16];
    a.out = (float*)d_out; a.ws = (unsigned char*)d_ws; a.ph_lo = 0; a.ph_hi = N_PHASES;
#ifdef REP_MASK
    a.rep = REP_MASK;
#endif
    void* kargs[] = {&a};
    const hipError_t e = hipLaunchCooperativeKernel((const void*)fwd_mega, dim3(grid), dim3(NWAVES * 64), kargs, LDS_BYTES, stream);
    if (e != hipSuccess) fprintf(stderr, "kernel_launch: cooperative launch failed: %s (grid %d)\n", hipGetErrorString(e), grid);
}
```
